# Optimizing an MI355X kernel written in HIP

```python
import jax, jax.numpy as jnp
from jax import lax
import numpy as np

D_MODEL = 2048
BATCH = 4
SEQ = 4096
DEPTH = 4

HEAD_DIM = 128
GROUP_HEADS = 4
GROUP_WIDTH = GROUP_HEADS * HEAD_DIM
N_GROUPS = 4
MIX_WIDTH = N_GROUPS * GROUP_WIDTH
Q_BLOCK = 128
MOBA_BLOCK = 256
MOBA_TOP_K = 3
MOBA_Q_CHUNK = 32
MLA_Q_RANK = 512
MLA_KV_RANK = 256
MLA_NOPE_DIM = 128
MLA_ROPE_DIM = 64
MLA_V_DIM = 128
MLA_QK_DIM = MLA_NOPE_DIM + MLA_ROPE_DIM
D_FF = 5632
CONV_WIDTH = 3
ROPE_THETA = 10000.0
EPS = 1e-6
FORGET_BIAS_LO = 1.0
FORGET_BIAS_HI = 4.0
IN_WIDTHS = (GROUP_WIDTH, GROUP_WIDTH, GROUP_WIDTH, GROUP_HEADS,
             GROUP_WIDTH, GROUP_WIDTH, GROUP_WIDTH,
             GROUP_WIDTH, GROUP_WIDTH, GROUP_WIDTH,
             MLA_Q_RANK, MLA_KV_RANK, MLA_ROPE_DIM)
IN_WIDTH = sum(IN_WIDTHS)

kernel_name = "hybrid_fox_stickbreak_moba_mla_convglu"


def rms_norm(x, g):
    xf = x.astype(jnp.float32)
    y = xf * lax.rsqrt(jnp.mean(xf * xf, axis=-1, keepdims=True) + EPS)
    return (y * g.astype(jnp.float32)).astype(x.dtype)


def to_heads(t, n_heads):
    b, s, _ = t.shape
    return t.reshape(b, s, n_heads, -1).transpose(0, 2, 1, 3)


def from_heads(t):
    b, h, s, e = t.shape
    return t.transpose(0, 2, 1, 3).reshape(b, s, h * e)


def rope_angles(seq, dim):
    inv_freq = ROPE_THETA ** (-jnp.arange(0, dim, 2, dtype=jnp.float32) / dim)
    ang = jnp.arange(seq, dtype=jnp.float32)[:, None] * inv_freq[None, :]
    return jnp.cos(ang), jnp.sin(ang)


def apply_rope(t, cos, sin):
    t1, t2 = jnp.split(t, 2, axis=-1)
    c, s = cos.astype(t.dtype), sin.astype(t.dtype)
    return jnp.concatenate([t1 * c - t2 * s, t1 * s + t2 * c], axis=-1)


def sweep_queries(block_fn, seq, chunk):
    out = lax.map(block_fn, jnp.arange(seq // chunk, dtype=jnp.int32) * chunk)
    n, b, h, c, e = out.shape
    return jnp.moveaxis(out, 0, 2).reshape(b, h, n * c, e)


def causal_softmax_attention(q, k, v, cum_log_forget=None):
    seq = q.shape[2]
    scale = q.shape[-1] ** -0.5
    key_pos = jnp.arange(seq)

    def block(start):
        qb = lax.dynamic_slice_in_dim(q, start, Q_BLOCK, axis=2)
        q_pos = start + jnp.arange(Q_BLOCK)
        logits = jnp.einsum("bhqd,bhkd->bhqk", qb, k).astype(jnp.float32) * scale
        if cum_log_forget is not None:
            cq = lax.dynamic_slice_in_dim(cum_log_forget, start, Q_BLOCK, axis=2)
            logits = logits + (cq[..., :, None] - cum_log_forget[..., None, :])
        logits = jnp.where(key_pos[None, :] <= q_pos[:, None], logits, -jnp.inf)
        p = jax.nn.softmax(logits, axis=-1)
        return jnp.einsum("bhqk,bhkd->bhqd", p.astype(v.dtype), v)

    return sweep_queries(block, seq, Q_BLOCK)


def stick_breaking_attention(q, k, v):
    seq = q.shape[2]
    scale = q.shape[-1] ** -0.5
    key_pos = jnp.arange(seq)

    def block(start):
        qb = lax.dynamic_slice_in_dim(q, start, Q_BLOCK, axis=2)
        q_pos = start + jnp.arange(Q_BLOCK)
        z = jnp.einsum("bhqd,bhkd->bhqk", qb, k).astype(jnp.float32) * scale
        strict = key_pos[None, :] < q_pos[:, None]
        log_beta = jax.nn.log_sigmoid(z)
        log_rest = jnp.where(strict, log_beta - z, 0.0)
        log_stick = lax.cumsum(log_rest, axis=3, reverse=True) - log_rest
        w = jnp.where(strict, jnp.exp(log_beta + log_stick), 0.0)
        return jnp.einsum("bhqk,bhkd->bhqd", w.astype(v.dtype), v)

    return sweep_queries(block, seq, Q_BLOCK)


def moba_attention(q, k, v):
    b, h, seq, d = q.shape
    scale = d ** -0.5
    n_blocks = -(-seq // MOBA_BLOCK)
    pad = n_blocks * MOBA_BLOCK - seq
    kp = jnp.pad(k, ((0, 0), (0, 0), (0, pad), (0, 0)))
    vp = jnp.pad(v, ((0, 0), (0, 0), (0, pad), (0, 0)))
    k_blocks = kp.reshape(b, h, n_blocks, MOBA_BLOCK, d)
    v_blocks = vp.reshape(b, h, n_blocks, MOBA_BLOCK, d)
    k_mean = jnp.mean(k_blocks.astype(jnp.float32), axis=3).astype(k.dtype)
    n_sel = min(MOBA_TOP_K, n_blocks)
    b_ix = jnp.arange(b)[:, None, None, None]
    h_ix = jnp.arange(h)[None, :, None, None]
    block_ids = jnp.arange(n_blocks)

    def chunk(start):
        qc = lax.dynamic_slice_in_dim(q, start, MOBA_Q_CHUNK, axis=2)
        q_pos = start + jnp.arange(MOBA_Q_CHUNK)
        own = start // MOBA_BLOCK
        gate = jnp.einsum("bhcd,bhnd->bhcn", qc, k_mean).astype(jnp.float32)
        gate = jnp.where(block_ids < own, gate, -jnp.inf)
        _, sel = lax.top_k(gate, n_sel)
        sel_valid = jnp.arange(n_sel) < own
        k_sel = k_blocks[b_ix, h_ix, sel]
        v_sel = v_blocks[b_ix, h_ix, sel]
        s_sel = jnp.einsum("bhcd,bhcnkd->bhcnk", qc, k_sel).astype(jnp.float32) * scale
        s_sel = jnp.where(sel_valid[:, None], s_sel, -jnp.inf)
        s_sel = s_sel.reshape(b, h, MOBA_Q_CHUNK, n_sel * MOBA_BLOCK)
        k_own = lax.dynamic_slice_in_dim(kp, own * MOBA_BLOCK, MOBA_BLOCK, axis=2)
        v_own = lax.dynamic_slice_in_dim(vp, own * MOBA_BLOCK, MOBA_BLOCK, axis=2)
        s_own = jnp.einsum("bhcd,bhkd->bhck", qc, k_own).astype(jnp.float32) * scale
        own_pos = own * MOBA_BLOCK + jnp.arange(MOBA_BLOCK)
        s_own = jnp.where(own_pos[None, :] <= q_pos[:, None], s_own, -jnp.inf)
        p = jax.nn.softmax(jnp.concatenate([s_sel, s_own], axis=-1), axis=-1)
        p_sel = p[..., :n_sel * MOBA_BLOCK].reshape(b, h, MOBA_Q_CHUNK, n_sel, MOBA_BLOCK)
        p_own = p[..., n_sel * MOBA_BLOCK:]
        return (jnp.einsum("bhcnk,bhcnkd->bhcd", p_sel.astype(v.dtype), v_sel)
                + jnp.einsum("bhck,bhkd->bhcd", p_own.astype(v.dtype), v_own))

    return sweep_queries(chunk, seq, MOBA_Q_CHUNK)


def mla_attention(c_q, c_kv, k_rope, cq_norm, ckv_norm, w_uq, w_ukv, q_norm, k_norm, cos, sin):
    b, s, _ = c_q.shape
    q = (rms_norm(c_q, cq_norm) @ w_uq).reshape(b, s, GROUP_HEADS, MLA_QK_DIM)
    kv = (rms_norm(c_kv, ckv_norm) @ w_ukv).reshape(b, s, GROUP_HEADS, MLA_NOPE_DIM + MLA_V_DIM)
    k_nope, v = jnp.split(kv, [MLA_NOPE_DIM], axis=-1)
    k_r = jnp.broadcast_to(k_rope[:, :, None, :], (b, s, GROUP_HEADS, MLA_ROPE_DIM))
    k = jnp.concatenate([k_nope, k_r], axis=-1)
    q = rms_norm(q, q_norm).transpose(0, 2, 1, 3)
    k = rms_norm(k, k_norm).transpose(0, 2, 1, 3)
    q = jnp.concatenate([q[..., :MLA_NOPE_DIM], apply_rope(q[..., MLA_NOPE_DIM:], cos, sin)], axis=-1)
    k = jnp.concatenate([k[..., :MLA_NOPE_DIM], apply_rope(k[..., MLA_NOPE_DIM:], cos, sin)], axis=-1)
    return causal_softmax_attention(q, k, v.transpose(0, 2, 1, 3))


def causal_depthwise_conv(u, w, bias):
    seq = u.shape[1]
    up = jnp.pad(u, ((0, 0), (CONV_WIDTH - 1, 0), (0, 0)))
    out = bias.astype(u.dtype) + up[:, 0:seq] * w[0]
    for j in range(1, CONV_WIDTH):
        out = out + up[:, j:j + seq] * w[j]
    return out


def mixer_sublayer(x, rope_c, rope_r, attn_norm, w_in, b_forget, fox_q_norm, fox_k_norm,
                   moba_q_norm, moba_k_norm, mla_cq_norm, mla_ckv_norm, w_uq, w_ukv,
                   mla_q_norm, mla_k_norm, mix_out_norm, w_out):
    b, s, _ = x.shape
    h = rms_norm(x, attn_norm)
    proj = h @ w_in
    offsets = np.cumsum(IN_WIDTHS)[:-1].tolist()
    (a_q, a_k, a_v, a_f, b_q, b_k, b_v, c_q, c_k, c_v,
     d_cq, d_ckv, d_kr) = jnp.split(proj, offsets, axis=-1)

    log_f = jax.nn.log_sigmoid((a_f + b_forget).astype(jnp.float32))
    cum_log_f = jnp.cumsum(log_f, axis=1).transpose(0, 2, 1)
    qa = rms_norm(to_heads(a_q, GROUP_HEADS), fox_q_norm)
    ka = rms_norm(to_heads(a_k, GROUP_HEADS), fox_k_norm)
    o_a = causal_softmax_attention(qa, ka, to_heads(a_v, GROUP_HEADS), cum_log_f)

    o_b = stick_breaking_attention(to_heads(b_q, GROUP_HEADS), to_heads(b_k, GROUP_HEADS),
                                   to_heads(b_v, GROUP_HEADS))

    cos_c, sin_c = rope_c
    qc = apply_rope(rms_norm(to_heads(c_q, GROUP_HEADS), moba_q_norm), cos_c, sin_c)
    kc = apply_rope(rms_norm(to_heads(c_k, GROUP_HEADS), moba_k_norm), cos_c, sin_c)
    o_c = moba_attention(qc, kc, to_heads(c_v, GROUP_HEADS))

    cos_r, sin_r = rope_r
    o_d = mla_attention(d_cq, d_ckv, d_kr, mla_cq_norm, mla_ckv_norm, w_uq, w_ukv,
                        mla_q_norm, mla_k_norm, cos_r, sin_r)

    y = jnp.stack([from_heads(o_a), from_heads(o_b), from_heads(o_c), from_heads(o_d)], axis=2)
    y = rms_norm(y, mix_out_norm.reshape(N_GROUPS, GROUP_WIDTH))
    return x + y.reshape(b, s, MIX_WIDTH) @ w_out


def ffn_sublayer(x, ffn_norm, w_up, conv_w, conv_b, w_down):
    h = rms_norm(x, ffn_norm)
    u = causal_depthwise_conv(h @ w_up, conv_w, conv_b)
    gate, val = jnp.split(u, 2, axis=-1)
    return x + (jax.nn.silu(gate) * val) @ w_down


def setup_inputs(seed: int = 0) -> dict:
    key = jax.random.key(seed)
    ks = jax.random.split(key, 21)
    f32 = jnp.float32

    def normal(k, shape, scale):
        return jax.random.normal(k, shape, f32) * scale

    def gain(k, shape):
        return 1.0 + 0.02 * jax.random.normal(k, shape, f32)

    out_scale = (2 * DEPTH) ** -0.5
    return {
        "x": normal(ks[0], (BATCH, SEQ, D_MODEL), 1.0),
        "attn_norm": gain(ks[1], (DEPTH, D_MODEL)),
        "w_in": normal(ks[2], (DEPTH, D_MODEL, IN_WIDTH), D_MODEL ** -0.5),
        "b_forget": jax.random.uniform(ks[3], (DEPTH, GROUP_HEADS), f32, FORGET_BIAS_LO, FORGET_BIAS_HI),
        "fox_q_norm": gain(ks[4], (DEPTH, HEAD_DIM)),
        "fox_k_norm": gain(ks[5], (DEPTH, HEAD_DIM)),
        "moba_q_norm": gain(ks[6], (DEPTH, HEAD_DIM)),
        "moba_k_norm": gain(ks[7], (DEPTH, HEAD_DIM)),
        "mla_cq_norm": gain(ks[8], (DEPTH, MLA_Q_RANK)),
        "mla_ckv_norm": gain(ks[9], (DEPTH, MLA_KV_RANK)),
        "w_uq": normal(ks[10], (DEPTH, MLA_Q_RANK, GROUP_HEADS * MLA_QK_DIM), MLA_Q_RANK ** -0.5),
        "w_ukv": normal(ks[11], (DEPTH, MLA_KV_RANK, GROUP_HEADS * (MLA_NOPE_DIM + MLA_V_DIM)), MLA_KV_RANK ** -0.5),
        "mla_q_norm": gain(ks[12], (DEPTH, MLA_QK_DIM)),
        "mla_k_norm": gain(ks[13], (DEPTH, MLA_QK_DIM)),
        "mix_out_norm": gain(ks[14], (DEPTH, MIX_WIDTH)),
        "w_out": normal(ks[15], (DEPTH, MIX_WIDTH, D_MODEL), MIX_WIDTH ** -0.5 * out_scale),
        "ffn_norm": gain(ks[16], (DEPTH, D_MODEL)),
        "w_up": normal(ks[17], (DEPTH, D_MODEL, 2 * D_FF), D_MODEL ** -0.5),
        "conv_w": normal(ks[18], (DEPTH, CONV_WIDTH, 2 * D_FF), CONV_WIDTH ** -0.5),
        "conv_b": normal(ks[19], (DEPTH, 2 * D_FF), 0.01),
        "w_down": normal(ks[20], (DEPTH, D_FF, D_MODEL), D_FF ** -0.5 * out_scale),
    }


def reference(x, attn_norm, w_in, b_forget, fox_q_norm, fox_k_norm, moba_q_norm, moba_k_norm,
              mla_cq_norm, mla_ckv_norm, w_uq, w_ukv, mla_q_norm, mla_k_norm, mix_out_norm,
              w_out, ffn_norm, w_up, conv_w, conv_b, w_down):
    seq = x.shape[1]
    rope_c = rope_angles(seq, HEAD_DIM)
    rope_r = rope_angles(seq, MLA_ROPE_DIM)
    for l in range(DEPTH):
        x = mixer_sublayer(x, rope_c, rope_r, attn_norm[l], w_in[l], b_forget[l],
                           fox_q_norm[l], fox_k_norm[l], moba_q_norm[l], moba_k_norm[l],
                           mla_cq_norm[l], mla_ckv_norm[l], w_uq[l], w_ukv[l],
                           mla_q_norm[l], mla_k_norm[l], mix_out_norm[l], w_out[l])
        x = ffn_sublayer(x, ffn_norm[l], w_up[l], conv_w[l], conv_b[l], w_down[l])
    return x
```

```cpp
#include <hip/hip_runtime.h>
#include <cstdio>
#include <cstdint>

#define GAS __attribute__((address_space(1)))
#define LAS __attribute__((address_space(3)))
typedef unsigned short bf16;
typedef short bf16x8 __attribute__((ext_vector_type(8)));
typedef short s16x4 __attribute__((ext_vector_type(4)));
typedef float f32x2 __attribute__((ext_vector_type(2)));
typedef float f32x4 __attribute__((ext_vector_type(4)));
typedef float f32x16 __attribute__((ext_vector_type(16)));
typedef unsigned u32x2 __attribute__((ext_vector_type(2)));
typedef unsigned u32x4 __attribute__((ext_vector_type(4)));

constexpr int BATCH = 4, SEQ = 4096, DM = 2048, DEPTH = 4;
constexpr int M = BATCH * SEQ;
constexpr int HD = 128, GH = 4, GW = 512, MIXW = 2048;
constexpr int INW = 5444, INP = 5632;
constexpr int DFF = 5632, DFF2 = 11264;
constexpr int QRANK = 512, KVRANK = 256, QKD = 192;
constexpr float EPS = 1e-6f;
#ifndef FFN_FP8_ON
#define FFN_FP8_ON 1
#endif
constexpr bool FFN_FP8 = FFN_FP8_ON;
constexpr float WUP_SCALE = FFN_FP8 ? 64.f : 1.f, WDOWN_SCALE = FFN_FP8 ? 256.f : 1.f;
constexpr int C_AQ = 0, C_AK = 512, C_AV = 1024, C_BQ = 1536, C_BK = 2048, C_BV = 2560, C_CQ = 3072, C_CK = 3584, C_CV = 4096, C_DCQ = 4608, C_DCKV = 5120, C_DKR = 5376, C_AF = 5440;
__host__ __device__ __forceinline__ int inproj_src_col(int n) {
    if (n < 1536) return n;
    if (n < 5440) return n + 4;
    if (n < 5444) return 1536 + (n - 5440);
    return -1;
}

constexpr size_t MiB = 1u << 20;
constexpr size_t WS_CTL = 0, CTL_ZERO_BYTES = 5 * MiB;
constexpr size_t WS_SS = 1 * MiB;
constexpr size_t WS_SSG = 2 * MiB;
constexpr size_t WS_SSD = 4 * MiB;
constexpr size_t WS_COSC = 5 * MiB, WS_SINC = 6 * MiB;
constexpr size_t WS_COSR = 7 * MiB, WS_SINR = 7 * MiB + 512 * 1024;
constexpr size_t WS_LF = 8 * MiB;
constexpr size_t WS_CF = WS_LF + 256 * 1024;
constexpr size_t WS_KMS = WS_CF + 256 * 1024;
constexpr size_t WS_SEL = WS_KMS + 512 * 1024;
constexpr size_t WS_W = 10 * MiB;
constexpr size_t W_IN = 0, W_UQ = W_IN + (size_t)INP * DM * 2, W_UKV = W_UQ + (size_t)768 * 512 * 2, W_OUT = W_UKV + (size_t)1024 * 256 * 2,
                 W_UP = W_OUT + (size_t)DM * MIXW * 2, W_DOWN = W_UP + (size_t)DFF2 * DM * 2, W_LAYER = W_DOWN + (size_t)DM * DFF * 2;
static_assert(W_LAYER == (size_t)(22 * 1024 + 768 + 512 + 8 * 1024 + 44 * 1024 + 22 * 1024) * 1024, "weights per layer");
constexpr size_t WS_XS = 400 * MiB;
constexpr size_t WS_U = 464 * MiB;
constexpr size_t WS_PROJ = WS_U;
constexpr size_t WS_QDR = WS_PROJ + (size_t)M * INP * 2;
constexpr size_t WS_KVR = WS_QDR + (size_t)M * 768 * 2;
constexpr size_t WS_KD = WS_KVR + (size_t)M * 1024 * 2;
constexpr size_t WS_O = WS_KD + (size_t)M * 768 * 2;
constexpr size_t WS_ACT = WS_U + (size_t)M * DFF2 * 2;
constexpr size_t WS_X8 = WS_ACT + (size_t)M * DFF * 2;
constexpr size_t WS_END = WS_X8 + (size_t)M * DM * 2;
static_assert(WS_W + DEPTH * W_LAYER <= WS_XS && WS_O + (size_t)M * MIXW * 2 <= WS_ACT && WS_XS + (size_t)M * DM * 2 <= WS_U && WS_SEL + 256 * 1024 <= WS_W && WS_SS + (size_t)DEPTH * 2 * M * 8 <= WS_SSG && WS_SSG + (size_t)DEPTH * M * 4 * 8 <= WS_SSD && WS_SSD + (size_t)DEPTH * 2 * M * 8 <= CTL_ZERO_BYTES, "d_ws map");
constexpr int CW_BAR = 4096;
constexpr int CW_KMAX = 32768;
constexpr int CW_QUEUE = 16384;

constexpr int RING_BYTES = 131072;
constexpr int MISC_OFF = RING_BYTES + 320;
constexpr int LDS_BYTES = 147456;
constexpr int NWAVES = 8;

#define LDS_WAIT() asm volatile("s_waitcnt lgkmcnt(0)" ::: "memory")
#define VM_WAIT() asm volatile("s_waitcnt vmcnt(0)" ::: "memory")
#define SBAR() __builtin_amdgcn_sched_barrier(0)

__device__ __forceinline__ float bf2f(unsigned b) { return __uint_as_float(b << 16); }
__device__ __forceinline__ unsigned cvt_pk_bf16(float lo, float hi) { unsigned r; asm volatile("v_cvt_pk_bf16_f32 %0, %1, %2" : "=v"(r) : "v"(lo), "v"(hi)); return r; }
__device__ __forceinline__ void unpack8(u32x4 w, float (&v)[8]) {
#pragma unroll
    for (int i = 0; i < 4; ++i) { v[2 * i] = __uint_as_float(w[i] << 16); v[2 * i + 1] = __uint_as_float(w[i] & 0xffff0000u); }
}
__device__ __forceinline__ u32x4 pack8(const float (&v)[8]) { u32x4 w; w.x = cvt_pk_bf16(v[0], v[1]); w.y = cvt_pk_bf16(v[2], v[3]); w.z = cvt_pk_bf16(v[4], v[5]); w.w = cvt_pk_bf16(v[6], v[7]); return w; }
__device__ __forceinline__ float wave_sum(float v) {
#pragma unroll
    for (int o = 1; o < 64; o <<= 1) v += __shfl_xor(v, o);
    return v;
}
template <int CTRL> __device__ __forceinline__ float dppf(float v) { return __uint_as_float((unsigned)__builtin_amdgcn_update_dpp(0, (int)__float_as_uint(v), CTRL, 0xf, 0xf, true)); }
__device__ __forceinline__ float sum16(float v) {
    v += dppf<0xB1>(v); v += dppf<0x4E>(v); v += dppf<0x141>(v); v += dppf<0x140>(v);
    return v;
}
__device__ __forceinline__ float clamp448(float x) { return __builtin_amdgcn_fmed3f(x, -448.f, 448.f); }
__device__ __forceinline__ unsigned pack4_fp8(float a, float b, float c, float d) {
    unsigned w = 0; w = __builtin_amdgcn_cvt_pk_fp8_f32(clamp448(a), clamp448(b), w, false); w = __builtin_amdgcn_cvt_pk_fp8_f32(clamp448(c), clamp448(d), w, true); return w; }
__constant__ float INVF128[64] = {1.f, 0.865964353f, 0.749894261f, 0.649381638f, 0.562341332f, 0.486967534f, 0.421696514f, 0.365174115f, 0.316227764f, 0.273841977f, 0.237137377f, 0.2053525f, 0.177827939f, 0.153992653f, 0.133352131f, 0.115478203f, 0.100000001f, 0.0865964293f, 0.0749894157f, 0.0649381652f, 0.0562341325f, 0.0486967526f, 0.0421696529f, 0.0365174115f, 0.0316227749f, 0.0273841973f, 0.0237137377f, 0.0205352511f, 0.0177827943f, 0.0153992651f, 0.0133352149f, 0.0115478206f, 0.00999999978f, 0.00865964312f, 0.00749894185f, 0.00649381615f, 0.00562341325f, 0.00486967526f, 0.00421696482f, 0.00365174119f, 0.00316227763f, 0.00273841969f, 0.00237137359f, 0.00205352483f, 0.00177827943f, 0.00153992651f, 0.00133352145f, 0.0011547819f, 0.00100000005f, 0.000865964335f, 0.000749894243f, 0.000649381662f, 0.000562341302f, 0.000486967532f, 0.000421696517f, 0.000365174143f, 0.000316227757f, 0.000273841957f, 0.00023713737f, 0.00020535251f, 0.00017782794f, 0.000153992645f, 0.00013335215f, 0.0001154782f};

namespace pg8 {
#define PG8_LAS __attribute__((address_space(3)))
typedef unsigned short bf16_t;
typedef short bf16x8 __attribute__((ext_vector_type(8)));
typedef float f32x4 __attribute__((ext_vector_type(4)));
typedef unsigned u32x4 __attribute__((ext_vector_type(4)));
typedef int v8i __attribute__((ext_vector_type(8)));
typedef unsigned u32x8 __attribute__((ext_vector_type(8)));
constexpr int BM = 256, BK = 64, HALF = 128, HTB = HALF * BK * 2  , STAGE_BYTES = 8 * HTB, NXCD = 8, WGM = 4;

__host__ __device__ __forceinline__ int lds_byte(int r, int c) { const int st = (r >> 4) * 2 + (c >> 5), rr = r & 15, cc = c & 31, ob = rr * 64 + cc * 2; return st * 1024 + (ob ^ (((ob >> 9) & 1) << 5)); }
__host__ __device__ __forceinline__ void stage_rc(int b, int& R, int& C) { const int st = b / 1024, sb = b % 1024, swz = sb ^ (((sb >> 9) & 1) << 5); R = (st >> 1) * 16 + swz / 64; C = (st & 1) * 32 + (swz % 64) / 2; }
__host__ __device__ __forceinline__ int perm32(int rho) { const int n = rho >> 4, i = rho & 15; return 8 * (i >> 2) + 4 * n + (i & 3); }

struct Unit { int pm, pn; };
struct Gemm { const bf16_t* A; const bf16_t* Bt; int M, N, K, lda; const unsigned long long* ssg; };

struct StaticOrder {
    int nM, nN, nwg, G, c;
    __host__ __device__ void init(int M, int N, int G_, int c_) { nM = M / BM; nN = N / BM; nwg = nM * nN; G = G_; c = c_; }
    __host__ __device__ bool next(int i, Unit& u) const {
        const long L = (long)i * G + c; if (L >= nwg) return false;
        int wgid = (int)L; { const int q = nwg / NXCD, r = nwg % NXCD, xcd = wgid % NXCD, off = wgid / NXCD; wgid = (xcd < r ? xcd * (q + 1) : r * (q + 1) + (xcd - r) * q) + off; }
        const int nig = WGM * nN, gid = wgid / nig, fm = gid * WGM, gsz = (nM - fm) < WGM ? (nM - fm) : WGM;
        u.pm = fm + ((wgid % nig) % gsz); u.pn = (wgid % nig) / gsz; return true;
    }
    __device__ __forceinline__ void a_ready(const Unit&) const {}
    __device__ __forceinline__ void done(const Unit&) const {}
};

__device__ __forceinline__ unsigned cvt_pk_bf16(float lo, float hi) { unsigned r; asm volatile("v_cvt_pk_bf16_f32 %0, %1, %2" : "=v"(r) : "v"(lo), "v"(hi)); return r; }
struct EpiBf16 {
    static constexpr bool PERM = true, AFTER_DRAIN = false;
    bf16_t* O; int ldc; float sc; const unsigned long long* ss; float inv_n;
    unsigned long long* st_a; unsigned long long* st_b; int pn_a0, pn_a1, pn_b;
    static constexpr bool PREFETCH_SS = true;
    __device__ __forceinline__ void operator()(const f32x4 (&acc)[2][2][4][2], const Unit& u, int wr, int wc, int fr, int fq, const unsigned long long (&pre)[8]) const {
        const int row0 = u.pm * BM + wr * 64 + fr, col0 = u.pn * BM + wc * 32 + 8 * fq;
        unsigned long long* st = nullptr; if (st_a) { if (u.pn >= pn_a0 && u.pn <= pn_a1) st = st_a; else if (u.pn == pn_b) st = st_b; }
#pragma unroll
        for (int ai = 0; ai < 2; ++ai)
#pragma unroll
            for (int m = 0; m < 4; ++m) { const int row = row0 + ai * HALF + m * 16; bf16_t* rowp = O + (size_t)row * ldc + col0; float ssq = 0.f;
                const float s = ss ? sc * rsqrtf((float)pre[ai * 4 + m] * (inv_n * (1.f / 16777216.f)) + 1e-6f) : sc;
#pragma unroll
                for (int bj = 0; bj < 2; ++bj) { const f32x4 v0 = acc[ai][bj][m][0] * s, v1 = acc[ai][bj][m][1] * s;
                    if (st) ssq += (v0[0] * v0[0] + v0[1] * v0[1]) + (v0[2] * v0[2] + v0[3] * v0[3]) + (v1[0] * v1[0] + v1[1] * v1[1]) + (v1[2] * v1[2] + v1[3] * v1[3]);
                    u32x4 w; w.x = cvt_pk_bf16(v0[0], v0[1]); w.y = cvt_pk_bf16(v0[2], v0[3]); w.z = cvt_pk_bf16(v1[0], v1[1]); w.w = cvt_pk_bf16(v1[2], v1[3]);
                    *(u32x4*)(rowp + bj * HALF) = w; }
                if (st) { ssq += __shfl_xor(ssq, 16); ssq += __shfl_xor(ssq, 32); if (fq == 0) __hip_atomic_fetch_add(st + row, (unsigned long long)(ssq * 16777216.f), __ATOMIC_RELAXED, __HIP_MEMORY_SCOPE_AGENT); } }
    }
};
template <bool COPY_FP8>
struct EpiStream {
    static constexpr bool PERM = true, AFTER_DRAIN = false, PREFETCH_SS = false;
    bf16_t* XS; float* OUT32; void* X8; unsigned long long* ss; int ldc; float sc;
    __device__ __forceinline__ void operator()(const f32x4 (&acc)[2][2][4][2], const Unit& u, int wr, int wc, int fr, int fq, const unsigned long long (&)[8]) const {
        const int row0 = u.pm * BM + wr * 64 + fr, col0 = u.pn * BM + wc * 32 + 8 * fq;
#pragma unroll
        for (int ai = 0; ai < 2; ++ai) {
            u32x4 xall[4][2];
#pragma unroll
            for (int m = 0; m < 4; ++m)
#pragma unroll
                for (int bj = 0; bj < 2; ++bj) xall[m][bj] = *(const u32x4*)(XS + (size_t)(row0 + ai * HALF + m * 16) * ldc + col0 + bj * HALF);
#pragma unroll
            for (int m = 0; m < 4; ++m) { const int row = row0 + ai * HALF + m * 16; const size_t ro = (size_t)row * ldc + col0; float ssq = 0.f;
#pragma unroll
                for (int bj = 0; bj < 2; ++bj) { const u32x4 xw = xall[m][bj];
                    f32x4 v0 = acc[ai][bj][m][0] * sc, v1 = acc[ai][bj][m][1] * sc;
                    v0[0] += __uint_as_float(xw[0] << 16); v0[1] += __uint_as_float(xw[0] & 0xffff0000u); v0[2] += __uint_as_float(xw[1] << 16); v0[3] += __uint_as_float(xw[1] & 0xffff0000u);
                    v1[0] += __uint_as_float(xw[2] << 16); v1[1] += __uint_as_float(xw[2] & 0xffff0000u); v1[2] += __uint_as_float(xw[3] << 16); v1[3] += __uint_as_float(xw[3] & 0xffff0000u);
                    ssq += (v0[0] * v0[0] + v0[1] * v0[1]) + (v0[2] * v0[2] + v0[3] * v0[3]) + (v1[0] * v1[0] + v1[1] * v1[1]) + (v1[2] * v1[2] + v1[3] * v1[3]);
                    if (OUT32) { *(f32x4*)(OUT32 + ro + bj * HALF) = v0; *(f32x4*)(OUT32 + ro + bj * HALF + 4) = v1; }
                    else { u32x4 w; w.x = cvt_pk_bf16(v0[0], v0[1]); w.y = cvt_pk_bf16(v0[2], v0[3]); w.z = cvt_pk_bf16(v1[0], v1[1]); w.w = cvt_pk_bf16(v1[2], v1[3]); *(u32x4*)(XS + ro + bj * HALF) = w; }
                    if (X8) { if constexpr (COPY_FP8) { u32x2 w; w.x = pack4_fp8(v0[0], v0[1], v0[2], v0[3]); w.y = pack4_fp8(v1[0], v1[1], v1[2], v1[3]); *(u32x2*)((unsigned char*)X8 + ro + bj * HALF) = w; }
                              else { u32x4 w; w.x = cvt_pk_bf16(v0[0], v0[1]); w.y = cvt_pk_bf16(v0[2], v0[3]); w.z = cvt_pk_bf16(v1[0], v1[1]); w.w = cvt_pk_bf16(v1[2], v1[3]); *(u32x4*)((bf16_t*)X8 + ro + bj * HALF) = w; } } }
                if (ss) { ssq += __shfl_xor(ssq, 16); ssq += __shfl_xor(ssq, 32); if (fq == 0) __hip_atomic_fetch_add(ss + row, (unsigned long long)(ssq * 16777216.f), __ATOMIC_RELAXED, __HIP_MEMORY_SCOPE_AGENT); } } }
    }
};

template <class Epi, class Sched, bool ALIGN_EPI = false, bool SP2 = false, bool FP8 = false, bool GS = false>
__device__ __forceinline__ void gemm_phase(PG8_LAS unsigned char* lds, const Gemm g, const Sched& S, const Epi& E) {
    int tid_ = threadIdx.x; asm volatile("" : "+v"(tid_));
    const int tid = tid_, wid = __builtin_amdgcn_readfirstlane(tid >> 6), lane = tid & 63, wr = wid >> 2, wc = wid & 3, fr = lane & 15, fq = lane >> 4;
    const int K = g.K, nt = K / BK;
    unsigned voffA[2], voffB[2];
#pragma unroll
    for (int i = 0; i < 2; ++i) { int R, C; stage_rc(tid * 16 + i * 8192, R, C); const int Rb = Epi::PERM ? ((R & ~31) + perm32(R & 31)) : R;
        voffA[i] = (unsigned)(R * g.lda + C) * 2u; voffB[i] = (unsigned)(Rb * K + C) * 2u; }
    const size_t kstep = (size_t)(BK * 2);
    const size_t hstepA = (size_t)HALF * g.lda * 2, hstepB = (size_t)HALF * K * 2;
    const size_t tstepA = 2 * hstepA, tstepB = 2 * hstepB;
    const unsigned ldsw = (unsigned)wid * 1024u;
    const int aoff = lds_byte(wr * 64 + fr, fq * 8), boff = lds_byte(wc * 32 + fr, fq * 8);
#define PG8_SA(b, h) (((b) * 2 + (h)) * HTB)
#define PG8_SB(b, h) ((4 + (b) * 2 + (h)) * HTB)
#define PG8_STAGE(bufoff, gbase, voff) do { _Pragma("unroll") for (int _i = 0; _i < 2; ++_i) \
        __builtin_amdgcn_global_load_lds((const unsigned*)((const char*)(gbase) + (voff)[_i]), (PG8_LAS unsigned*)(lds + (bufoff) + ldsw + _i * 8192), 16, 0, 0); } while (0)
#define PG8_LD2(dst, addr) do { const u32x4 lo_ = *(const PG8_LAS u32x4*)(addr), hi_ = *(const PG8_LAS u32x4*)((addr) + 1024); dst = __builtin_shufflevector(lo_, hi_, 0, 1, 2, 3, 4, 5, 6, 7); } while (0)
#define PG8_LDA(dst, b, h) do { _Pragma("unroll") for (int m = 0; m < 4; ++m) PG8_LD2(dst[m], lds + PG8_SA(b, h) + aoff + m * 2048); } while (0)
#define PG8_LDB(dst, b, h) do { _Pragma("unroll") for (int n = 0; n < 2; ++n) PG8_LD2(dst[n], lds + PG8_SB(b, h) + boff + n * 2048); } while (0)
#define PG8_HALF(X, k) __builtin_bit_cast(bf16x8, __builtin_shufflevector(X, X, 4 * (k), 4 * (k) + 1, 4 * (k) + 2, 4 * (k) + 3))
#define PG8_MMA(ai, bj, At, Bt) do { __builtin_amdgcn_s_setprio(1); \
        if constexpr (FP8) { _Pragma("unroll") for (int m = 0; m < 4; ++m) _Pragma("unroll") for (int n = 0; n < 2; ++n) \
            asm volatile("v_mfma_scale_f32_16x16x128_f8f6f4 %0, %1, %2, %0, %3, %3 op_sel_hi:[0,0,0]" : "+v"(acc[ai][bj][m][n]) : "v"(Bt[n]), "v"(At[m]), "v"(one_scale)); } \
        else { _Pragma("unroll") for (int m = 0; m < 4; ++m) _Pragma("unroll") for (int n = 0; n < 2; ++n) { \
            acc[ai][bj][m][n] = __builtin_amdgcn_mfma_f32_16x16x32_bf16(PG8_HALF(Bt[n], 0), PG8_HALF(At[m], 0), acc[ai][bj][m][n], 0, 0, 0); \
            acc[ai][bj][m][n] = __builtin_amdgcn_mfma_f32_16x16x32_bf16(PG8_HALF(Bt[n], 1), PG8_HALF(At[m], 1), acc[ai][bj][m][n], 0, 0, 0); } } \
        __builtin_amdgcn_s_setprio(0); } while (0)
#define PG8_WAIT_V(n) asm volatile("s_waitcnt vmcnt(" #n ")" ::: "memory")
#define PG8_WAIT_L(n) asm volatile("s_waitcnt lgkmcnt(" #n ")" ::: "memory")
#define PG8_BAR __builtin_amdgcn_s_barrier()
#define PG8_SCHED __builtin_amdgcn_sched_barrier(0)
    Unit cur, nxt; int ui = 0;
    if (!S.next(0, cur)) return;
    PG8_LAS unsigned char* const gs_lds = lds + STAGE_BYTES + 1024;
#define PG8_GS_TABLE(u_, buf_) do { if constexpr (GS) { if (tid < 256) { const unsigned long long* sp_ = g.ssg + ((size_t)(u_).pm * BM + tid) * 4; float r_[4]; \
        _Pragma("unroll") for (int q_ = 0; q_ < 4; ++q_) r_[q_] = rsqrtf((float)__hip_atomic_load(sp_ + q_, __ATOMIC_RELAXED, __HIP_MEMORY_SCOPE_AGENT) * (1.f / 16777216.f / 512.f) + 1e-6f); \
        *(PG8_LAS f32x4*)(gs_lds + (buf_) * 4096 + tid * 16) = (f32x4){r_[0] / r_[1], r_[1] / r_[2], r_[2] / r_[3], r_[3]}; } } } while (0)
#define PG8_GS_SCALE(buf_, col_) do { _Pragma("unroll") for (int ai_ = 0; ai_ < 2; ++ai_) _Pragma("unroll") for (int m_ = 0; m_ < 4; ++m_) { \
        const float f_ = *(const PG8_LAS float*)(gs_lds + (buf_) * 4096 + (wr * 64 + fr + ai_ * HALF + m_ * 16) * 16 + (col_) * 4); \
        _Pragma("unroll") for (int bj_ = 0; bj_ < 2; ++bj_) _Pragma("unroll") for (int n_ = 0; n_ < 2; ++n_) acc[ai_][bj_][m_][n_] = acc[ai_][bj_][m_][n_] * f_; } } while (0)
    f32x4 acc[2][2][4][2];
#pragma unroll
    for (int a = 0; a < 2; ++a)
#pragma unroll
        for (int b = 0; b < 2; ++b)
#pragma unroll
            for (int m = 0; m < 4; ++m)
#pragma unroll
                for (int n = 0; n < 2; ++n) acc[a][b][m][n] = (f32x4){0.f, 0.f, 0.f, 0.f};
    unsigned one_scale = 0x7f7f7f7fu; asm volatile("" : "+v"(one_scale));
    unsigned long long pre[8] = {0, 0, 0, 0, 0, 0, 0, 0};
    u32x8 At[4], B0[2], B1[2];
    const char* cA = (const char*)g.A + (size_t)cur.pm * tstepA; const char* cB = (const char*)g.Bt + (size_t)cur.pn * tstepB;
    S.a_ready(cur); PG8_GS_TABLE(cur, 0);
    if constexpr (SP2) {
        PG8_STAGE(PG8_SB(0, 0), cB, voffB); PG8_STAGE(PG8_SB(0, 1), cB + hstepB, voffB); PG8_STAGE(PG8_SA(0, 0), cA, voffA); PG8_STAGE(PG8_SA(0, 1), cA + hstepA, voffA);
        if (wr == 1) PG8_BAR;
        PG8_WAIT_V(2); PG8_BAR;
        PG8_STAGE(PG8_SB(1, 0), cB + kstep, voffB); PG8_STAGE(PG8_SA(1, 0), cA + kstep, voffA); PG8_STAGE(PG8_SB(1, 1), cB + hstepB + kstep, voffB);
        PG8_WAIT_V(6); PG8_BAR;
    } else {
        PG8_STAGE(PG8_SB(0, 0), cB, voffB); PG8_STAGE(PG8_SA(0, 0), cA, voffA); PG8_STAGE(PG8_SB(0, 1), cB + hstepB, voffB); PG8_STAGE(PG8_SA(0, 1), cA + hstepA, voffA);
        if (wr == 1) PG8_BAR;
        PG8_WAIT_V(4); PG8_BAR;
        PG8_STAGE(PG8_SB(1, 0), cB + kstep, voffB); PG8_STAGE(PG8_SA(1, 0), cA + kstep, voffA); PG8_STAGE(PG8_SB(1, 1), cB + hstepB + kstep, voffB);
        PG8_WAIT_V(6); PG8_BAR;
    }
    for (;;) {
        const bool has_next = S.next(ui + 1, nxt);
        const char* nA = has_next ? (const char*)g.A + (size_t)nxt.pm * tstepA : cA; const char* nB = has_next ? (const char*)g.Bt + (size_t)nxt.pn * tstepB : cB;
        for (int t = 0; t < nt; t += 2) {
            const bool last = (t == nt - 2);
            const char* a1 = cA + (size_t)(t + 1) * kstep;
            const char* a2 = last ? nA : cA + (size_t)(t + 2) * kstep; const char* b2 = last ? nB : cB + (size_t)(t + 2) * kstep;
            const char* a3 = a2 + kstep; const char* b3 = b2 + kstep;
            if (last && has_next) { S.a_ready(nxt); PG8_GS_TABLE(nxt, (ui + 1) & 1); }
            if constexpr (Epi::PREFETCH_SS) { if (last && E.ss) {
#pragma unroll
                for (int q_ = 0; q_ < 8; ++q_) pre[q_] = __hip_atomic_load(E.ss + cur.pm * BM + wr * 64 + fr + (q_ >> 2) * HALF + (q_ & 3) * 16, __ATOMIC_RELAXED, __HIP_MEMORY_SCOPE_AGENT); } }
            if constexpr (GS) { if (t == 8 || t == 16 || t == 24) PG8_GS_SCALE(ui & 1, (t >> 3) - 1); }
            if constexpr (SP2) {
            PG8_LDB(B0, 0, 0); PG8_LDB(B1, 0, 1); PG8_SCHED; PG8_LDA(At, 0, 0); PG8_STAGE(PG8_SA(1, 1), a1 + hstepA, voffA);
            PG8_WAIT_V(8); PG8_WAIT_L(0); PG8_BAR; PG8_MMA(0, 0, At, B0); PG8_MMA(0, 1, At, B1); PG8_BAR; PG8_SCHED;
            PG8_LDA(At, 0, 1); PG8_STAGE(PG8_SB(0, 0), b2, voffB); PG8_STAGE(PG8_SB(0, 1), b2 + hstepB, voffB); PG8_STAGE(PG8_SA(0, 0), a2, voffA);
            PG8_WAIT_V(8); PG8_WAIT_L(0); PG8_BAR; PG8_MMA(1, 0, At, B0); PG8_MMA(1, 1, At, B1); PG8_BAR; PG8_SCHED;
            PG8_LDB(B0, 1, 0); PG8_LDB(B1, 1, 1); PG8_SCHED; PG8_LDA(At, 1, 0); PG8_STAGE(PG8_SA(0, 1), a2 + hstepA, voffA);
            PG8_WAIT_V(8); PG8_WAIT_L(0); PG8_BAR; PG8_MMA(0, 0, At, B0); PG8_MMA(0, 1, At, B1); PG8_BAR; PG8_SCHED;
            PG8_LDA(At, 1, 1); PG8_STAGE(PG8_SB(1, 0), b3, voffB); PG8_STAGE(PG8_SB(1, 1), b3 + hstepB, voffB); PG8_STAGE(PG8_SA(1, 0), a3, voffA);
            PG8_WAIT_V(8); PG8_WAIT_L(0); PG8_BAR; PG8_MMA(1, 0, At, B0); PG8_MMA(1, 1, At, B1); PG8_BAR; PG8_SCHED;
            } else {
            PG8_LDB(B0, 0, 0); PG8_SCHED; PG8_LDA(At, 0, 0); PG8_STAGE(PG8_SA(1, 1), a1 + hstepA, voffA);
            PG8_WAIT_L(8); PG8_BAR; PG8_WAIT_L(0); PG8_MMA(0, 0, At, B0); PG8_BAR; PG8_SCHED;
            PG8_LDB(B1, 0, 1); PG8_STAGE(PG8_SB(0, 0), b2, voffB);
            PG8_BAR; PG8_WAIT_L(0); PG8_MMA(0, 1, At, B1); PG8_BAR;
            PG8_LDA(At, 0, 1); PG8_STAGE(PG8_SA(0, 0), a2, voffA);
            PG8_BAR; PG8_WAIT_L(0); PG8_MMA(1, 0, At, B0); PG8_BAR; PG8_SCHED;
            PG8_STAGE(PG8_SB(0, 1), b2 + hstepB, voffB);
            PG8_WAIT_V(6); PG8_BAR; PG8_MMA(1, 1, At, B1); PG8_BAR;
            PG8_LDB(B0, 1, 0); PG8_SCHED; PG8_LDA(At, 1, 0); PG8_STAGE(PG8_SA(0, 1), a2 + hstepA, voffA);
            PG8_WAIT_L(8); PG8_BAR; PG8_WAIT_L(0); PG8_MMA(0, 0, At, B0); PG8_BAR; PG8_SCHED;
            PG8_LDB(B1, 1, 1); PG8_STAGE(PG8_SB(1, 0), b3, voffB);
            PG8_BAR; PG8_WAIT_L(0); PG8_MMA(0, 1, At, B1); PG8_BAR;
            PG8_LDA(At, 1, 1); PG8_STAGE(PG8_SA(1, 0), a3, voffA);
            PG8_BAR; PG8_WAIT_L(0); PG8_MMA(1, 0, At, B0); PG8_BAR; PG8_SCHED;
            PG8_STAGE(PG8_SB(1, 1), b3 + hstepB, voffB);
            PG8_WAIT_V(6); PG8_BAR; PG8_MMA(1, 1, At, B1); PG8_BAR;
            }
        }
        if constexpr (ALIGN_EPI) { if (wr == 0) PG8_BAR; }
        if constexpr (FP8) asm volatile("s_nop 15\n\ts_nop 15" ::: "memory");
        if constexpr (GS) PG8_GS_SCALE(ui & 1, 3);
        if constexpr (!Epi::AFTER_DRAIN) { E(acc, cur, wr, wc, fr, fq, pre); S.done(cur); }
        if (!has_next) break;
#pragma unroll
        for (int a = 0; a < 2; ++a)
#pragma unroll
            for (int b = 0; b < 2; ++b)
#pragma unroll
                for (int m = 0; m < 4; ++m)
#pragma unroll
                    for (int n = 0; n < 2; ++n) acc[a][b][m][n] = (f32x4){0.f, 0.f, 0.f, 0.f};
        cur = nxt; cA = nA; cB = nB; ++ui;
        if constexpr (ALIGN_EPI) { if (wr == 1) PG8_BAR; }
    }
    PG8_WAIT_V(0);
    if constexpr (!ALIGN_EPI) { if (wr == 0) PG8_BAR; }
    PG8_BAR;
    if constexpr (Epi::AFTER_DRAIN) { E.fused(acc, cur, wr, wc, fr, fq, lds, wid, lane); S.done(cur); }
#undef PG8_GS_TABLE
#undef PG8_GS_SCALE
#undef PG8_SA
#undef PG8_SB
#undef PG8_STAGE
#undef PG8_LDA
#undef PG8_LDB
#undef PG8_MMA
#undef PG8_HALF
#undef PG8_LD2
#undef PG8_WAIT_V
#undef PG8_WAIT_L
#undef PG8_BAR
#undef PG8_SCHED
}
}
#define XB_TMO      128
#define XB_XCNT(j)  (256  + 64 * (j))
#define XB_XSUB(j)  (1280 + 64 * (j))
#define XB_XGEN(j)  (2304 + 64 * (j))
#define XB_TOP      3328
#define XB_TOPGEN   3392
#define XCD_BAR_WORDS 3456
#define XB_SPIN_CAP (1u << 20)

__device__ __forceinline__ unsigned xb_ld(unsigned* p)              { return __hip_atomic_load(p, __ATOMIC_RELAXED, __HIP_MEMORY_SCOPE_AGENT); }
__device__ __forceinline__ unsigned xb_add(unsigned* p, unsigned v) { return __hip_atomic_fetch_add(p, v, __ATOMIC_RELAXED, __HIP_MEMORY_SCOPE_AGENT); }
__device__ __forceinline__ unsigned xb_xcc_id() { return (unsigned)__builtin_amdgcn_s_getreg((3 << 11) | 20) & 0xFu; }
#define XB_SPIN(cond, bar) do { unsigned _sp = 0; while (cond) { __builtin_amdgcn_s_sleep(1); \
    if ((++_sp & 255u) == 0u) { if (xb_ld(&(bar)[XB_TMO])) break; if (_sp > XB_SPIN_CAP) { atomicAdd(&(bar)[XB_TMO], 1u); break; } } } } while (0)

struct XcdBarrier {
    unsigned* bar; unsigned x;
    volatile LAS unsigned* st;
};

__device__ __forceinline__ XcdBarrier xcd_barrier_post(unsigned* bar, volatile LAS unsigned* st) {
    XcdBarrier b; b.bar = bar; b.x = xb_xcc_id(); b.st = st;
    if (threadIdx.x == 0) (void)xb_add(&bar[XB_XCNT(b.x)], 1u);
    return b;
}
__device__ __forceinline__ void xcd_barrier_complete(unsigned* bar, unsigned x, unsigned& nloc, unsigned& nx) {
    const unsigned G = gridDim.x * gridDim.y * gridDim.z;
    unsigned sum, cnt, mine, sp = 0u;
    for (;;) {
        sum = 0u; cnt = 0u; mine = 0u;
#pragma unroll
        for (unsigned j = 0; j < 16; ++j) { const unsigned c = xb_ld(&bar[XB_XCNT(j)]); sum += c; cnt += (c > 0u) ? 1u : 0u; mine = (j == x) ? c : mine; }
        if (sum == G) break;
        __builtin_amdgcn_s_sleep(1);
        if ((++sp & 255u) == 0u) { if (xb_ld(&bar[XB_TMO])) break; if (sp > XB_SPIN_CAP) { atomicAdd(&bar[XB_TMO], 1u); break; } }
    }
    nloc = mine > 0u ? mine : 1u; nx = cnt > 0u ? cnt : 1u;
}

__device__ __forceinline__ void xcd_barrier(const XcdBarrier& b) {
    asm volatile("s_waitcnt vmcnt(0)" ::: "memory");
    __syncthreads();
    if (threadIdx.x == 0) {
        unsigned* bar = b.bar;
        __builtin_amdgcn_s_waitcnt(0);
        unsigned nloc = b.st[0], nx = b.st[1];
        if (nloc == 0u) { xcd_barrier_complete(bar, b.x, nloc, nx); b.st[0] = nloc; b.st[1] = nx; }
        const unsigned old = xb_add(&bar[XB_XSUB(b.x)], 1u);
        const unsigned gen = old / nloc;
        if (old + 1u == (gen + 1u) * nloc) {
            __builtin_amdgcn_fence(__ATOMIC_RELEASE, "agent");
            asm volatile("s_waitcnt vmcnt(0)" ::: "memory");
            const unsigned og = xb_add(&bar[XB_TOP], 1u);
            const unsigned tg = og / nx;
            if (og + 1u == (tg + 1u) * nx) xb_add(&bar[XB_TOPGEN], 1u);
            else XB_SPIN(xb_ld(&bar[XB_TOPGEN]) == tg, bar);
            __builtin_amdgcn_fence(__ATOMIC_ACQUIRE, "agent");
            xb_add(&bar[XB_XGEN(b.x)], 1u);
            asm volatile("s_waitcnt vmcnt(0)" ::: "memory");
        } else {
            XB_SPIN(xb_ld(&bar[XB_XGEN(b.x)]) == gen, bar);
            __builtin_amdgcn_fence(__ATOMIC_ACQUIRE, "agent");
            asm volatile("s_waitcnt vmcnt(0)" ::: "memory");
        }
    }
    __syncthreads();
}

struct WG { int tid, lane, wave, vcu, G; LAS unsigned char* lds; };

template <int MAP, bool F8>
__device__ __forceinline__ void transpose_item(const float* W, int K, int ldw, int Npad, void* WT, LAS unsigned char* scr, int item, int lane, float wscale, const float* kgain) {
    const int nblk = Npad / 128, kb = item / nblk, nb = item % nblk, k0 = 64 * kb, n0 = 128 * nb;
    const int r = lane >> 5, c4 = lane & 31;
    int sc = n0 + 4 * c4; if (MAP == 1) sc = inproj_src_col(sc);
    constexpr int EB = F8 ? 1 : 2;
    constexpr int ROWB = 64 * EB, NCH = ROWB / 16;
#pragma unroll
    for (int hb = 0; hb < 2; ++hb) {
        f32x4 v[16];
#pragma unroll
        for (int i = 0; i < 16; ++i) { const int k = k0 + 32 * r + 16 * hb + i;
            v[i] = (sc >= 0) ? *(const f32x4*)(W + (size_t)k * ldw + sc) : (f32x4){0.f, 0.f, 0.f, 0.f}; }
        if (kgain) {
#pragma unroll
            for (int i = 0; i < 16; ++i) v[i] = v[i] * kgain[k0 + 32 * r + 16 * hb + i]; }
#pragma unroll
        for (int j = 0; j < 4; ++j) { const int n = 4 * c4 + j;
            if constexpr (F8) { u32x4 w;
                w.x = pack4_fp8(v[0][j] * wscale, v[1][j] * wscale, v[2][j] * wscale, v[3][j] * wscale); w.y = pack4_fp8(v[4][j] * wscale, v[5][j] * wscale, v[6][j] * wscale, v[7][j] * wscale);
                w.z = pack4_fp8(v[8][j] * wscale, v[9][j] * wscale, v[10][j] * wscale, v[11][j] * wscale); w.w = pack4_fp8(v[12][j] * wscale, v[13][j] * wscale, v[14][j] * wscale, v[15][j] * wscale);
                *(LAS u32x4*)(scr + n * ROWB + ((((2 * r + hb)) ^ ((n >> 2) & (NCH - 1))) << 4)) = w; }
            else { u32x4 w0, w1;
                w0.x = cvt_pk_bf16(v[0][j], v[1][j]); w0.y = cvt_pk_bf16(v[2][j], v[3][j]); w0.z = cvt_pk_bf16(v[4][j], v[5][j]); w0.w = cvt_pk_bf16(v[6][j], v[7][j]);
                w1.x = cvt_pk_bf16(v[8][j], v[9][j]); w1.y = cvt_pk_bf16(v[10][j], v[11][j]); w1.z = cvt_pk_bf16(v[12][j], v[13][j]); w1.w = cvt_pk_bf16(v[14][j], v[15][j]);
                *(LAS u32x4*)(scr + n * ROWB + (((4 * r + 2 * hb) ^ ((n >> 2) & (NCH - 1))) << 4)) = w0;
                *(LAS u32x4*)(scr + n * ROWB + (((4 * r + 2 * hb + 1) ^ ((n >> 2) & (NCH - 1))) << 4)) = w1; } }
    }
    LDS_WAIT();
#pragma unroll
    for (int t = 0; t < 2 * NCH; ++t) { const int n = lane / NCH + (64 / NCH) * t, c = lane % NCH;
        const u32x4 w = *(const LAS u32x4*)(scr + n * ROWB + ((c ^ ((n >> 2) & (NCH - 1))) << 4));
        *(u32x4*)((unsigned char*)WT + ((size_t)(n0 + n) * K + k0) * EB + c * 16) = w; }
    LDS_WAIT();
}
struct LayerW { const float *w_in, *w_uq, *w_ukv, *w_out, *w_up, *w_down; };
constexpr int CONV_ITEMS = (DM / 64) * (INP / 128) + (QRANK / 64) * (768 / 128) + (KVRANK / 64) * (1024 / 128) + (MIXW / 64) * (DM / 128) + (DM / 64) * (DFF2 / 128) + (DFF / 64) * (DM / 128);
constexpr int CONV_SPLIT = 3456;
__device__ __forceinline__ void convert_item(const WG& g, const float* const* in, unsigned char* ws, int l, int it) {
    LAS unsigned char* scr = g.lds + g.wave * 16384;
    constexpr int I_IN = (DM / 64) * (INP / 128), I_UQ = (QRANK / 64) * (768 / 128), I_UKV = (KVRANK / 64) * (1024 / 128), I_OUT = (MIXW / 64) * (DM / 128),
                  I_UP = (DM / 64) * (DFF2 / 128), I_DOWN = (DFF / 64) * (DM / 128), I_LAYER = I_IN + I_UQ + I_UKV + I_OUT + I_UP + I_DOWN;
    static_assert(I_LAYER == CONV_ITEMS, "item count");
    unsigned char* wl = ws + WS_W + (size_t)l * W_LAYER;
    int r = it;
    if (r < I_IN) { transpose_item<1, false>(in[2] + (size_t)l * DM * INW, DM, INW, INP, wl + W_IN, scr, r, g.lane, 1.f, in[1] + (size_t)l * DM); return; } r -= I_IN;
    if (r < I_UQ) { transpose_item<0, false>(in[10] + (size_t)l * QRANK * 768, QRANK, 768, 768, wl + W_UQ, scr, r, g.lane, 1.f, in[8] + (size_t)l * QRANK); return; } r -= I_UQ;
    if (r < I_UKV) { transpose_item<0, false>(in[11] + (size_t)l * KVRANK * 1024, KVRANK, 1024, 1024, wl + W_UKV, scr, r, g.lane, 1.f, in[9] + (size_t)l * KVRANK); return; } r -= I_UKV;
    if (r < I_OUT) { transpose_item<0, false>(in[15] + (size_t)l * MIXW * DM, MIXW, DM, DM, wl + W_OUT, scr, r, g.lane, 1.f, in[14] + (size_t)l * MIXW); return; } r -= I_OUT;
    if (r < I_UP) { transpose_item<0, FFN_FP8>(in[17] + (size_t)l * DM * DFF2, DM, DFF2, DFF2, wl + W_UP, scr, r, g.lane, WUP_SCALE, in[16] + (size_t)l * DM); return; } r -= I_UP;
    transpose_item<0, FFN_FP8>(in[20] + (size_t)l * DFF * DM, DFF, DM, DM, wl + W_DOWN, scr, r, g.lane, WDOWN_SCALE, nullptr);
}
__device__ __forceinline__ void convert_layer(const WG& g, const float* const* in, unsigned char* ws, int l, int widx, int nw, int it0 = 0, int it1 = CONV_ITEMS) {
    for (int it = it0 + widx; it < it1; it += nw) convert_item(g, in, ws, l, it);
}
__device__ __forceinline__ void prologue_phase(const WG& g, const float* const* in, unsigned char* ws) {
    convert_layer(g, in, ws, 0, g.vcu * NWAVES + g.wave, g.G * NWAVES);
    float* cosC = (float*)(ws + WS_COSC); float* sinC = (float*)(ws + WS_SINC); float* cosR = (float*)(ws + WS_COSR); float* sinR = (float*)(ws + WS_SINR);
    for (int idx = (g.vcu * NWAVES + g.wave) * 64 + g.lane; idx < SEQ * 96; idx += g.G * NWAVES * 64) {
        const bool isC = idx < SEQ * 64; const int j = isC ? idx : idx - SEQ * 64;
        const int pos = isC ? (j >> 6) : (j >> 5), i = isC ? (j & 63) : (j & 31);
        const float ang = (float)pos * (isC ? INVF128[i] : INVF128[2 * i]);
        double rev = (double)ang * 0.15915494309189535; rev -= __builtin_rint(rev);
        const float fr = (float)rev, c = __builtin_amdgcn_cosf(fr), s = __builtin_amdgcn_sinf(fr);
        if (isC) { cosC[j] = c; sinC[j] = s; } else { cosR[j] = c; sinR[j] = s; }
    }
}

__device__ __forceinline__ void stream_init_phase(const WG& g, const float* x, bf16* XS, unsigned long long* SS) {
    const int gw = g.vcu * NWAVES + g.wave, NGW = g.G * NWAVES;
    for (int m = gw; m < M; m += NGW) {
        const f32x4* xr = (const f32x4*)(x + (size_t)m * DM) + g.lane;
        f32x4 v[8]; float s = 0.f;
#pragma unroll
        for (int j = 0; j < 8; ++j) { v[j] = xr[64 * j]; s += (v[j].x * v[j].x + v[j].y * v[j].y) + (v[j].z * v[j].z + v[j].w * v[j].w); }
        s = wave_sum(s);
        if (g.lane == 0) SS[m] = (unsigned long long)(s * 16777216.f);
        u32x2* o8 = (u32x2*)(XS + (size_t)m * DM) + g.lane;
#pragma unroll
        for (int j = 0; j < 8; ++j) { u32x2 w; w.x = cvt_pk_bf16(v[j].x, v[j].y); w.y = cvt_pk_bf16(v[j].z, v[j].w); o8[64 * j] = w; }
    }
}

__device__ __forceinline__ float log_sigmoid_f(float x) { return fminf(x, 0.f) - log1pf(expf(-fabsf(x))); }

__device__ __forceinline__ void head_norm128(const bf16* p, const float* gain, int hl, int li, float (&v)[8]) {
    unpack8(*(const u32x4*)(p + hl * 128 + li * 8), v);
    float ss = 0.f;
#pragma unroll
    for (int j = 0; j < 8; ++j) ss += v[j] * v[j];
    const float rstd = rsqrtf(sum16(ss) * (1.f / 128) + EPS);
    const f32x4 g0 = *(const f32x4*)(gain + li * 8), g1 = *(const f32x4*)(gain + li * 8 + 4);
#pragma unroll
    for (int j = 0; j < 4; ++j) { v[j] = v[j] * rstd * g0[j]; v[4 + j] = v[4 + j] * rstd * g1[j]; }
}
template <int NV>
__device__ __forceinline__ void rope_group(float (&v)[NV], const float* cs, const float* sn, int li) {
#pragma unroll
    for (int j = 0; j < NV; ++j) { const float pv = dppf<0x128>(v[j]); const float c = cs[j], s = sn[j];
        v[j] = (li < 8) ? (v[j] * c - pv * s) : (pv * s + v[j] * c); }
}

struct Prep { bf16* PROJ; bf16* OUT; bf16* QDR; bf16* QOUT; const bf16* KVR; bf16* KD; const float *fox_q, *fox_k, *moba_q, *moba_k, *q_g, *k_g, *b_forget; float* LF; float* KMS;
              const float *cosC, *sinC, *cosR, *sinR; unsigned* KMAX; };
__device__ __forceinline__ void mla_norm_rope(float (&n8)[8], float (&r4)[4], const float* gain, const float* cosR, const float* sinR, int pos, int li) {
    float ss = 0.f;
#pragma unroll
    for (int j = 0; j < 8; ++j) ss += n8[j] * n8[j];
#pragma unroll
    for (int j = 0; j < 4; ++j) ss += r4[j] * r4[j];
    const float rstd = rsqrtf(sum16(ss) * (1.f / QKD) + EPS);
    const f32x4 g0 = *(const f32x4*)(gain + li * 8), g1 = *(const f32x4*)(gain + li * 8 + 4), g2 = *(const f32x4*)(gain + 128 + li * 4);
#pragma unroll
    for (int j = 0; j < 4; ++j) { n8[j] = n8[j] * rstd * g0[j]; n8[4 + j] = n8[4 + j] * rstd * g1[j]; r4[j] = r4[j] * rstd * g2[j]; }
    const f32x4 c = *(const f32x4*)(cosR + pos * 32 + (li & 7) * 4), s = *(const f32x4*)(sinR + pos * 32 + (li & 7) * 4);
    float cs[4] = {c[0], c[1], c[2], c[3]}, sn[4] = {s[0], s[1], s[2], s[3]};
    rope_group<4>(r4, cs, sn, li);
}
struct PrepRaw { u32x4 aq, ak, cq, ck, qn, kn; u32x2 qr, kr; unsigned fw; f32x4 cc0, cc1, sc0, sc1, cr, sr; };
__device__ __forceinline__ PrepRaw prep_load(const Prep& P, int m, int hl, int li, int lane) {
    PrepRaw r; const bf16* row = P.PROJ + (size_t)m * INP; const int pos = m & (SEQ - 1);
    r.aq = *(const u32x4*)(row + C_AQ + hl * 128 + li * 8); r.ak = *(const u32x4*)(row + C_AK + hl * 128 + li * 8);
    r.cq = *(const u32x4*)(row + C_CQ + hl * 128 + li * 8); r.ck = *(const u32x4*)(row + C_CK + hl * 128 + li * 8);
    const bf16* qp = P.QDR + (size_t)m * 768 + hl * 192; r.qn = *(const u32x4*)(qp + li * 8); r.qr = *(const u32x2*)(qp + 128 + li * 4);
    r.kn = *(const u32x4*)(P.KVR + (size_t)m * 1024 + hl * 256 + li * 8); r.kr = *(const u32x2*)(row + C_DKR + li * 4);
    r.fw = (lane < 4) ? (unsigned)row[C_AF + lane] : 0u;
    const float* cp = P.cosC + pos * 64 + (li & 7) * 8; const float* sp = P.sinC + pos * 64 + (li & 7) * 8;
    r.cc0 = *(const f32x4*)cp; r.cc1 = *(const f32x4*)(cp + 4); r.sc0 = *(const f32x4*)sp; r.sc1 = *(const f32x4*)(sp + 4);
    r.cr = *(const f32x4*)(P.cosR + pos * 32 + (li & 7) * 4); r.sr = *(const f32x4*)(P.sinR + pos * 32 + (li & 7) * 4);
    return r;
}
__device__ __forceinline__ void norm128(u32x4 raw, const float (&gn)[8], float (&v)[8]) {
    unpack8(raw, v); float ss = 0.f;
#pragma unroll
    for (int j = 0; j < 8; ++j) ss += v[j] * v[j];
    const float rstd = rsqrtf(sum16(ss) * (1.f / 128) + EPS);
#pragma unroll
    for (int j = 0; j < 8; ++j) v[j] = v[j] * rstd * gn[j];
}
__device__ __forceinline__ void mla192(u32x4 rawn, u32x2 rawr, const float (&gn)[8], const float (&gr)[4], f32x4 c, f32x4 s, int li, float (&n8)[8], float (&r4)[4]) {
    unpack8(rawn, n8);
    r4[0] = __uint_as_float(rawr.x << 16); r4[1] = __uint_as_float(rawr.x & 0xffff0000u); r4[2] = __uint_as_float(rawr.y << 16); r4[3] = __uint_as_float(rawr.y & 0xffff0000u);
    float ss = 0.f;
#pragma unroll
    for (int j = 0; j < 8; ++j) ss += n8[j] * n8[j];
#pragma unroll
    for (int j = 0; j < 4; ++j) ss += r4[j] * r4[j];
    const float rstd = rsqrtf(sum16(ss) * (1.f / QKD) + EPS);
#pragma unroll
    for (int j = 0; j < 8; ++j) n8[j] = n8[j] * rstd * gn[j];
#pragma unroll
    for (int j = 0; j < 4; ++j) r4[j] = r4[j] * rstd * gr[j];
    float cs[4] = {c[0], c[1], c[2], c[3]}, sn[4] = {s[0], s[1], s[2], s[3]};
    rope_group<4>(r4, cs, sn, li);
}
__device__ __forceinline__ void prep_phase(const WG& g, const Prep& P) {
    LAS float* kacc = (LAS float*)g.lds;
    const int hl = g.lane >> 4, li = g.lane & 15;
    float gfq[8], gfk[8], gmq[8], gmk[8], gqn[8], gkn[8], gqr[4], gkr[4];
#pragma unroll
    for (int j = 0; j < 8; ++j) { gfq[j] = P.fox_q[li * 8 + j]; gfk[j] = P.fox_k[li * 8 + j]; gmq[j] = P.moba_q[li * 8 + j]; gmk[j] = P.moba_k[li * 8 + j]; gqn[j] = P.q_g[li * 8 + j]; gkn[j] = P.k_g[li * 8 + j]; }
#pragma unroll
    for (int j = 0; j < 4; ++j) { gqr[j] = P.q_g[128 + li * 4 + j]; gkr[j] = P.k_g[128 + li * 4 + j]; }
    const float bfg = (g.lane < 4) ? P.b_forget[g.lane] : 0.f;
    for (int chunk = g.vcu; chunk < M / 64; chunk += g.G) {
        float ksum[8]; float kmx = 0.f;
#pragma unroll
        for (int j = 0; j < 8; ++j) ksum[j] = 0.f;
        const int mb = chunk * 64 + g.wave * 8;
        PrepRaw raw = prep_load(P, mb, hl, li, g.lane);
        for (int rr = 0; rr < 8; ++rr) {
            const int m = mb + rr;
            PrepRaw nxt = raw; if (rr < 7) nxt = prep_load(P, m + 1, hl, li, g.lane);
            bf16* orow = P.OUT + (size_t)m * INP;
            float v[8];
            norm128(raw.aq, gfq, v); *(u32x4*)(orow + C_AQ + hl * 128 + li * 8) = pack8(v);
            norm128(raw.ak, gfk, v); *(u32x4*)(orow + C_AK + hl * 128 + li * 8) = pack8(v);
            { float kn2 = 0.f;
#pragma unroll
              for (int j = 0; j < 8; ++j) kn2 += v[j] * v[j];
              kmx = fmaxf(kmx, sum16(kn2)); }
            float cs[8], sn[8];
#pragma unroll
            for (int j = 0; j < 4; ++j) { cs[j] = raw.cc0[j]; cs[4 + j] = raw.cc1[j]; sn[j] = raw.sc0[j]; sn[4 + j] = raw.sc1[j]; }
            norm128(raw.cq, gmq, v); rope_group<8>(v, cs, sn, li); *(u32x4*)(orow + C_CQ + hl * 128 + li * 8) = pack8(v);
            norm128(raw.ck, gmk, v); rope_group<8>(v, cs, sn, li); *(u32x4*)(orow + C_CK + hl * 128 + li * 8) = pack8(v);
#pragma unroll
            for (int j = 0; j < 8; ++j) ksum[j] += v[j];
            { float n8[8], r4[4];
              mla192(raw.qn, raw.qr, gqn, gqr, raw.cr, raw.sr, li, n8, r4);
              bf16* qo = P.QOUT + (size_t)m * 768 + hl * 192;
              *(u32x4*)(qo + li * 8) = pack8(n8); u32x2 o; o.x = cvt_pk_bf16(r4[0], r4[1]); o.y = cvt_pk_bf16(r4[2], r4[3]); *(u32x2*)(qo + 128 + li * 4) = o; }
            { float n8[8], r4[4];
              mla192(raw.kn, raw.kr, gkn, gkr, raw.cr, raw.sr, li, n8, r4);
              bf16* kp = P.KD + (size_t)m * 768 + hl * 192;
              *(u32x4*)(kp + li * 8) = pack8(n8); u32x2 o; o.x = cvt_pk_bf16(r4[0], r4[1]); o.y = cvt_pk_bf16(r4[2], r4[3]); *(u32x2*)(kp + 128 + li * 4) = o; }
            if (g.lane < 4) P.LF[(size_t)m * 4 + g.lane] = log_sigmoid_f(bf2f(raw.fw) + bfg);
            raw = nxt;
        }
#pragma unroll
        for (int j = 0; j < 8; ++j) kacc[g.wave * 512 + hl * 128 + li * 8 + j] = ksum[j];
        if (li == 0) kacc[4096 + g.wave * 4 + hl] = kmx;
        __syncthreads();
        if (g.tid < 4) { float t = kacc[4096 + g.tid];
#pragma unroll
            for (int w = 1; w < 8; ++w) t = fmaxf(t, kacc[4096 + w * 4 + g.tid]);
            __hip_atomic_fetch_max(P.KMAX + ((chunk >> 6) * 4 + g.tid) * 16, __float_as_uint(t), __ATOMIC_RELAXED, __HIP_MEMORY_SCOPE_AGENT); }
        { float t = 0.f;
#pragma unroll
          for (int w = 0; w < 8; ++w) t += kacc[w * 512 + g.tid];
          P.KMS[(size_t)chunk * 512 + g.tid] = t; }
        __syncthreads();
    }
}

__device__ __forceinline__ void groupnorm_phase(const WG& g, bf16* O, const float* gain, bf16* OUT) {
    const int gw = g.vcu * NWAVES + g.wave, NGW = g.G * NWAVES;
    for (int m = gw; m < M; m += NGW) {
        bf16* row = O + (size_t)m * MIXW + g.lane * 8; bf16* orow = OUT + (size_t)m * MIXW + g.lane * 8;
#pragma unroll
        for (int grp = 0; grp < 4; ++grp) { float v[8]; unpack8(*(const u32x4*)(row + grp * GW), v); float ss = 0.f;
#pragma unroll
            for (int j = 0; j < 8; ++j) ss += v[j] * v[j];
            const float rstd = rsqrtf(wave_sum(ss) * (1.f / GW) + EPS);
            const f32x4 g0 = *(const f32x4*)(gain + grp * GW + g.lane * 8), g1 = *(const f32x4*)(gain + grp * GW + g.lane * 8 + 4);
#pragma unroll
            for (int j = 0; j < 4; ++j) { v[j] = v[j] * rstd * g0[j]; v[4 + j] = v[4 + j] * rstd * g1[j]; }
            *(u32x4*)(orow + grp * GW) = pack8(v); }
    }
}

__device__ __forceinline__ void convgate_phase(const WG& g, const bf16* U, const float* cw, const float* cb, bf16* ACT) {
    const int gw = g.vcu * NWAVES + g.wave, NGW = g.G * NWAVES;
    for (int u = gw; u < (M / 32) * 11; u += NGW) {
        const int cblk = u % 11, rc = u / 11, m0 = rc * 32, c0 = cblk * 512 + g.lane * 8;
        float w0[16], w1[16], w2[16], bb[16];
#pragma unroll
        for (int half = 0; half < 2; ++half) { const int c = c0 + half * DFF;
#pragma unroll
            for (int q = 0; q < 2; ++q) { const f32x4 a = *(const f32x4*)(cw + c + 4 * q), b = *(const f32x4*)(cw + DFF2 + c + 4 * q), d = *(const f32x4*)(cw + 2 * DFF2 + c + 4 * q), e = *(const f32x4*)(cb + c + 4 * q);
#pragma unroll
                for (int j = 0; j < 4; ++j) { w0[half * 8 + q * 4 + j] = a[j]; w1[half * 8 + q * 4 + j] = b[j]; w2[half * 8 + q * 4 + j] = d[j]; bb[half * 8 + q * 4 + j] = e[j]; } } }
        float p2[16], p1[16];
        if ((m0 & (SEQ - 1)) == 0) {
#pragma unroll
            for (int j = 0; j < 16; ++j) { p2[j] = 0.f; p1[j] = 0.f; }
        } else {
            float t[8];
            unpack8(*(const u32x4*)(U + (size_t)(m0 - 2) * DFF2 + c0), t);
#pragma unroll
            for (int j = 0; j < 8; ++j) p2[j] = t[j];
            unpack8(*(const u32x4*)(U + (size_t)(m0 - 2) * DFF2 + DFF + c0), t);
#pragma unroll
            for (int j = 0; j < 8; ++j) p2[8 + j] = t[j];
            unpack8(*(const u32x4*)(U + (size_t)(m0 - 1) * DFF2 + c0), t);
#pragma unroll
            for (int j = 0; j < 8; ++j) p1[j] = t[j];
            unpack8(*(const u32x4*)(U + (size_t)(m0 - 1) * DFF2 + DFF + c0), t);
#pragma unroll
            for (int j = 0; j < 8; ++j) p1[8 + j] = t[j];
        }
        for (int r0 = 0; r0 < 32; r0 += 8) {
            u32x4 gl[8], vl[8];
#pragma unroll
            for (int q = 0; q < 8; ++q) { gl[q] = *(const u32x4*)(U + (size_t)(m0 + r0 + q) * DFF2 + c0); vl[q] = *(const u32x4*)(U + (size_t)(m0 + r0 + q) * DFF2 + DFF + c0); }
#pragma unroll
            for (int q = 0; q < 8; ++q) {
                float cur[16], t[8];
                unpack8(gl[q], t);
#pragma unroll
                for (int j = 0; j < 8; ++j) cur[j] = t[j];
                unpack8(vl[q], t);
#pragma unroll
                for (int j = 0; j < 8; ++j) cur[8 + j] = t[j];
                float o[8];
#pragma unroll
                for (int j = 0; j < 8; ++j) {
                    const float gt = bb[j] + w0[j] * p2[j] + w1[j] * p1[j] + w2[j] * cur[j];
                    const float vl_ = bb[8 + j] + w0[8 + j] * p2[8 + j] + w1[8 + j] * p1[8 + j] + w2[8 + j] * cur[8 + j];
                    o[j] = gt * __builtin_amdgcn_rcpf(1.f + __builtin_amdgcn_exp2f(gt * -1.4426950408889634f)) * vl_;
                }
                if constexpr (FFN_FP8) { u32x2 w; w.x = pack4_fp8(o[0], o[1], o[2], o[3]); w.y = pack4_fp8(o[4], o[5], o[6], o[7]); *(u32x2*)((unsigned char*)ACT + (size_t)(m0 + r0 + q) * DFF + c0) = w; }
                else *(u32x4*)(ACT + (size_t)(m0 + r0 + q) * DFF + c0) = pack8(o);
#pragma unroll
                for (int j = 0; j < 16; ++j) { p2[j] = p1[j]; p1[j] = cur[j]; }
            }
        }
    }
}

namespace att {
enum { T_FOX = 0, T_STICK = 1, T_MOBA = 2, T_MLA = 3 };
constexpr int KVB = 64, SHM_K = 16384, SHM_V = 16384, SHM_KR = 8192;
constexpr int OFF_K = 0, OFF_V = 32768, OFF_KR = 65536, OFF_WS = 82432, OFF_MISC = 84480, OFF_AUX = 86016;
#define KSWZ(row, colB) ((row) * 256 + ((colB) ^ (((row) & 7) << 4)))
__device__ __forceinline__ int v_st(int k, int c) { const int kk = (k & ~0xC) | ((k & 4) << 1) | ((k & 8) >> 1); return ((kk >> 3) * 4 + (c >> 5)) * 512 + ((kk & 7) * 32 + (c & 31)) * 2; }
__device__ __forceinline__ int v_rd_base(int lane) { return ((lane & 3) << 3) | (((lane >> 2) & 3) << 6) | (((lane >> 4) & 1) << 5) | (((lane >> 5) & 1) << 8); }
constexpr int v_rd_off(int d0, int ks, int half) { return d0 * 512 + ks * 4096 + half * 2048; }
__device__ __forceinline__ int crow(int r, int hi) { return (r & 3) + 8 * (r >> 2) + 4 * hi; }

__device__ __forceinline__ void pack_p(const f32x16& p0, const f32x16& p1, bf16x8& pa0, bf16x8& pa1, bf16x8& pa2, bf16x8& pa3) {
#define PK4(P, B_, OUT) do { unsigned a0 = cvt_pk_bf16(P[B_+0], P[B_+1]), a1 = cvt_pk_bf16(P[B_+2], P[B_+3]);                          \
        unsigned b0 = cvt_pk_bf16(P[B_+4], P[B_+5]), b1 = cvt_pk_bf16(P[B_+6], P[B_+7]);                                             \
        auto r0 = __builtin_amdgcn_permlane32_swap(a0, b0, false, false); auto r1 = __builtin_amdgcn_permlane32_swap(a1, b1, false, false); \
        u32x4 w = {r0[0], r1[0], r0[1], r1[1]}; OUT = *reinterpret_cast<bf16x8*>(&w); } while (0)
    PK4(p0, 0, pa0); PK4(p0, 8, pa1); PK4(p1, 0, pa2); PK4(p1, 8, pa3);
#undef PK4
}
__device__ __forceinline__ void softmax_tile(f32x16& p0, f32x16& p1, float& m_reg, float& l_reg, float& alpha, const float SCALE, const float C2) {
    float pmax = p0[0];
#pragma unroll
    for (int r = 1; r < 16; ++r) pmax = fmaxf(pmax, p0[r]);
#pragma unroll
    for (int r = 0; r < 16; ++r) pmax = fmaxf(pmax, p1[r]);
    { auto rr = __builtin_amdgcn_permlane32_swap(__float_as_uint(pmax), __float_as_uint(pmax), false, false);
      pmax = fmaxf(__uint_as_float(rr[0]), __uint_as_float(rr[1])); }
    float mn;
    if (__builtin_expect(__all((pmax - m_reg) * SCALE <= 8.f), 1)) { mn = m_reg; alpha = 1.f; }
    else { mn = fmaxf(m_reg, pmax); alpha = __builtin_amdgcn_exp2f((m_reg - mn) * C2); m_reg = mn; }
    const float mnL = -mn * C2;
#pragma unroll
    for (int r = 0; r < 16; ++r) { p0[r] = __builtin_amdgcn_exp2f(fmaf(p0[r], C2, mnL)); p1[r] = __builtin_amdgcn_exp2f(fmaf(p1[r], C2, mnL)); }
    float ps = 0.f;
#pragma unroll
    for (int r = 0; r < 16; ++r) ps += p0[r];
#pragma unroll
    for (int r = 0; r < 16; ++r) ps += p1[r];
    { auto rr = __builtin_amdgcn_permlane32_swap(__float_as_uint(ps), __float_as_uint(ps), false, false);
      ps = __uint_as_float(rr[0]) + __uint_as_float(rr[1]); }
    l_reg = l_reg * alpha + ps;
}
__device__ __forceinline__ void pv_tile(f32x16* o, int vb0, bf16x8 pa0, bf16x8 pa1, bf16x8 pa2, bf16x8 pa3) {
#define TRRD(dst, off) asm volatile("ds_read_b64_tr_b16 %0, %1 offset:%2" : "=&v"(dst) : "v"(vb0), "i"(off) : "memory")
#define PV_D0(d0) do { s16x4 l0, l1, l2, l3, h0, h1, h2, h3; constexpr int b_ = v_rd_off(d0, 0, 0);   \
        TRRD(l0, b_); TRRD(h0, b_ + 2048); TRRD(l1, b_ + 4096); TRRD(h1, b_ + 6144); TRRD(l2, b_ + 8192); TRRD(h2, b_ + 10240); TRRD(l3, b_ + 12288); TRRD(h3, b_ + 14336); \
        asm volatile("s_waitcnt lgkmcnt(0)" ::: "memory"); SBAR();   \
        o[d0] = __builtin_amdgcn_mfma_f32_32x32x16_bf16(pa0, (bf16x8){l0[0], l0[1], l0[2], l0[3], h0[0], h0[1], h0[2], h0[3]}, o[d0], 0, 0, 0);   \
        o[d0] = __builtin_amdgcn_mfma_f32_32x32x16_bf16(pa1, (bf16x8){l1[0], l1[1], l1[2], l1[3], h1[0], h1[1], h1[2], h1[3]}, o[d0], 0, 0, 0);   \
        o[d0] = __builtin_amdgcn_mfma_f32_32x32x16_bf16(pa2, (bf16x8){l2[0], l2[1], l2[2], l2[3], h2[0], h2[1], h2[2], h2[3]}, o[d0], 0, 0, 0);   \
        o[d0] = __builtin_amdgcn_mfma_f32_32x32x16_bf16(pa3, (bf16x8){l3[0], l3[1], l3[2], l3[3], h3[0], h3[1], h3[2], h3[3]}, o[d0], 0, 0, 0); } while (0)
    PV_D0(0); PV_D0(1); PV_D0(2); PV_D0(3);
#undef PV_D0
#undef TRRD
}

__device__ __forceinline__ int moba_k0(unsigned um, int i) { unsigned mm = um; for (int j = 0; j < (i >> 2); ++j) mm &= mm - 1; return (__ffs(mm) - 1) * 256 + (i & 3) * 64; }
struct Tensors {
    const bf16* Q; const bf16* K; const bf16* V; int ldq, ldk, ldv;
    int qh, kh, vh, grp;
    bf16* O;
    const float* LF; const float* KMS; const unsigned* KMAX; unsigned long long* SSG;
};

template <int TYPE>
__device__ __forceinline__ void attn_item(const Tensors& T, int b, int h, int qb, LAS unsigned char* lds, unsigned ldsb) {
    constexpr bool FOX = TYPE == T_FOX, STICK = TYPE == T_STICK, MOBA = TYPE == T_MOBA, MLA = TYPE == T_MLA;
    constexpr int NKS = MLA ? 12 : 8;
    const float SCALE = MLA ? 0.07216878364870322f : 0.08838834764831845f;
    const float C2 = SCALE * 1.4426950408889634f;
    int tid_ = threadIdx.x; asm volatile("" : "+v"(tid_));
    const int tid = tid_, wid = __builtin_amdgcn_readfirstlane(tid >> 6), lane = tid & 63, r32 = lane & 31, hi = lane >> 5;
    const int qlo = qb * 256 + wid * 32, qpos = qlo + r32;
    const size_t tok0 = (size_t)b * SEQ;
    LAS unsigned* misc = (LAS unsigned*)(lds + OFF_MISC);
    LAS float* wsf = (LAS float*)(lds + OFF_WS) + wid * 64; LAS float* li_l = wsf; LAS float* al_l = wsf + 32;
    bf16x8 qr[NKS];
    { const bf16* qp = T.Q + (tok0 + qpos) * T.ldq + h * T.qh + hi * 8;
#pragma unroll
      for (int d0 = 0; d0 < NKS; ++d0) qr[d0] = *(const bf16x8*)(qp + d0 * 16); }
    const bf16* Kp = T.K + tok0 * T.ldk + h * T.kh; const bf16* Vp = T.V + tok0 * T.ldv + h * T.vh;
    unsigned um = 0, selmask = 0; int NT = 4 * (qb + 1);
    if constexpr (MOBA) {
        { LAS float* KM = (LAS float*)(lds + OFF_AUX);
          for (int idx = tid; idx < qb * 128; idx += NWAVES * 64) { const int n = idx >> 7, d = idx & 127;
              const float* s = T.KMS + ((size_t)(b * 64 + 4 * n) * 4 + h) * 128 + d;
              KM[idx] = ((s[0] + s[512]) + (s[1024] + s[1536])) * (1.f / 256); }
          __syncthreads();
          float gate[15];
#pragma unroll
          for (int n = 0; n < 15; ++n) { gate[n] = -__builtin_inff();
              if (n < qb) { float a = 0.f;
#pragma unroll
                  for (int d0 = 0; d0 < 8; ++d0) { const f32x4 ka = *(const LAS f32x4*)(KM + n * 128 + d0 * 16 + hi * 8), kb = *(const LAS f32x4*)(KM + n * 128 + d0 * 16 + hi * 8 + 4);
                      const u32x4 w = __builtin_bit_cast(u32x4, qr[d0]);
                      a = fmaf(__uint_as_float(w[0] << 16), ka[0], a); a = fmaf(__uint_as_float(w[0] & 0xffff0000u), ka[1], a);
                      a = fmaf(__uint_as_float(w[1] << 16), ka[2], a); a = fmaf(__uint_as_float(w[1] & 0xffff0000u), ka[3], a);
                      a = fmaf(__uint_as_float(w[2] << 16), kb[0], a); a = fmaf(__uint_as_float(w[2] & 0xffff0000u), kb[1], a);
                      a = fmaf(__uint_as_float(w[3] << 16), kb[2], a); a = fmaf(__uint_as_float(w[3] & 0xffff0000u), kb[3], a); }
                  gate[n] = a + __shfl_xor(a, 32); } }
#pragma unroll
          for (int pass = 0; pass < 3; ++pass) { float best = -__builtin_inff(); int bi = -1;
#pragma unroll
              for (int n = 0; n < 15; ++n) { if (n < qb && !((selmask >> n) & 1u) && gate[n] > best) { best = gate[n]; bi = n; } }
              if (bi >= 0) selmask |= 1u << bi; } }
        unsigned w = selmask;
#pragma unroll
        for (int o = 1; o < 64; o <<= 1) w |= __shfl_xor(w, o);
        if (lane == 0) __hip_atomic_fetch_or(&misc[1], w, __ATOMIC_RELAXED, __HIP_MEMORY_SCOPE_WORKGROUP);
        __syncthreads();
        um = misc[1] | (1u << qb); NT = 4 * __popc(um);
    }
#define tile_k0(i_) ((STICK || FOX) ? 64 * (NT - 1 - (i_)) : MOBA ? moba_k0(um, (i_)) : 64 * (i_))
    const int sr = tid >> 4, sc = (tid & 15) * 8, kws = KSWZ(sr, sc * 2), vst0 = v_st(sr, sc), vst1 = v_st(32 + sr, sc);
    const int krr = tid >> 3, krc = tid & 7, krw = krr * 128 + ((krc ^ ((krr >> 1) & 7)) << 4);
    bf16x8 st_k0, st_k1, st_v0, st_v1, st_kr;
    LAS float* cfl = (LAS float*)(lds + OFF_AUX);
    if constexpr (FOX) { LAS double* dsum = (LAS double*)(lds + OFF_AUX + 16384);
        const int nk = 256 * (qb + 1); double loc[8], run = 0.0;
        if (8 * tid < nk) {
#pragma unroll
            for (int j = 0; j < 8; ++j) { run += (double)T.LF[(tok0 + 8 * tid + j) * 4 + h]; loc[j] = run; } }
        double inc = run;
#pragma unroll
        for (int o = 1; o < 64; o <<= 1) { const double t = __shfl_up(inc, o); if (lane >= o) inc += t; }
        if (lane == 63) dsum[wid] = inc;
        __syncthreads();
        double off = inc - run;
        for (int w = 0; w < wid; ++w) off += dsum[w];
        if (8 * tid < nk) {
#pragma unroll
            for (int j = 0; j < 8; ++j) cfl[8 * tid + j] = (float)(off + loc[j]); }
        __syncthreads(); }
#define SLOAD(k0_) do { const int k0s = (k0_); const bf16* kp_ = Kp + (size_t)(k0s + sr) * T.ldk + sc; const bf16* vp_ = Vp + (size_t)(k0s + sr) * T.ldv + sc; \
        st_k0 = *(const bf16x8*)kp_; st_k1 = *(const bf16x8*)(kp_ + (size_t)32 * T.ldk); st_v0 = *(const bf16x8*)vp_; st_v1 = *(const bf16x8*)(vp_ + (size_t)32 * T.ldv); \
        if constexpr (MLA) st_kr = *(const bf16x8*)(Kp + (size_t)(k0s + krr) * T.ldk + 128 + krc * 8); \
        } while (0)
#define SWRITE(bf) do { *(LAS bf16x8*)(lds + OFF_K + (bf) * SHM_K + kws) = st_k0; *(LAS bf16x8*)(lds + OFF_K + (bf) * SHM_K + kws + 32 * 256) = st_k1; \
        *(LAS bf16x8*)(lds + OFF_V + (bf) * SHM_V + vst0) = st_v0; *(LAS bf16x8*)(lds + OFF_V + (bf) * SHM_V + vst1) = st_v1; \
        if constexpr (MLA) *(LAS bf16x8*)(lds + OFF_KR + (bf) * SHM_KR + krw) = st_kr; \
        } while (0)
    const int vrd = v_rd_base(lane);
    const int kq0 = KSWZ(r32, (0 * 16 + hi * 8) * 2), kq1 = KSWZ(r32, (1 * 16 + hi * 8) * 2), kq2 = KSWZ(r32, (2 * 16 + hi * 8) * 2), kq3 = KSWZ(r32, (3 * 16 + hi * 8) * 2);
    float m_reg = -1e30f, l_reg = 0.f, Pst = 1.f; f32x16 o[4] = {};
    const float ci = FOX ? cfl[qpos] * 11.313708498984761f : 0.f;
    float bound_s = 0.f; bool wdone = false;
    if constexpr (FOX) { float ssq = 0.f;
#pragma unroll
        for (int d0 = 0; d0 < 8; ++d0) { const u32x4 w = __builtin_bit_cast(u32x4, qr[d0]);
#pragma unroll
            for (int e = 0; e < 4; ++e) { const float a0 = __uint_as_float(w[e] << 16), a1 = __uint_as_float(w[e] & 0xffff0000u); ssq += a0 * a0 + a1 * a1; } }
        ssq += __shfl_xor(ssq, 32);
        const float kmax2 = __uint_as_float(__hip_atomic_load(T.KMAX + (b * 4 + h) * 16, __ATOMIC_RELAXED, __HIP_MEMORY_SCOPE_AGENT));
        bound_s = sqrtf(ssq) * sqrtf(kmax2) * 1.02f; }
    SLOAD(tile_k0(0)); SWRITE(0);
    for (int i = 0; i < NT; ++i) {
        const int cur = i & 1, k0 = tile_k0(i);
        if (i + 1 < NT) SLOAD(tile_k0(i + 1));
        __syncthreads();
        if constexpr (STICK || FOX) { if (i > 0) { bool alld = true;
#pragma unroll
            for (int w = 0; w < 8; ++w) alld = alld && (misc[4 + ((i - 1) & 1) * 8 + w] != 0u);
            if (alld) break; } }
        bool act = k0 <= qlo;
        if constexpr (MOBA) { const int blk = k0 >> 8; if (blk != qb) act = __any((selmask >> blk) & 1u); }
        if constexpr (FOX) { if (wdone) act = false; }
        if (act) {
            f32x16 p0, p1;
            if constexpr (FOX) { const LAS float* bp = cfl + k0 + 4 * hi;
#pragma unroll
                for (int gq = 0; gq < 4; ++gq) { const f32x4 c0 = *(const LAS f32x4*)(bp + 8 * gq), c1 = *(const LAS f32x4*)(bp + 32 + 8 * gq);
#pragma unroll
                    for (int q = 0; q < 4; ++q) { p0[4 * gq + q] = fmaf(c0[q], -11.313708498984761f, ci); p1[4 * gq + q] = fmaf(c1[q], -11.313708498984761f, ci); } } }
            else { p0 = f32x16{}; p1 = f32x16{}; }
            { const LAS unsigned char* kb = lds + OFF_K + cur * SHM_K;
#pragma unroll
              for (int d0 = 0; d0 < 8; ++d0) { const int ko = ((d0 & 3) == 0 ? kq0 : (d0 & 3) == 1 ? kq1 : (d0 & 3) == 2 ? kq2 : kq3) + (d0 >> 2) * 128;
                const bf16x8 b0 = *(const LAS bf16x8*)(kb + ko), b1 = *(const LAS bf16x8*)(kb + ko + 32 * 256);
                p0 = __builtin_amdgcn_mfma_f32_32x32x16_bf16(b0, qr[d0], p0, 0, 0, 0);
                p1 = __builtin_amdgcn_mfma_f32_32x32x16_bf16(b1, qr[d0], p1, 0, 0, 0); } }
            if constexpr (MLA) { const LAS unsigned char* kb = lds + OFF_KR + cur * SHM_KR + r32 * 128; const int sw = (r32 >> 1) & 7;
#pragma unroll
              for (int dd = 0; dd < 4; ++dd) { const int ko = ((2 * dd + hi) ^ sw) << 4;
                const bf16x8 b0 = *(const LAS bf16x8*)(kb + ko), b1 = *(const LAS bf16x8*)(kb + ko + 32 * 128);
                p0 = __builtin_amdgcn_mfma_f32_32x32x16_bf16(b0, qr[8 + dd], p0, 0, 0, 0);
                p1 = __builtin_amdgcn_mfma_f32_32x32x16_bf16(b1, qr[8 + dd], p1, 0, 0, 0); } }
            bf16x8 pa0, pa1, pa2, pa3;
            if constexpr (!STICK) {
                const float NEG = -__builtin_inff();
                if constexpr (MOBA) { const int blk = k0 >> 8; if (blk != qb && !((selmask >> blk) & 1u)) {
#pragma unroll
                    for (int r = 0; r < 16; ++r) { p0[r] = NEG; p1[r] = NEG; } } }
                if (k0 + 63 > qlo) { const int dq = qpos - k0 - 4 * hi;
#pragma unroll
                    for (int r = 0; r < 16; ++r) { const int c = (r & 3) + 8 * (r >> 2); if (dq - c < 0) p0[r] = NEG; if (dq - c - 32 < 0) p1[r] = NEG; } }
                float alpha;
                softmax_tile(p0, p1, m_reg, l_reg, alpha, SCALE, C2);
                if constexpr (FOX) { const float ck0 = cfl[k0] * 11.313708498984761f;
                    wdone = __all((bound_s + ci - ck0 - m_reg) * SCALE < -30.f); }
                if (__any(alpha < 1.f)) { if (hi == 0) al_l[r32] = alpha; LDS_WAIT();
#pragma unroll
                    for (int d_ = 0; d_ < 4; ++d_)
#pragma unroll
                        for (int r = 0; r < 16; ++r) o[d_][r] *= al_l[crow(r, hi)];
                    LDS_WAIT(); }
                pack_p(p0, p1, pa0, pa1, pa2, pa3);
            } else {
                const bool needmask = k0 + 63 >= qlo; const int dq = qpos - k0 - 4 * hi;
                float Tg[8];
#pragma unroll
                for (int gq = 0; gq < 8; ++gq) {
                    float be[4], om[4];
#pragma unroll
                    for (int q = 0; q < 4; ++q) { const float s = gq < 4 ? p0[4 * gq + q] : p1[4 * (gq - 4) + q];
                        const float z2 = fminf(fmaxf(s * C2, -115.f), 115.f), e = __builtin_amdgcn_exp2f(z2);
                        float omq = __builtin_amdgcn_rcpf(1.f + e), beq = e * omq;
                        const int c = q + 8 * (gq & 3) + 32 * (gq >> 2);
                        if (needmask && !(c < dq)) { omq = 1.f; beq = 0.f; }
                        om[q] = omq; be[q] = beq; }
                    const float s2 = om[3], s1 = s2 * om[2], s0 = s1 * om[1];
                    Tg[gq] = s0 * om[0];
                    const float w0 = be[0] * s0, w1 = be[1] * s1, w2 = be[2] * s2, w3 = be[3];
                    if (gq < 4) { p0[4 * gq] = w0; p0[4 * gq + 1] = w1; p0[4 * gq + 2] = w2; p0[4 * gq + 3] = w3; }
                    else { p1[4 * (gq - 4)] = w0; p1[4 * (gq - 4) + 1] = w1; p1[4 * (gq - 4) + 2] = w2; p1[4 * (gq - 4) + 3] = w3; }
                }
                float S = Pst;
#pragma unroll
                for (int gq = 7; gq >= 0; --gq) {
                    const float oth = __shfl_xor(Tg[gq], 32);
                    const float E = hi ? S : S * oth;
                    S = S * (Tg[gq] * oth);
                    if (gq < 4) { p0[4 * gq] *= E; p0[4 * gq + 1] *= E; p0[4 * gq + 2] *= E; p0[4 * gq + 3] *= E; }
                    else { p1[4 * (gq - 4)] *= E; p1[4 * (gq - 4) + 1] *= E; p1[4 * (gq - 4) + 2] *= E; p1[4 * (gq - 4) + 3] *= E; }
                }
                Pst = S;
                pack_p(p0, p1, pa0, pa1, pa2, pa3);
            }
            pv_tile(o, (int)(ldsb + OFF_V + cur * SHM_V) + vrd, pa0, pa1, pa2, pa3);
        }
        if constexpr (STICK) { const bool dn = __all(Pst < 1e-30f); if (lane == 0) misc[4 + (i & 1) * 8 + wid] = dn ? 1u : 0u; }
        if constexpr (FOX) { if (lane == 0) misc[4 + (i & 1) * 8 + wid] = wdone ? 1u : 0u; }
        if (i + 1 < NT) SWRITE(cur ^ 1);
    }
    float rli[16];
    if constexpr (!STICK) { if (hi == 0) li_l[r32] = l_reg; LDS_WAIT();
#pragma unroll
        for (int r = 0; r < 16; ++r) rli[r] = __builtin_amdgcn_rcpf(li_l[crow(r, hi)]); }
    __syncthreads();
    LAS unsigned char* ost = lds + wid * 8192;
    float sq[16];
#pragma unroll
    for (int r = 0; r < 16; ++r) { const int orow = crow(r, hi); sq[r] = 0.f;
#pragma unroll
        for (int d0 = 0; d0 < 4; ++d0) { float v = o[d0][r]; if constexpr (!STICK) v *= rli[r];
            sq[r] += v * v;
            const float vn = __shfl_xor(v, 1);
            if ((r32 & 1) == 0) *(LAS unsigned*)(ost + orow * 256 + (d0 * 32 + r32) * 2) = cvt_pk_bf16(v, vn); } }
    LDS_WAIT();
    { bf16* Ow = T.O + (tok0 + qlo) * MIXW + h * HD;
#pragma unroll
      for (int k = 0; k < 8; ++k) { const int row = (lane >> 4) + 4 * k, ch = lane & 15;
          const u32x4 w = *(const LAS u32x4*)(ost + row * 256 + ch * 16);
          *(u32x4*)(Ow + (size_t)row * MIXW + ch * 8) = w; } }
#pragma unroll
    for (int r = 0; r < 16; ++r) {
#pragma unroll
        for (int s = 1; s < 32; s <<= 1) sq[r] += __shfl_xor(sq[r], s); }
    if (r32 == 0) {
#pragma unroll
        for (int r = 0; r < 16; ++r) __hip_atomic_fetch_add(T.SSG + (tok0 + qlo + crow(r, hi)) * 4 + T.grp, (unsigned long long)(sq[r] * 16777216.f), __ATOMIC_RELAXED, __HIP_MEMORY_SCOPE_AGENT); }
#undef SLOAD
#undef SWRITE
#undef tile_k0
}

struct PhaseArgs { const bf16* PROJ; const bf16* QDR; const bf16* KVR; const bf16* KD; bf16* O; const float* LF; const float* KMS; unsigned* queue; const unsigned* KMAX; unsigned long long* SSG; int only; };
struct PairOrder { unsigned char ty[64], qb[64]; };
__host__ __device__ constexpr PairOrder make_pair_order() {
    PairOrder o{}; float cost[64] = {}; int n = 0;
    for (int ty = 0; ty < 4; ++ty) for (int qb = 0; qb < 16; ++qb) {
        const float c = ty == T_MLA ? 1.25f * (qb + 1) : ty == T_MOBA ? 1.0f * (qb + 1) + 0.5f : ty == T_FOX ? (qb + 1 < 5 ? 1.0f * (qb + 1) : 4.5f + 0.05f * qb) : (qb + 1 < 2 ? 0.6f : 0.8f + 0.01f * qb);
        int pos = n; while (pos > 0 && cost[pos - 1] < c) { cost[pos] = cost[pos - 1]; o.ty[pos] = o.ty[pos - 1]; o.qb[pos] = o.qb[pos - 1]; --pos; }
        cost[pos] = c; o.ty[pos] = (unsigned char)ty; o.qb[pos] = (unsigned char)qb; ++n; }
    return o;
}
__constant__ PairOrder PAIR_ORDER = make_pair_order();
__device__ __forceinline__ void attn_phase(const PhaseArgs& A, LAS unsigned char* lds, unsigned ldsb) {
    LAS unsigned* misc = (LAS unsigned*)(lds + OFF_MISC);
    Tensors TD, TA, TC, TB;
    TD.LF = TA.LF = TC.LF = TB.LF = A.LF; TD.KMS = TA.KMS = TC.KMS = TB.KMS = A.KMS; TD.KMAX = TA.KMAX = TC.KMAX = TB.KMAX = A.KMAX; TD.SSG = TA.SSG = TC.SSG = TB.SSG = A.SSG;
    TD.Q = A.QDR; TD.K = A.KD; TD.V = A.KVR + 128; TD.ldq = 768; TD.ldk = 768; TD.ldv = 1024; TD.qh = 192; TD.kh = 192; TD.vh = 256; TD.O = A.O + 3 * GW; TD.grp = 3;
    TA.Q = A.PROJ + C_AQ; TA.K = A.PROJ + C_AK; TA.V = A.PROJ + C_AV; TA.ldq = TA.ldk = TA.ldv = INP; TA.qh = TA.kh = TA.vh = 128; TA.O = A.O; TA.grp = 0;
    TC = TA; TC.Q = A.PROJ + C_CQ; TC.K = A.PROJ + C_CK; TC.V = A.PROJ + C_CV; TC.O = A.O + 2 * GW; TC.grp = 2;
    TB = TA; TB.Q = A.PROJ + C_BQ; TB.K = A.PROJ + C_BK; TB.V = A.PROJ + C_BV; TB.O = A.O + GW; TB.grp = 1;
    const int G = (int)gridDim.x, x0 = (int)blockIdx.x & 7, nstat = (G == 256) ? 32 : 0;
    int kq = 0;
    for (int round = 0;; ++round) {
        if (threadIdx.x == 0) { unsigned code = 0xffffffffu;
            if (round == 0 && nstat) code = (unsigned)(x0 * 128 + ((int)blockIdx.x >> 3));
            else { for (; kq < 8; ++kq) { const int q = (x0 + kq) & 7;
                       const unsigned i = (unsigned)nstat + __hip_atomic_fetch_add(A.queue + 16 * q, 1u, __ATOMIC_RELAXED, __HIP_MEMORY_SCOPE_AGENT);
                       if (i < 128u) { code = (unsigned)q * 128u + i; break; } } }
            misc[0] = code; misc[1] = 0u; }
        __syncthreads();
        const unsigned code = misc[0];
        if (code == 0xffffffffu) break;
        const int q = (int)(code >> 7), i = (int)(code & 127u), pr = i >> 1, bh = q + 8 * (i & 1), ty = PAIR_ORDER.ty[pr], qb = PAIR_ORDER.qb[pr];
        if (ty == T_MLA) attn_item<T_MLA>(TD, bh >> 2, bh & 3, qb, lds, ldsb);
        else if (ty == T_MOBA) attn_item<T_MOBA>(TC, bh >> 2, bh & 3, qb, lds, ldsb);
        else if (ty == T_FOX) attn_item<T_FOX>(TA, bh >> 2, bh & 3, qb, lds, ldsb);
        else attn_item<T_STICK>(TB, bh >> 2, bh & 3, qb, lds, ldsb);
        __syncthreads();
    }
}
}

#ifndef PROBE_DUP
#define PROBE_DUP 0
#endif
#ifndef MK_SPLIT
#define MK_SPLIT 0
#endif
constexpr int N_PHASES = 1 + 8 * DEPTH;
struct Args { const float* in[21]; float* out; unsigned char* ws; int ph_lo, ph_hi; };
__global__ void __launch_bounds__(NWAVES * 64, 2) hybrid_fwd(Args args) {
    extern __shared__ __attribute__((aligned(16))) unsigned char lds_raw[];
#define MKWG() WG g; { int t_ = threadIdx.x; asm volatile("" : "+v"(t_)); g.lds = (LAS unsigned char*)lds_raw; g.tid = t_; g.lane = t_ & 63; g.wave = __builtin_amdgcn_readfirstlane(t_ >> 6); \
        g.G = gridDim.x; const int bx_ = blockIdx.x; g.vcu = (g.G % 8 == 0) ? (bx_ % 8) * (g.G / 8) + bx_ / 8 : bx_; }
    LAS unsigned char* const lds0 = (LAS unsigned char*)lds_raw; const int tid0 = threadIdx.x, G0 = gridDim.x;
    volatile LAS unsigned* MISC = (volatile LAS unsigned*)(lds0 + MISC_OFF);
    unsigned char* ws = args.ws;
    unsigned* ctl = (unsigned*)(ws + WS_CTL);
    for (int u = tid0; u < (LDS_BYTES - RING_BYTES) / 4; u += NWAVES * 64) ((LAS unsigned*)(lds0 + RING_BYTES))[u] = 0u;
    __syncthreads();
    const int lo = args.ph_lo, hi = args.ph_hi;
    XcdBarrier bar; bar.bar = ctl + CW_BAR; bar.x = 0; bar.st = nullptr;
    if (hi - lo > 1) bar = xcd_barrier_post(ctl + CW_BAR, MISC + 8);
    const unsigned ldsb = (unsigned)(uintptr_t)lds_raw;
#ifndef PH_EN
#define PH_EN 0x1fff
#endif
#define IN(k) (lo <= (k) && (k) < hi)
#define EN(j) ((PH_EN >> (j)) & 1)
#if PROBE_DUP == 10
#define SEAM(k) do { if (IN(k) && IN((k) + 1)) { xcd_barrier(bar); xcd_barrier(bar); } } while (0)
#else
#define SEAM(k) do { if (IN(k) && IN((k) + 1)) xcd_barrier(bar); } while (0)
#endif

    bf16* XS = (bf16*)(ws + WS_XS); bf16* PROJ = (bf16*)(ws + WS_PROJ); bf16* QDR = (bf16*)(ws + WS_QDR); bf16* KVR = (bf16*)(ws + WS_KVR); bf16* KD = (bf16*)(ws + WS_KD);
    bf16* OB = (bf16*)(ws + WS_O); bf16* UB = (bf16*)(ws + WS_U); bf16* ACT = (bf16*)(ws + WS_ACT); bf16* X8 = (bf16*)(ws + WS_X8);
    float* LF = (float*)(ws + WS_LF); float* KMS = (float*)(ws + WS_KMS); unsigned long long* SS = (unsigned long long*)(ws + WS_SS); unsigned long long* SSG = (unsigned long long*)(ws + WS_SSG); unsigned long long* SSD = (unsigned long long*)(ws + WS_SSD);
    const float* cosC = (const float*)(ws + WS_COSC); const float* sinC = (const float*)(ws + WS_SINC); const float* cosR = (const float*)(ws + WS_COSR); const float* sinR = (const float*)(ws + WS_SINR);

    if (EN(12) && IN(0)) { MKWG(); prologue_phase(g, args.in, ws); __syncthreads(); stream_init_phase(g, args.in[0], XS, SS);
#if PROBE_DUP == 4
        __syncthreads(); prologue_phase(g, args.in, ws); __syncthreads(); stream_init_phase(g, args.in[0], XS, SS);
#endif
    }
    SEAM(0);

    for (int l = 0; l < DEPTH; ++l) {
        const int p0 = 1 + 8 * l;
        const unsigned char* wl = ws + WS_W + (size_t)l * W_LAYER;
        unsigned long long* SS1 = SS + (size_t)(2 * l) * M; unsigned long long* SS2 = SS1 + M;
        unsigned long long* SSQ = SSD + (size_t)(2 * l) * M; unsigned long long* SSKV = SSQ + M;
        if (EN(0) && IN(p0 + 0)) { MKWG(); pg8::Gemm gm{XS, (const bf16*)(wl + W_IN), M, INP, DM, DM, nullptr}; pg8::StaticOrder S; S.init(M, INP, g.G, (int)blockIdx.x);
            pg8::EpiBf16 E{PROJ, INP, 1.f, SS1, 1.f / DM, SSQ, SSKV, C_DCQ / 256, C_DCQ / 256 + 1, C_DCKV / 256};
            pg8::gemm_phase<pg8::EpiBf16, pg8::StaticOrder, true, true>(g.lds, gm, S, E);
            if (l + 1 < DEPTH) { MKWG(); const int nwg = (M / 256) * (INP / 256), maxr = (nwg + g.G - 1) / g.G, rem = nwg - (maxr - 1) * g.G, c = (int)blockIdx.x;
                if (rem >= g.G) convert_layer(g, args.in, ws, l + 1, c * NWAVES + g.wave, g.G * NWAVES, 0, CONV_SPLIT);
                else if (c >= rem) convert_layer(g, args.in, ws, l + 1, (c - rem) * NWAVES + g.wave, (g.G - rem) * NWAVES, 0, CONV_SPLIT); }
#if PROBE_DUP == 1
            pg8::gemm_phase<pg8::EpiBf16, pg8::StaticOrder, true, true>(g.lds, gm, S, E);
#endif
#if PROBE_DUP == 22
            xcd_barrier(bar); { pg8::EpiBf16 E2{PROJ, INP, 1.f, SS1, 1.f / DM, nullptr, nullptr, 0, 0, 0}; pg8::gemm_phase<pg8::EpiBf16, pg8::StaticOrder, true, true>(g.lds, gm, S, E2); }
#endif
        }
        SEAM(p0 + 0);
        if (EN(2) && IN(p0 + 1)) { MKWG();
            { pg8::Gemm gm{PROJ + C_DCQ, (const bf16*)(wl + W_UQ), M, 768, QRANK, INP, nullptr}; pg8::StaticOrder S; S.init(M, 768, g.G, (int)blockIdx.x);
              pg8::EpiBf16 E{QDR, 768, 1.f, SSQ, 1.f / QRANK, nullptr, nullptr, 0, 0, 0};
              pg8::gemm_phase<pg8::EpiBf16, pg8::StaticOrder, true, true>(g.lds, gm, S, E); }
            { pg8::Gemm gm{PROJ + C_DCKV, (const bf16*)(wl + W_UKV), M, 1024, KVRANK, INP, nullptr}; pg8::StaticOrder S; S.init(M, 1024, g.G, (int)blockIdx.x);
              pg8::EpiBf16 E{KVR, 1024, 1.f, SSKV, 1.f / KVRANK, nullptr, nullptr, 0, 0, 0};
              pg8::gemm_phase<pg8::EpiBf16, pg8::StaticOrder, true, true>(g.lds, gm, S, E); }
        }
        SEAM(p0 + 1);
        if (EN(1) && IN(p0 + 2)) { MKWG(); Prep P{PROJ, PROJ, QDR, QDR, KVR, KD, args.in[4] + l * HD, args.in[5] + l * HD, args.in[6] + l * HD, args.in[7] + l * HD, args.in[12] + l * QKD, args.in[13] + l * QKD, args.in[3] + l * GH,
                                                 LF, KMS, cosC, sinC, cosR, sinR, ctl + CW_KMAX + 256 * l};
            prep_phase(g, P);
#if PROBE_DUP == 24
            xcd_barrier(bar); P.OUT = ACT; P.QOUT = ACT + (size_t)M * INP; P.KD = P.QOUT + (size_t)M * 768; P.LF = (float*)(P.KD + (size_t)M * 768); P.KMS = P.LF + (size_t)M * 4; P.KMAX = (unsigned*)(P.KMS + 262144); prep_phase(g, P);
#endif
        }
        SEAM(p0 + 2);
        if (EN(4) && IN(p0 + 3)) { MKWG(); att::PhaseArgs A{PROJ, QDR, KVR, KD, OB, LF, KMS, ctl + CW_QUEUE + 256 * l, ctl + CW_KMAX + 256 * l, SSG + (size_t)l * M * 4, -1};
            att::attn_phase(A, g.lds, ldsb);
            if (l + 1 < DEPTH) { MKWG(); volatile LAS unsigned* mq = (volatile LAS unsigned*)(g.lds + MISC_OFF + 64);
                for (;;) { __syncthreads(); if (g.tid == 0) mq[0] = __hip_atomic_fetch_add(ctl + CW_QUEUE + 256 * l + 192, 1u, __ATOMIC_RELAXED, __HIP_MEMORY_SCOPE_AGENT);
                    __syncthreads(); const int base = CONV_SPLIT + 8 * (int)mq[0]; if (base >= CONV_ITEMS) break;
                    if (base + g.wave < CONV_ITEMS) convert_item(g, args.in, ws, l + 1, base + g.wave); } }
#if PROBE_DUP == 2
            __syncthreads(); A.queue = ctl + CW_QUEUE + 256 * (l + 8); att::attn_phase(A, g.lds, ldsb);
#endif
#if PROBE_DUP >= 30 && PROBE_DUP <= 33
            __syncthreads(); A.queue = ctl + CW_QUEUE + 256 * (l + 8); A.SSG = (unsigned long long*)ACT; A.only = PROBE_DUP - 30; att::attn_phase(A, g.lds, ldsb);
#endif
#if PROBE_DUP == 21
            xcd_barrier(bar); A.queue = ctl + CW_QUEUE + 256 * (l + 8); A.SSG = (unsigned long long*)ACT; att::attn_phase(A, g.lds, ldsb);
#endif
        }
        SEAM(p0 + 3);
        if (EN(6) && IN(p0 + 4)) { MKWG(); pg8::Gemm gm{OB, (const bf16*)(wl + W_OUT), M, DM, MIXW, MIXW, SSG + (size_t)l * M * 4}; pg8::StaticOrder S; S.init(M, DM, g.G, (int)blockIdx.x);
            pg8::EpiStream<FFN_FP8> E{XS, nullptr, X8, SS2, DM, 1.f};
            pg8::gemm_phase<pg8::EpiStream<FFN_FP8>, pg8::StaticOrder, true, true, false, true>(g.lds, gm, S, E);
#if PROBE_DUP == 5
            { pg8::EpiStream<FFN_FP8> E2{XS, nullptr, X8, nullptr, DM, 0.f}; pg8::gemm_phase<pg8::EpiStream<FFN_FP8>, pg8::StaticOrder, true, true>(g.lds, gm, S, E2); }
#endif
        }
        SEAM(p0 + 4);
        if (EN(8) && IN(p0 + 5)) { MKWG(); constexpr int KD_ = FFN_FP8 ? 2 : 1;
            pg8::Gemm gm{X8, (const bf16*)(wl + W_UP), M, DFF2, DM / KD_, DM / KD_, nullptr}; pg8::StaticOrder S; S.init(M, DFF2, g.G, (int)blockIdx.x);
            pg8::EpiBf16 E{UB, DFF2, 1.f / WUP_SCALE, SS2, 1.f / DM, nullptr, nullptr, 0, 0, 0};
            pg8::gemm_phase<pg8::EpiBf16, pg8::StaticOrder, true, false, FFN_FP8>(g.lds, gm, S, E);
#if PROBE_DUP == 1
            pg8::gemm_phase<pg8::EpiBf16, pg8::StaticOrder, true, false, FFN_FP8>(g.lds, gm, S, E);
#endif
#if PROBE_DUP == 23
            xcd_barrier(bar); pg8::gemm_phase<pg8::EpiBf16, pg8::StaticOrder, true, false, FFN_FP8>(g.lds, gm, S, E);
#endif
        }
        SEAM(p0 + 5);
        if (EN(9) && IN(p0 + 6)) { MKWG(); convgate_phase(g, UB, args.in[18] + (size_t)l * 3 * DFF2, args.in[19] + (size_t)l * DFF2, ACT);
#if PROBE_DUP == 3
            convgate_phase(g, UB, args.in[18] + (size_t)l * 3 * DFF2, args.in[19] + (size_t)l * DFF2, ACT);
#endif
#if PROBE_DUP == 12
            xcd_barrier(bar); convgate_phase(g, UB, args.in[18] + (size_t)l * 3 * DFF2, args.in[19] + (size_t)l * DFF2, ACT);
#endif
        }
        SEAM(p0 + 6);
        if (EN(10) && IN(p0 + 7)) { MKWG(); constexpr int KD_ = FFN_FP8 ? 2 : 1; const bool last = (l + 1 == DEPTH);
            pg8::Gemm gm{ACT, (const bf16*)(wl + W_DOWN), M, DM, DFF / KD_, DFF / KD_, nullptr}; pg8::StaticOrder S; S.init(M, DM, g.G, (int)blockIdx.x);
            pg8::EpiStream<false> E{XS, last ? args.out : nullptr, nullptr, last ? nullptr : SS1 + 2 * M, DM, 1.f / WDOWN_SCALE};
            pg8::gemm_phase<pg8::EpiStream<false>, pg8::StaticOrder, true, false, FFN_FP8>(g.lds, gm, S, E);
#if PROBE_DUP == 6
            if (!last) { pg8::EpiStream<false> E2{XS, nullptr, nullptr, nullptr, DM, 0.f}; pg8::gemm_phase<pg8::EpiStream<false>, pg8::StaticOrder, true, false, FFN_FP8>(g.lds, gm, S, E2); }
#endif
        }
        if (l + 1 < DEPTH) SEAM(p0 + 7);
    }
#undef IN
#undef SEAM
#undef MKWG
}

extern "C" void kernel_launch(void* const* d_in, const int* in_sizes, int n_in, void* d_out, int out_size, void* d_ws, size_t ws_size, hipStream_t stream) {
    static int grid = 0;
    if (grid == 0) {
        if (n_in != 21 || in_sizes[0] != M * DM || out_size != M * DM || ws_size < WS_END) {
            fprintf(stderr, "kernel_launch: built for 21 inputs, x and out of %d floats, >= %zu bytes of workspace; got n_in %d, in0 %d, out %d, ws %zu; nothing launched\n", M * DM, (size_t)WS_END, n_in, n_in > 0 ? in_sizes[0] : -1, out_size, ws_size);
            grid = -1; return; }
        int dev = 0, cus = 0, per_cu = 0;
        if (hipGetDevice(&dev) != hipSuccess || hipDeviceGetAttribute(&cus, hipDeviceAttributeMultiprocessorCount, dev) != hipSuccess) { fprintf(stderr, "kernel_launch: device query failed\n"); grid = -1; return; }
        if (hipFuncSetAttribute((const void*)hybrid_fwd, hipFuncAttributeMaxDynamicSharedMemorySize, LDS_BYTES) != hipSuccess) { fprintf(stderr, "kernel_launch: hipFuncSetAttribute(%d B LDS) failed\n", LDS_BYTES); grid = -1; return; }
        if (hipOccupancyMaxActiveBlocksPerMultiprocessor(&per_cu, (const void*)hybrid_fwd, NWAVES * 64, LDS_BYTES) != hipSuccess || per_cu < 1)
            fprintf(stderr, "kernel_launch: note: occupancy query reports %d workgroups per CU\n", per_cu);
        (void)hipGetLastError();
        grid = cus;
    }
    if (grid < 0) return;
    if (hipMemsetAsync((char*)d_ws + WS_CTL, 0, CTL_ZERO_BYTES, stream) != hipSuccess) { fprintf(stderr, "kernel_launch: memset failed\n"); return; }
    Args a{};
    for (int i = 0; i < 21; ++i) a.in[i] = (const float*)d_in[i];
    a.out = (float*)d_out; a.ws = (unsigned char*)d_ws;
#if MK_SPLIT
    for (int p = 0; p < N_PHASES; ++p) { a.ph_lo = p; a.ph_hi = p + 1; hipLaunchKernelGGL(hybrid_fwd, dim3(grid), dim3(NWAVES * 64), LDS_BYTES, stream, a); }
#else
    a.ph_lo = 0; a.ph_hi = N_PHASES;
    hipLaunchKernelGGL(hybrid_fwd, dim3(grid), dim3(NWAVES * 64), LDS_BYTES, stream, a);
#endif
    const hipError_t le = hipPeekAtLastError();
    if (le != hipSuccess) fprintf(stderr, "kernel_launch: launch failed: %s\n", hipGetErrorName(le));
}
```

```cpp
#include <hip/hip_runtime.h>
#include <cstdio>
#include <cstdint>

#define GAS __attribute__((address_space(1)))
#define LAS __attribute__((address_space(3)))
typedef unsigned short bf16;
typedef short bf16x8 __attribute__((ext_vector_type(8)));
typedef short s16x4 __attribute__((ext_vector_type(4)));
typedef float f32x2 __attribute__((ext_vector_type(2)));
typedef float f32x4 __attribute__((ext_vector_type(4)));
typedef float f32x16 __attribute__((ext_vector_type(16)));
typedef unsigned u32x2 __attribute__((ext_vector_type(2)));
typedef unsigned u32x4 __attribute__((ext_vector_type(4)));

constexpr int BATCH = 4, SEQ = 4096, DM = 2048, DEPTH = 4;
constexpr int M = BATCH * SEQ;
constexpr int HD = 128, GH = 4, GW = 512, MIXW = 2048;
constexpr int INW = 5444, INP = 5632;
constexpr int DFF = 5632, DFF2 = 11264;
constexpr int QRANK = 512, KVRANK = 256, QKD = 192;
constexpr float EPS = 1e-6f;
#ifndef FFN_FP8_ON
#define FFN_FP8_ON 1
#endif
constexpr bool FFN_FP8 = FFN_FP8_ON;
constexpr float WUP_SCALE = FFN_FP8 ? 64.f : 1.f, WDOWN_SCALE = FFN_FP8 ? 256.f : 1.f;
constexpr int C_AQ = 0, C_AK = 512, C_AV = 1024, C_BQ = 1536, C_BK = 2048, C_BV = 2560, C_CQ = 3072, C_CK = 3584, C_CV = 4096, C_DCQ = 4608, C_DCKV = 5120, C_DKR = 5376, C_AF = 5440;
__host__ __device__ __forceinline__ int inproj_src_col(int n) {
    if (n < 1536) return n;
    if (n < 5440) return n + 4;
    if (n < 5444) return 1536 + (n - 5440);
    return -1;
}

constexpr size_t MiB = 1u << 20;
constexpr size_t WS_CTL = 0, CTL_ZERO_BYTES = 5 * MiB;
constexpr size_t WS_SS = 1 * MiB;
constexpr size_t WS_SSG = 2 * MiB;
constexpr size_t WS_SSD = 4 * MiB;
constexpr size_t WS_COSC = 5 * MiB, WS_SINC = 6 * MiB;
constexpr size_t WS_COSR = 7 * MiB, WS_SINR = 7 * MiB + 512 * 1024;
constexpr size_t WS_LF = 8 * MiB;
constexpr size_t WS_CF = WS_LF + 256 * 1024;
constexpr size_t WS_KMS = WS_CF + 256 * 1024;
constexpr size_t WS_SEL = WS_KMS + 512 * 1024;
constexpr size_t WS_W = 10 * MiB;
constexpr size_t W_IN = 0, W_UQ = W_IN + (size_t)INP * DM * 2, W_UKV = W_UQ + (size_t)768 * 512 * 2, W_OUT = W_UKV + (size_t)1024 * 256 * 2,
                 W_UP = W_OUT + (size_t)DM * MIXW * 2, W_DOWN = W_UP + (size_t)DFF2 * DM * 2, W_LAYER = W_DOWN + (size_t)DM * DFF * 2;
static_assert(W_LAYER == (size_t)(22 * 1024 + 768 + 512 + 8 * 1024 + 44 * 1024 + 22 * 1024) * 1024, "weights per layer");
constexpr size_t WS_XS = 400 * MiB;
constexpr size_t WS_U = 464 * MiB;
constexpr size_t WS_PROJ = WS_U;
constexpr size_t WS_QDR = WS_PROJ + (size_t)M * INP * 2;
constexpr size_t WS_KVR = WS_QDR + (size_t)M * 768 * 2;
constexpr size_t WS_KD = WS_KVR + (size_t)M * 1024 * 2;
constexpr size_t WS_O = WS_KD + (size_t)M * 768 * 2;
constexpr size_t WS_ACT = WS_U + (size_t)M * DFF2 * 2;
constexpr size_t WS_X8 = WS_ACT + (size_t)M * DFF * 2;
constexpr size_t WS_END = WS_X8 + (size_t)M * DM * 2;
static_assert(WS_W + DEPTH * W_LAYER <= WS_XS && WS_O + (size_t)M * MIXW * 2 <= WS_ACT && WS_XS + (size_t)M * DM * 2 <= WS_U && WS_SEL + 256 * 1024 <= WS_W && WS_SS + (size_t)DEPTH * 2 * M * 8 <= WS_SSG && WS_SSG + (size_t)DEPTH * M * 4 * 8 <= WS_SSD && WS_SSD + (size_t)DEPTH * 2 * M * 8 <= CTL_ZERO_BYTES, "d_ws map");
constexpr int CW_BAR = 4096;
constexpr int CW_KMAX = 32768;
constexpr int CW_QUEUE = 16384;

constexpr int RING_BYTES = 131072;
constexpr int MISC_OFF = RING_BYTES + 320;
constexpr int LDS_BYTES = 147456;
constexpr int NWAVES = 8;

#define LDS_WAIT() asm volatile("s_waitcnt lgkmcnt(0)" ::: "memory")
#define VM_WAIT() asm volatile("s_waitcnt vmcnt(0)" ::: "memory")
#define SBAR() __builtin_amdgcn_sched_barrier(0)

__device__ __forceinline__ float bf2f(unsigned b) { return __uint_as_float(b << 16); }
__device__ __forceinline__ unsigned cvt_pk_bf16(float lo, float hi) { unsigned r; asm volatile("v_cvt_pk_bf16_f32 %0, %1, %2" : "=v"(r) : "v"(lo), "v"(hi)); return r; }
__device__ __forceinline__ void unpack8(u32x4 w, float (&v)[8]) {
#pragma unroll
    for (int i = 0; i < 4; ++i) { v[2 * i] = __uint_as_float(w[i] << 16); v[2 * i + 1] = __uint_as_float(w[i] & 0xffff0000u); }
}
__device__ __forceinline__ u32x4 pack8(const float (&v)[8]) { u32x4 w; w.x = cvt_pk_bf16(v[0], v[1]); w.y = cvt_pk_bf16(v[2], v[3]); w.z = cvt_pk_bf16(v[4], v[5]); w.w = cvt_pk_bf16(v[6], v[7]); return w; }
__device__ __forceinline__ float wave_sum(float v) {
#pragma unroll
    for (int o = 1; o < 64; o <<= 1) v += __shfl_xor(v, o);
    return v;
}
template <int CTRL> __device__ __forceinline__ float dppf(float v) { return __uint_as_float((unsigned)__builtin_amdgcn_update_dpp(0, (int)__float_as_uint(v), CTRL, 0xf, 0xf, true)); }
__device__ __forceinline__ float sum16(float v) {
    v += dppf<0xB1>(v); v += dppf<0x4E>(v); v += dppf<0x141>(v); v += dppf<0x140>(v);
    return v;
}
__device__ __forceinline__ float clamp448(float x) { return __builtin_amdgcn_fmed3f(x, -448.f, 448.f); }
__device__ __forceinline__ unsigned pack4_fp8(float a, float b, float c, float d) {
    unsigned w = 0; w = __builtin_amdgcn_cvt_pk_fp8_f32(clamp448(a), clamp448(b), w, false); w = __builtin_amdgcn_cvt_pk_fp8_f32(clamp448(c), clamp448(d), w, true); return w; }
__constant__ float INVF128[64] = {1.f, 0.865964353f, 0.749894261f, 0.649381638f, 0.562341332f, 0.486967534f, 0.421696514f, 0.365174115f, 0.316227764f, 0.273841977f, 0.237137377f, 0.2053525f, 0.177827939f, 0.153992653f, 0.133352131f, 0.115478203f, 0.100000001f, 0.0865964293f, 0.0749894157f, 0.0649381652f, 0.0562341325f, 0.0486967526f, 0.0421696529f, 0.0365174115f, 0.0316227749f, 0.0273841973f, 0.0237137377f, 0.0205352511f, 0.0177827943f, 0.0153992651f, 0.0133352149f, 0.0115478206f, 0.00999999978f, 0.00865964312f, 0.00749894185f, 0.00649381615f, 0.00562341325f, 0.00486967526f, 0.00421696482f, 0.00365174119f, 0.00316227763f, 0.00273841969f, 0.00237137359f, 0.00205352483f, 0.00177827943f, 0.00153992651f, 0.00133352145f, 0.0011547819f, 0.00100000005f, 0.000865964335f, 0.000749894243f, 0.000649381662f, 0.000562341302f, 0.000486967532f, 0.000421696517f, 0.000365174143f, 0.000316227757f, 0.000273841957f, 0.00023713737f, 0.00020535251f, 0.00017782794f, 0.000153992645f, 0.00013335215f, 0.0001154782f};

namespace pg8 {
#define PG8_LAS __attribute__((address_space(3)))
typedef unsigned short bf16_t;
typedef short bf16x8 __attribute__((ext_vector_type(8)));
typedef float f32x4 __attribute__((ext_vector_type(4)));
typedef unsigned u32x4 __attribute__((ext_vector_type(4)));
typedef int v8i __attribute__((ext_vector_type(8)));
typedef unsigned u32x8 __attribute__((ext_vector_type(8)));
constexpr int BM = 256, BK = 64, HALF = 128, HTB = HALF * BK * 2  , STAGE_BYTES = 8 * HTB, NXCD = 8, WGM = 4;

__host__ __device__ __forceinline__ int lds_byte(int r, int c) { const int st = (r >> 4) * 2 + (c >> 5), rr = r & 15, cc = c & 31, ob = rr * 64 + cc * 2; return st * 1024 + (ob ^ (((ob >> 9) & 1) << 5)); }
__host__ __device__ __forceinline__ void stage_rc(int b, int& R, int& C) { const int st = b / 1024, sb = b % 1024, swz = sb ^ (((sb >> 9) & 1) << 5); R = (st >> 1) * 16 + swz / 64; C = (st & 1) * 32 + (swz % 64) / 2; }
__host__ __device__ __forceinline__ int perm32(int rho) { const int n = rho >> 4, i = rho & 15; return 8 * (i >> 2) + 4 * n + (i & 3); }

struct Unit { int pm, pn; };
struct Gemm { const bf16_t* A; const bf16_t* Bt; int M, N, K, lda; const unsigned long long* ssg; };

struct StaticOrder {
    int nM, nN, nwg, G, c;
    __host__ __device__ void init(int M, int N, int G_, int c_) { nM = M / BM; nN = N / BM; nwg = nM * nN; G = G_; c = c_; }
    __host__ __device__ bool next(int i, Unit& u) const {
        const long L = (long)i * G + c; if (L >= nwg) return false;
        int wgid = (int)L; { const int q = nwg / NXCD, r = nwg % NXCD, xcd = wgid % NXCD, off = wgid / NXCD; wgid = (xcd < r ? xcd * (q + 1) : r * (q + 1) + (xcd - r) * q) + off; }
        const int nig = WGM * nN, gid = wgid / nig, fm = gid * WGM, gsz = (nM - fm) < WGM ? (nM - fm) : WGM;
        u.pm = fm + ((wgid % nig) % gsz); u.pn = (wgid % nig) / gsz; return true;
    }
    __device__ __forceinline__ void a_ready(const Unit&) const {}
    __device__ __forceinline__ void done(const Unit&) const {}
};

__device__ __forceinline__ unsigned cvt_pk_bf16(float lo, float hi) { unsigned r; asm volatile("v_cvt_pk_bf16_f32 %0, %1, %2" : "=v"(r) : "v"(lo), "v"(hi)); return r; }
struct EpiBf16 {
    static constexpr bool PERM = true, AFTER_DRAIN = false;
    bf16_t* O; int ldc; float sc; const unsigned long long* ss; float inv_n;
    unsigned long long* st_a; unsigned long long* st_b; int pn_a0, pn_a1, pn_b;
    static constexpr bool PREFETCH_SS = true;
    __device__ __forceinline__ void operator()(const f32x4 (&acc)[2][2][4][2], const Unit& u, int wr, int wc, int fr, int fq, const unsigned long long (&pre)[8]) const {
        const int row0 = u.pm * BM + wr * 64 + fr, col0 = u.pn * BM + wc * 32 + 8 * fq;
        unsigned long long* st = nullptr; if (st_a) { if (u.pn >= pn_a0 && u.pn <= pn_a1) st = st_a; else if (u.pn == pn_b) st = st_b; }
#pragma unroll
        for (int ai = 0; ai < 2; ++ai)
#pragma unroll
            for (int m = 0; m < 4; ++m) { const int row = row0 + ai * HALF + m * 16; bf16_t* rowp = O + (size_t)row * ldc + col0; float ssq = 0.f;
                const float s = ss ? sc * rsqrtf((float)pre[ai * 4 + m] * (inv_n * (1.f / 16777216.f)) + 1e-6f) : sc;
#pragma unroll
                for (int bj = 0; bj < 2; ++bj) { const f32x4 v0 = acc[ai][bj][m][0] * s, v1 = acc[ai][bj][m][1] * s;
                    if (st) ssq += (v0[0] * v0[0] + v0[1] * v0[1]) + (v0[2] * v0[2] + v0[3] * v0[3]) + (v1[0] * v1[0] + v1[1] * v1[1]) + (v1[2] * v1[2] + v1[3] * v1[3]);
                    u32x4 w; w.x = cvt_pk_bf16(v0[0], v0[1]); w.y = cvt_pk_bf16(v0[2], v0[3]); w.z = cvt_pk_bf16(v1[0], v1[1]); w.w = cvt_pk_bf16(v1[2], v1[3]);
                    *(u32x4*)(rowp + bj * HALF) = w; }
                if (st) { ssq += __shfl_xor(ssq, 16); ssq += __shfl_xor(ssq, 32); if (fq == 0) __hip_atomic_fetch_add(st + row, (unsigned long long)(ssq * 16777216.f), __ATOMIC_RELAXED, __HIP_MEMORY_SCOPE_AGENT); } }
    }
};
template <bool COPY_FP8>
struct EpiStream {
    static constexpr bool PERM = true, AFTER_DRAIN = false, PREFETCH_SS = false;
    bf16_t* XS; float* OUT32; void* X8; unsigned long long* ss; int ldc; float sc;
    __device__ __forceinline__ void operator()(const f32x4 (&acc)[2][2][4][2], const Unit& u, int wr, int wc, int fr, int fq, const unsigned long long (&)[8]) const {
        const int row0 = u.pm * BM + wr * 64 + fr, col0 = u.pn * BM + wc * 32 + 8 * fq;
#pragma unroll
        for (int ai = 0; ai < 2; ++ai) {
            u32x4 xall[4][2];
#pragma unroll
            for (int m = 0; m < 4; ++m)
#pragma unroll
                for (int bj = 0; bj < 2; ++bj) xall[m][bj] = *(const u32x4*)(XS + (size_t)(row0 + ai * HALF + m * 16) * ldc + col0 + bj * HALF);
#pragma unroll
            for (int m = 0; m < 4; ++m) { const int row = row0 + ai * HALF + m * 16; const size_t ro = (size_t)row * ldc + col0; float ssq = 0.f;
#pragma unroll
                for (int bj = 0; bj < 2; ++bj) { const u32x4 xw = xall[m][bj];
                    f32x4 v0 = acc[ai][bj][m][0] * sc, v1 = acc[ai][bj][m][1] * sc;
                    v0[0] += __uint_as_float(xw[0] << 16); v0[1] += __uint_as_float(xw[0] & 0xffff0000u); v0[2] += __uint_as_float(xw[1] << 16); v0[3] += __uint_as_float(xw[1] & 0xffff0000u);
                    v1[0] += __uint_as_float(xw[2] << 16); v1[1] += __uint_as_float(xw[2] & 0xffff0000u); v1[2] += __uint_as_float(xw[3] << 16); v1[3] += __uint_as_float(xw[3] & 0xffff0000u);
                    ssq += (v0[0] * v0[0] + v0[1] * v0[1]) + (v0[2] * v0[2] + v0[3] * v0[3]) + (v1[0] * v1[0] + v1[1] * v1[1]) + (v1[2] * v1[2] + v1[3] * v1[3]);
                    if (OUT32) { *(f32x4*)(OUT32 + ro + bj * HALF) = v0; *(f32x4*)(OUT32 + ro + bj * HALF + 4) = v1; }
                    else { u32x4 w; w.x = cvt_pk_bf16(v0[0], v0[1]); w.y = cvt_pk_bf16(v0[2], v0[3]); w.z = cvt_pk_bf16(v1[0], v1[1]); w.w = cvt_pk_bf16(v1[2], v1[3]); *(u32x4*)(XS + ro + bj * HALF) = w; }
                    if (X8) { if constexpr (COPY_FP8) { u32x2 w; w.x = pack4_fp8(v0[0], v0[1], v0[2], v0[3]); w.y = pack4_fp8(v1[0], v1[1], v1[2], v1[3]); *(u32x2*)((unsigned char*)X8 + ro + bj * HALF) = w; }
                              else { u32x4 w; w.x = cvt_pk_bf16(v0[0], v0[1]); w.y = cvt_pk_bf16(v0[2], v0[3]); w.z = cvt_pk_bf16(v1[0], v1[1]); w.w = cvt_pk_bf16(v1[2], v1[3]); *(u32x4*)((bf16_t*)X8 + ro + bj * HALF) = w; } } }
                if (ss) { ssq += __shfl_xor(ssq, 16); ssq += __shfl_xor(ssq, 32); if (fq == 0) __hip_atomic_fetch_add(ss + row, (unsigned long long)(ssq * 16777216.f), __ATOMIC_RELAXED, __HIP_MEMORY_SCOPE_AGENT); } } }
    }
};

template <class Epi, class Sched, bool ALIGN_EPI = false, bool SP2 = false, bool FP8 = false, bool GS = false>
__device__ __forceinline__ void gemm_phase(PG8_LAS unsigned char* lds, const Gemm g, const Sched& S, const Epi& E) {
    int tid_ = threadIdx.x; asm volatile("" : "+v"(tid_));
    const int tid = tid_, wid = __builtin_amdgcn_readfirstlane(tid >> 6), lane = tid & 63, wr = wid >> 2, wc = wid & 3, fr = lane & 15, fq = lane >> 4;
    const int K = g.K, nt = K / BK;
    unsigned voffA[2], voffB[2];
#pragma unroll
    for (int i = 0; i < 2; ++i) { int R, C; stage_rc(tid * 16 + i * 8192, R, C); const int Rb = Epi::PERM ? ((R & ~31) + perm32(R & 31)) : R;
        voffA[i] = (unsigned)(R * g.lda + C) * 2u; voffB[i] = (unsigned)(Rb * K + C) * 2u; }
    const size_t kstep = (size_t)(BK * 2);
    const size_t hstepA = (size_t)HALF * g.lda * 2, hstepB = (size_t)HALF * K * 2;
    const size_t tstepA = 2 * hstepA, tstepB = 2 * hstepB;
    const unsigned ldsw = (unsigned)wid * 1024u;
    const int aoff = lds_byte(wr * 64 + fr, fq * 8), boff = lds_byte(wc * 32 + fr, fq * 8);
#define PG8_SA(b, h) (((b) * 2 + (h)) * HTB)
#define PG8_SB(b, h) ((4 + (b) * 2 + (h)) * HTB)
#define PG8_STAGE(bufoff, gbase, voff) do { _Pragma("unroll") for (int _i = 0; _i < 2; ++_i) \
        __builtin_amdgcn_global_load_lds((const unsigned*)((const char*)(gbase) + (voff)[_i]), (PG8_LAS unsigned*)(lds + (bufoff) + ldsw + _i * 8192), 16, 0, 0); } while (0)
#define PG8_LD2(dst, addr) do { const u32x4 lo_ = *(const PG8_LAS u32x4*)(addr), hi_ = *(const PG8_LAS u32x4*)((addr) + 1024); dst = __builtin_shufflevector(lo_, hi_, 0, 1, 2, 3, 4, 5, 6, 7); } while (0)
#define PG8_LDA(dst, b, h) do { _Pragma("unroll") for (int m = 0; m < 4; ++m) PG8_LD2(dst[m], lds + PG8_SA(b, h) + aoff + m * 2048); } while (0)
#define PG8_LDB(dst, b, h) do { _Pragma("unroll") for (int n = 0; n < 2; ++n) PG8_LD2(dst[n], lds + PG8_SB(b, h) + boff + n * 2048); } while (0)
#define PG8_HALF(X, k) __builtin_bit_cast(bf16x8, __builtin_shufflevector(X, X, 4 * (k), 4 * (k) + 1, 4 * (k) + 2, 4 * (k) + 3))
#define PG8_MMA(ai, bj, At, Bt) do { __builtin_amdgcn_s_setprio(1); \
        if constexpr (FP8) { _Pragma("unroll") for (int m = 0; m < 4; ++m) _Pragma("unroll") for (int n = 0; n < 2; ++n) \
            asm volatile("v_mfma_scale_f32_16x16x128_f8f6f4 %0, %1, %2, %0, %3, %3 op_sel_hi:[0,0,0]" : "+v"(acc[ai][bj][m][n]) : "v"(Bt[n]), "v"(At[m]), "v"(one_scale)); } \
        else { _Pragma("unroll") for (int m = 0; m < 4; ++m) _Pragma("unroll") for (int n = 0; n < 2; ++n) { \
            acc[ai][bj][m][n] = __builtin_amdgcn_mfma_f32_16x16x32_bf16(PG8_HALF(Bt[n], 0), PG8_HALF(At[m], 0), acc[ai][bj][m][n], 0, 0, 0); \
            acc[ai][bj][m][n] = __builtin_amdgcn_mfma_f32_16x16x32_bf16(PG8_HALF(Bt[n], 1), PG8_HALF(At[m], 1), acc[ai][bj][m][n], 0, 0, 0); } } \
        __builtin_amdgcn_s_setprio(0); } while (0)
#define PG8_WAIT_V(n) asm volatile("s_waitcnt vmcnt(" #n ")" ::: "memory")
#define PG8_WAIT_L(n) asm volatile("s_waitcnt lgkmcnt(" #n ")" ::: "memory")
#define PG8_BAR __builtin_amdgcn_s_barrier()
#define PG8_SCHED __builtin_amdgcn_sched_barrier(0)
    Unit cur, nxt; int ui = 0;
    if (!S.next(0, cur)) return;
    PG8_LAS unsigned char* const gs_lds = lds + STAGE_BYTES + 1024;
#define PG8_GS_TABLE(u_, buf_) do { if constexpr (GS) { if (tid < 256) { const unsigned long long* sp_ = g.ssg + ((size_t)(u_).pm * BM + tid) * 4; float r_[4]; \
        _Pragma("unroll") for (int q_ = 0; q_ < 4; ++q_) r_[q_] = rsqrtf((float)__hip_atomic_load(sp_ + q_, __ATOMIC_RELAXED, __HIP_MEMORY_SCOPE_AGENT) * (1.f / 16777216.f / 512.f) + 1e-6f); \
        *(PG8_LAS f32x4*)(gs_lds + (buf_) * 4096 + tid * 16) = (f32x4){r_[0] / r_[1], r_[1] / r_[2], r_[2] / r_[3], r_[3]}; } } } while (0)
#define PG8_GS_SCALE(buf_, col_) do { _Pragma("unroll") for (int ai_ = 0; ai_ < 2; ++ai_) _Pragma("unroll") for (int m_ = 0; m_ < 4; ++m_) { \
        const float f_ = *(const PG8_LAS float*)(gs_lds + (buf_) * 4096 + (wr * 64 + fr + ai_ * HALF + m_ * 16) * 16 + (col_) * 4); \
        _Pragma("unroll") for (int bj_ = 0; bj_ < 2; ++bj_) _Pragma("unroll") for (int n_ = 0; n_ < 2; ++n_) acc[ai_][bj_][m_][n_] = acc[ai_][bj_][m_][n_] * f_; } } while (0)
    f32x4 acc[2][2][4][2];
#pragma unroll
    for (int a = 0; a < 2; ++a)
#pragma unroll
        for (int b = 0; b < 2; ++b)
#pragma unroll
            for (int m = 0; m < 4; ++m)
#pragma unroll
                for (int n = 0; n < 2; ++n) acc[a][b][m][n] = (f32x4){0.f, 0.f, 0.f, 0.f};
    unsigned one_scale = 0x7f7f7f7fu; asm volatile("" : "+v"(one_scale));
    unsigned long long pre[8] = {0, 0, 0, 0, 0, 0, 0, 0};
    u32x8 At[4], B0[2], B1[2];
    const char* cA = (const char*)g.A + (size_t)cur.pm * tstepA; const char* cB = (const char*)g.Bt + (size_t)cur.pn * tstepB;
    S.a_ready(cur); PG8_GS_TABLE(cur, 0);
    if constexpr (SP2) {
        PG8_STAGE(PG8_SB(0, 0), cB, voffB); PG8_STAGE(PG8_SB(0, 1), cB + hstepB, voffB); PG8_STAGE(PG8_SA(0, 0), cA, voffA); PG8_STAGE(PG8_SA(0, 1), cA + hstepA, voffA);
        if (wr == 1) PG8_BAR;
        PG8_WAIT_V(2); PG8_BAR;
        PG8_STAGE(PG8_SB(1, 0), cB + kstep, voffB); PG8_STAGE(PG8_SA(1, 0), cA + kstep, voffA); PG8_STAGE(PG8_SB(1, 1), cB + hstepB + kstep, voffB);
        PG8_WAIT_V(6); PG8_BAR;
    } else {
        PG8_STAGE(PG8_SB(0, 0), cB, voffB); PG8_STAGE(PG8_SA(0, 0), cA, voffA); PG8_STAGE(PG8_SB(0, 1), cB + hstepB, voffB); PG8_STAGE(PG8_SA(0, 1), cA + hstepA, voffA);
        if (wr == 1) PG8_BAR;
        PG8_WAIT_V(4); PG8_BAR;
        PG8_STAGE(PG8_SB(1, 0), cB + kstep, voffB); PG8_STAGE(PG8_SA(1, 0), cA + kstep, voffA); PG8_STAGE(PG8_SB(1, 1), cB + hstepB + kstep, voffB);
        PG8_WAIT_V(6); PG8_BAR;
    }
    for (;;) {
        const bool has_next = S.next(ui + 1, nxt);
        const char* nA = has_next ? (const char*)g.A + (size_t)nxt.pm * tstepA : cA; const char* nB = has_next ? (const char*)g.Bt + (size_t)nxt.pn * tstepB : cB;
        for (int t = 0; t < nt; t += 2) {
            const bool last = (t == nt - 2);
            const char* a1 = cA + (size_t)(t + 1) * kstep;
            const char* a2 = last ? nA : cA + (size_t)(t + 2) * kstep; const char* b2 = last ? nB : cB + (size_t)(t + 2) * kstep;
            const char* a3 = a2 + kstep; const char* b3 = b2 + kstep;
            if (last && has_next) { S.a_ready(nxt); PG8_GS_TABLE(nxt, (ui + 1) & 1); }
            if constexpr (Epi::PREFETCH_SS) { if (last && E.ss) {
#pragma unroll
                for (int q_ = 0; q_ < 8; ++q_) pre[q_] = __hip_atomic_load(E.ss + cur.pm * BM + wr * 64 + fr + (q_ >> 2) * HALF + (q_ & 3) * 16, __ATOMIC_RELAXED, __HIP_MEMORY_SCOPE_AGENT); } }
            if constexpr (GS) { if (t == 8 || t == 16 || t == 24) PG8_GS_SCALE(ui & 1, (t >> 3) - 1); }
            if constexpr (SP2) {
            PG8_LDB(B0, 0, 0); PG8_LDB(B1, 0, 1); PG8_SCHED; PG8_LDA(At, 0, 0); PG8_STAGE(PG8_SA(1, 1), a1 + hstepA, voffA);
            PG8_WAIT_V(8); PG8_WAIT_L(0); PG8_BAR; PG8_MMA(0, 0, At, B0); PG8_MMA(0, 1, At, B1); PG8_BAR; PG8_SCHED;
            PG8_LDA(At, 0, 1); PG8_STAGE(PG8_SB(0, 0), b2, voffB); PG8_STAGE(PG8_SB(0, 1), b2 + hstepB, voffB); PG8_STAGE(PG8_SA(0, 0), a2, voffA);
            PG8_WAIT_V(8); PG8_WAIT_L(0); PG8_BAR; PG8_MMA(1, 0, At, B0); PG8_MMA(1, 1, At, B1); PG8_BAR; PG8_SCHED;
            PG8_LDB(B0, 1, 0); PG8_LDB(B1, 1, 1); PG8_SCHED; PG8_LDA(At, 1, 0); PG8_STAGE(PG8_SA(0, 1), a2 + hstepA, voffA);
            PG8_WAIT_V(8); PG8_WAIT_L(0); PG8_BAR; PG8_MMA(0, 0, At, B0); PG8_MMA(0, 1, At, B1); PG8_BAR; PG8_SCHED;
            PG8_LDA(At, 1, 1); PG8_STAGE(PG8_SB(1, 0), b3, voffB); PG8_STAGE(PG8_SB(1, 1), b3 + hstepB, voffB); PG8_STAGE(PG8_SA(1, 0), a3, voffA);
            PG8_WAIT_V(8); PG8_WAIT_L(0); PG8_BAR; PG8_MMA(1, 0, At, B0); PG8_MMA(1, 1, At, B1); PG8_BAR; PG8_SCHED;
            } else {
            PG8_LDB(B0, 0, 0); PG8_SCHED; PG8_LDA(At, 0, 0); PG8_STAGE(PG8_SA(1, 1), a1 + hstepA, voffA);
            PG8_WAIT_L(8); PG8_BAR; PG8_WAIT_L(0); PG8_MMA(0, 0, At, B0); PG8_BAR; PG8_SCHED;
            PG8_LDB(B1, 0, 1); PG8_STAGE(PG8_SB(0, 0), b2, voffB);
            PG8_BAR; PG8_WAIT_L(0); PG8_MMA(0, 1, At, B1); PG8_BAR;
            PG8_LDA(At, 0, 1); PG8_STAGE(PG8_SA(0, 0), a2, voffA);
            PG8_BAR; PG8_WAIT_L(0); PG8_MMA(1, 0, At, B0); PG8_BAR; PG8_SCHED;
            PG8_STAGE(PG8_SB(0, 1), b2 + hstepB, voffB);
            PG8_WAIT_V(6); PG8_BAR; PG8_MMA(1, 1, At, B1); PG8_BAR;
            PG8_LDB(B0, 1, 0); PG8_SCHED; PG8_LDA(At, 1, 0); PG8_STAGE(PG8_SA(0, 1), a2 + hstepA, voffA);
            PG8_WAIT_L(8); PG8_BAR; PG8_WAIT_L(0); PG8_MMA(0, 0, At, B0); PG8_BAR; PG8_SCHED;
            PG8_LDB(B1, 1, 1); PG8_STAGE(PG8_SB(1, 0), b3, voffB);
            PG8_BAR; PG8_WAIT_L(0); PG8_MMA(0, 1, At, B1); PG8_BAR;
            PG8_LDA(At, 1, 1); PG8_STAGE(PG8_SA(1, 0), a3, voffA);
            PG8_BAR; PG8_WAIT_L(0); PG8_MMA(1, 0, At, B0); PG8_BAR; PG8_SCHED;
            PG8_STAGE(PG8_SB(1, 1), b3 + hstepB, voffB);
            PG8_WAIT_V(6); PG8_BAR; PG8_MMA(1, 1, At, B1); PG8_BAR;
            }
        }
        if constexpr (ALIGN_EPI) { if (wr == 0) PG8_BAR; }
        if constexpr (FP8) asm volatile("s_nop 15\n\ts_nop 15" ::: "memory");
        if constexpr (GS) PG8_GS_SCALE(ui & 1, 3);
        if constexpr (!Epi::AFTER_DRAIN) { E(acc, cur, wr, wc, fr, fq, pre); S.done(cur); }
        if (!has_next) break;
#pragma unroll
        for (int a = 0; a < 2; ++a)
#pragma unroll
            for (int b = 0; b < 2; ++b)
#pragma unroll
                for (int m = 0; m < 4; ++m)
#pragma unroll
                    for (int n = 0; n < 2; ++n) acc[a][b][m][n] = (f32x4){0.f, 0.f, 0.f, 0.f};
        cur = nxt; cA = nA; cB = nB; ++ui;
        if constexpr (ALIGN_EPI) { if (wr == 1) PG8_BAR; }
    }
    PG8_WAIT_V(0);
    if constexpr (!ALIGN_EPI) { if (wr == 0) PG8_BAR; }
    PG8_BAR;
    if constexpr (Epi::AFTER_DRAIN) { E.fused(acc, cur, wr, wc, fr, fq, lds, wid, lane); S.done(cur); }
#undef PG8_GS_TABLE
#undef PG8_GS_SCALE
#undef PG8_SA
#undef PG8_SB
#undef PG8_STAGE
#undef PG8_LDA
#undef PG8_LDB
#undef PG8_MMA
#undef PG8_HALF
#undef PG8_LD2
#undef PG8_WAIT_V
#undef PG8_WAIT_L
#undef PG8_BAR
#undef PG8_SCHED
}
}
#define XB_TMO      128
#define XB_XCNT(j)  (256  + 64 * (j))
#define XB_XSUB(j)  (1280 + 64 * (j))
#define XB_XGEN(j)  (2304 + 64 * (j))
#define XB_TOP      3328
#define XB_TOPGEN   3392
#define XCD_BAR_WORDS 3456
#define XB_SPIN_CAP (1u << 20)

__device__ __forceinline__ unsigned xb_ld(unsigned* p)              { return __hip_atomic_load(p, __ATOMIC_RELAXED, __HIP_MEMORY_SCOPE_AGENT); }
__device__ __forceinline__ unsigned xb_add(unsigned* p, unsigned v) { return __hip_atomic_fetch_add(p, v, __ATOMIC_RELAXED, __HIP_MEMORY_SCOPE_AGENT); }
__device__ __forceinline__ unsigned xb_xcc_id() { return (unsigned)__builtin_amdgcn_s_getreg((3 << 11) | 20) & 0xFu; }
#define XB_SPIN(cond, bar) do { unsigned _sp = 0; while (cond) { __builtin_amdgcn_s_sleep(1); \
    if ((++_sp & 255u) == 0u) { if (xb_ld(&(bar)[XB_TMO])) break; if (_sp > XB_SPIN_CAP) { atomicAdd(&(bar)[XB_TMO], 1u); break; } } } } while (0)

struct XcdBarrier {
    unsigned* bar; unsigned x;
    volatile LAS unsigned* st;
};

__device__ __forceinline__ XcdBarrier xcd_barrier_post(unsigned* bar, volatile LAS unsigned* st) {
    XcdBarrier b; b.bar = bar; b.x = xb_xcc_id(); b.st = st;
    if (threadIdx.x == 0) (void)xb_add(&bar[XB_XCNT(b.x)], 1u);
    return b;
}
__device__ __forceinline__ void xcd_barrier_complete(unsigned* bar, unsigned x, unsigned& nloc, unsigned& nx) {
    const unsigned G = gridDim.x * gridDim.y * gridDim.z;
    unsigned sum, cnt, mine, sp = 0u;
    for (;;) {
        sum = 0u; cnt = 0u; mine = 0u;
#pragma unroll
        for (unsigned j = 0; j < 16; ++j) { const unsigned c = xb_ld(&bar[XB_XCNT(j)]); sum += c; cnt += (c > 0u) ? 1u : 0u; mine = (j == x) ? c : mine; }
        if (sum == G) break;
        __builtin_amdgcn_s_sleep(1);
        if ((++sp & 255u) == 0u) { if (xb_ld(&bar[XB_TMO])) break; if (sp > XB_SPIN_CAP) { atomicAdd(&bar[XB_TMO], 1u); break; } }
    }
    nloc = mine > 0u ? mine : 1u; nx = cnt > 0u ? cnt : 1u;
}

__device__ __forceinline__ void xcd_barrier(const XcdBarrier& b) {
    asm volatile("s_waitcnt vmcnt(0)" ::: "memory");
    __syncthreads();
    if (threadIdx.x == 0) {
        unsigned* bar = b.bar;
        __builtin_amdgcn_s_waitcnt(0);
        unsigned nloc = b.st[0], nx = b.st[1];
        if (nloc == 0u) { xcd_barrier_complete(bar, b.x, nloc, nx); b.st[0] = nloc; b.st[1] = nx; }
        const unsigned old = xb_add(&bar[XB_XSUB(b.x)], 1u);
        const unsigned gen = old / nloc;
        if (old + 1u == (gen + 1u) * nloc) {
            __builtin_amdgcn_fence(__ATOMIC_RELEASE, "agent");
            asm volatile("s_waitcnt vmcnt(0)" ::: "memory");
            const unsigned og = xb_add(&bar[XB_TOP], 1u);
            const unsigned tg = og / nx;
            if (og + 1u == (tg + 1u) * nx) xb_add(&bar[XB_TOPGEN], 1u);
            else XB_SPIN(xb_ld(&bar[XB_TOPGEN]) == tg, bar);
            __builtin_amdgcn_fence(__ATOMIC_ACQUIRE, "agent");
            xb_add(&bar[XB_XGEN(b.x)], 1u);
            asm volatile("s_waitcnt vmcnt(0)" ::: "memory");
        } else {
            XB_SPIN(xb_ld(&bar[XB_XGEN(b.x)]) == gen, bar);
            __builtin_amdgcn_fence(__ATOMIC_ACQUIRE, "agent");
            asm volatile("s_waitcnt vmcnt(0)" ::: "memory");
        }
    }
    __syncthreads();
}

struct WG { int tid, lane, wave, vcu, G; LAS unsigned char* lds; };

template <int MAP, bool F8>
__device__ __forceinline__ void transpose_item(const float* W, int K, int ldw, int Npad, void* WT, LAS unsigned char* scr, int item, int lane, float wscale, const float* kgain) {
    const int nblk = Npad / 128, kb = item / nblk, nb = item % nblk, k0 = 64 * kb, n0 = 128 * nb;
    const int r = lane >> 5, c4 = lane & 31;
    int sc = n0 + 4 * c4; if (MAP == 1) sc = inproj_src_col(sc);
    constexpr int EB = F8 ? 1 : 2;
    constexpr int ROWB = 64 * EB, NCH = ROWB / 16;
#pragma unroll
    for (int hb = 0; hb < 2; ++hb) {
        f32x4 v[16];
#pragma unroll
        for (int i = 0; i < 16; ++i) { const int k = k0 + 32 * r + 16 * hb + i;
            v[i] = (sc >= 0) ? *(const f32x4*)(W + (size_t)k * ldw + sc) : (f32x4){0.f, 0.f, 0.f, 0.f}; }
        if (kgain) {
#pragma unroll
            for (int i = 0; i < 16; ++i) v[i] = v[i] * kgain[k0 + 32 * r + 16 * hb + i]; }
#pragma unroll
        for (int j = 0; j < 4; ++j) { const int n = 4 * c4 + j;
            if constexpr (F8) { u32x4 w;
                w.x = pack4_fp8(v[0][j] * wscale, v[1][j] * wscale, v[2][j] * wscale, v[3][j] * wscale); w.y = pack4_fp8(v[4][j] * wscale, v[5][j] * wscale, v[6][j] * wscale, v[7][j] * wscale);
                w.z = pack4_fp8(v[8][j] * wscale, v[9][j] * wscale, v[10][j] * wscale, v[11][j] * wscale); w.w = pack4_fp8(v[12][j] * wscale, v[13][j] * wscale, v[14][j] * wscale, v[15][j] * wscale);
                *(LAS u32x4*)(scr + n * ROWB + ((((2 * r + hb)) ^ ((n >> 2) & (NCH - 1))) << 4)) = w; }
            else { u32x4 w0, w1;
                w0.x = cvt_pk_bf16(v[0][j], v[1][j]); w0.y = cvt_pk_bf16(v[2][j], v[3][j]); w0.z = cvt_pk_bf16(v[4][j], v[5][j]); w0.w = cvt_pk_bf16(v[6][j], v[7][j]);
                w1.x = cvt_pk_bf16(v[8][j], v[9][j]); w1.y = cvt_pk_bf16(v[10][j], v[11][j]); w1.z = cvt_pk_bf16(v[12][j], v[13][j]); w1.w = cvt_pk_bf16(v[14][j], v[15][j]);
                *(LAS u32x4*)(scr + n * ROWB + (((4 * r + 2 * hb) ^ ((n >> 2) & (NCH - 1))) << 4)) = w0;
                *(LAS u32x4*)(scr + n * ROWB + (((4 * r + 2 * hb + 1) ^ ((n >> 2) & (NCH - 1))) << 4)) = w1; } }
    }
    LDS_WAIT();
#pragma unroll
    for (int t = 0; t < 2 * NCH; ++t) { const int n = lane / NCH + (64 / NCH) * t, c = lane % NCH;
        const u32x4 w = *(const LAS u32x4*)(scr + n * ROWB + ((c ^ ((n >> 2) & (NCH - 1))) << 4));
        *(u32x4*)((unsigned char*)WT + ((size_t)(n0 + n) * K + k0) * EB + c * 16) = w; }
    LDS_WAIT();
}
struct LayerW { const float *w_in, *w_uq, *w_ukv, *w_out, *w_up, *w_down; };
constexpr int CONV_ITEMS = (DM / 64) * (INP / 128) + (QRANK / 64) * (768 / 128) + (KVRANK / 64) * (1024 / 128) + (MIXW / 64) * (DM / 128) + (DM / 64) * (DFF2 / 128) + (DFF / 64) * (DM / 128);
constexpr int CONV_SPLIT = 3456;
__device__ __forceinline__ void convert_item(const WG& g, const float* const* in, unsigned char* ws, int l, int it) {
    LAS unsigned char* scr = g.lds + g.wave * 16384;
    constexpr int I_IN = (DM / 64) * (INP / 128), I_UQ = (QRANK / 64) * (768 / 128), I_UKV = (KVRANK / 64) * (1024 / 128), I_OUT = (MIXW / 64) * (DM / 128),
                  I_UP = (DM / 64) * (DFF2 / 128), I_DOWN = (DFF / 64) * (DM / 128), I_LAYER = I_IN + I_UQ + I_UKV + I_OUT + I_UP + I_DOWN;
    static_assert(I_LAYER == CONV_ITEMS, "item count");
    unsigned char* wl = ws + WS_W + (size_t)l * W_LAYER;
    int r = it;
    if (r < I_IN) { transpose_item<1, false>(in[2] + (size_t)l * DM * INW, DM, INW, INP, wl + W_IN, scr, r, g.lane, 1.f, in[1] + (size_t)l * DM); return; } r -= I_IN;
    if (r < I_UQ) { transpose_item<0, false>(in[10] + (size_t)l * QRANK * 768, QRANK, 768, 768, wl + W_UQ, scr, r, g.lane, 1.f, in[8] + (size_t)l * QRANK); return; } r -= I_UQ;
    if (r < I_UKV) { transpose_item<0, false>(in[11] + (size_t)l * KVRANK * 1024, KVRANK, 1024, 1024, wl + W_UKV, scr, r, g.lane, 1.f, in[9] + (size_t)l * KVRANK); return; } r -= I_UKV;
    if (r < I_OUT) { transpose_item<0, false>(in[15] + (size_t)l * MIXW * DM, MIXW, DM, DM, wl + W_OUT, scr, r, g.lane, 1.f, in[14] + (size_t)l * MIXW); return; } r -= I_OUT;
    if (r < I_UP) { transpose_item<0, FFN_FP8>(in[17] + (size_t)l * DM * DFF2, DM, DFF2, DFF2, wl + W_UP, scr, r, g.lane, WUP_SCALE, in[16] + (size_t)l * DM); return; } r -= I_UP;
    transpose_item<0, FFN_FP8>(in[20] + (size_t)l * DFF * DM, DFF, DM, DM, wl + W_DOWN, scr, r, g.lane, WDOWN_SCALE, nullptr);
}
__device__ __forceinline__ void convert_layer(const WG& g, const float* const* in, unsigned char* ws, int l, int widx, int nw, int it0 = 0, int it1 = CONV_ITEMS) {
    for (int it = it0 + widx; it < it1; it += nw) convert_item(g, in, ws, l, it);
}
__device__ __forceinline__ void prologue_phase(const WG& g, const float* const* in, unsigned char* ws) {
    convert_layer(g, in, ws, 0, g.vcu * NWAVES + g.wave, g.G * NWAVES);
    float* cosC = (float*)(ws + WS_COSC); float* sinC = (float*)(ws + WS_SINC); float* cosR = (float*)(ws + WS_COSR); float* sinR = (float*)(ws + WS_SINR);
    for (int idx = (g.vcu * NWAVES + g.wave) * 64 + g.lane; idx < SEQ * 96; idx += g.G * NWAVES * 64) {
        const bool isC = idx < SEQ * 64; const int j = isC ? idx : idx - SEQ * 64;
        const int pos = isC ? (j >> 6) : (j >> 5), i = isC ? (j & 63) : (j & 31);
        const float ang = (float)pos * (isC ? INVF128[i] : INVF128[2 * i]);
        double rev = (double)ang * 0.15915494309189535; rev -= __builtin_rint(rev);
        const float fr = (float)rev, c = __builtin_amdgcn_cosf(fr), s = __builtin_amdgcn_sinf(fr);
        if (isC) { cosC[j] = c; sinC[j] = s; } else { cosR[j] = c; sinR[j] = s; }
    }
}

__device__ __forceinline__ void stream_init_phase(const WG& g, const float* x, bf16* XS, unsigned long long* SS) {
    const int gw = g.vcu * NWAVES + g.wave, NGW = g.G * NWAVES;
    for (int m = gw; m < M; m += NGW) {
        const f32x4* xr = (const f32x4*)(x + (size_t)m * DM) + g.lane;
        f32x4 v[8]; float s = 0.f;
#pragma unroll
        for (int j = 0; j < 8; ++j) { v[j] = xr[64 * j]; s += (v[j].x * v[j].x + v[j].y * v[j].y) + (v[j].z * v[j].z + v[j].w * v[j].w); }
        s = wave_sum(s);
        if (g.lane == 0) SS[m] = (unsigned long long)(s * 16777216.f);
        u32x2* o8 = (u32x2*)(XS + (size_t)m * DM) + g.lane;
#pragma unroll
        for (int j = 0; j < 8; ++j) { u32x2 w; w.x = cvt_pk_bf16(v[j].x, v[j].y); w.y = cvt_pk_bf16(v[j].z, v[j].w); o8[64 * j] = w; }
    }
}

__device__ __forceinline__ float log_sigmoid_f(float x) { return fminf(x, 0.f) - log1pf(expf(-fabsf(x))); }

__device__ __forceinline__ void head_norm128(const bf16* p, const float* gain, int hl, int li, float (&v)[8]) {
    unpack8(*(const u32x4*)(p + hl * 128 + li * 8), v);
    float ss = 0.f;
#pragma unroll
    for (int j = 0; j < 8; ++j) ss += v[j] * v[j];
    const float rstd = rsqrtf(sum16(ss) * (1.f / 128) + EPS);
    const f32x4 g0 = *(const f32x4*)(gain + li * 8), g1 = *(const f32x4*)(gain + li * 8 + 4);
#pragma unroll
    for (int j = 0; j < 4; ++j) { v[j] = v[j] * rstd * g0[j]; v[4 + j] = v[4 + j] * rstd * g1[j]; }
}
template <int NV>
__device__ __forceinline__ void rope_group(float (&v)[NV], const float* cs, const float* sn, int li) {
#pragma unroll
    for (int j = 0; j < NV; ++j) { const float pv = dppf<0x128>(v[j]); const float c = cs[j], s = sn[j];
        v[j] = (li < 8) ? (v[j] * c - pv * s) : (pv * s + v[j] * c); }
}

struct Prep { bf16* PROJ; bf16* OUT; bf16* QDR; bf16* QOUT; const bf16* KVR; bf16* KD; const float *fox_q, *fox_k, *moba_q, *moba_k, *q_g, *k_g, *b_forget; float* LF; float* KMS;
              const float *cosC, *sinC, *cosR, *sinR; unsigned* KMAX; };
__device__ __forceinline__ void mla_norm_rope(float (&n8)[8], float (&r4)[4], const float* gain, const float* cosR, const float* sinR, int pos, int li) {
    float ss = 0.f;
#pragma unroll
    for (int j = 0; j < 8; ++j) ss += n8[j] * n8[j];
#pragma unroll
    for (int j = 0; j < 4; ++j) ss += r4[j] * r4[j];
    const float rstd = rsqrtf(sum16(ss) * (1.f / QKD) + EPS);
    const f32x4 g0 = *(const f32x4*)(gain + li * 8), g1 = *(const f32x4*)(gain + li * 8 + 4), g2 = *(const f32x4*)(gain + 128 + li * 4);
#pragma unroll
    for (int j = 0; j < 4; ++j) { n8[j] = n8[j] * rstd * g0[j]; n8[4 + j] = n8[4 + j] * rstd * g1[j]; r4[j] = r4[j] * rstd * g2[j]; }
    const f32x4 c = *(const f32x4*)(cosR + pos * 32 + (li & 7) * 4), s = *(const f32x4*)(sinR + pos * 32 + (li & 7) * 4);
    float cs[4] = {c[0], c[1], c[2], c[3]}, sn[4] = {s[0], s[1], s[2], s[3]};
    rope_group<4>(r4, cs, sn, li);
}
struct PrepRaw { u32x4 aq, ak, cq, ck, qn, kn; u32x2 qr, kr; unsigned fw; f32x4 cc0, cc1, sc0, sc1, cr, sr; };
__device__ __forceinline__ PrepRaw prep_load(const Prep& P, int m, int hl, int li, int lane) {
    PrepRaw r; const bf16* row = P.PROJ + (size_t)m * INP; const int pos = m & (SEQ - 1);
    r.aq = *(const u32x4*)(row + C_AQ + hl * 128 + li * 8); r.ak = *(const u32x4*)(row + C_AK + hl * 128 + li * 8);
    r.cq = *(const u32x4*)(row + C_CQ + hl * 128 + li * 8); r.ck = *(const u32x4*)(row + C_CK + hl * 128 + li * 8);
    const bf16* qp = P.QDR + (size_t)m * 768 + hl * 192; r.qn = *(const u32x4*)(qp + li * 8); r.qr = *(const u32x2*)(qp + 128 + li * 4);
    r.kn = *(const u32x4*)(P.KVR + (size_t)m * 1024 + hl * 256 + li * 8); r.kr = *(const u32x2*)(row + C_DKR + li * 4);
    r.fw = (lane < 4) ? (unsigned)row[C_AF + lane] : 0u;
    const float* cp = P.cosC + pos * 64 + (li & 7) * 8; const float* sp = P.sinC + pos * 64 + (li & 7) * 8;
    r.cc0 = *(const f32x4*)cp; r.cc1 = *(const f32x4*)(cp + 4); r.sc0 = *(const f32x4*)sp; r.sc1 = *(const f32x4*)(sp + 4);
    r.cr = *(const f32x4*)(P.cosR + pos * 32 + (li & 7) * 4); r.sr = *(const f32x4*)(P.sinR + pos * 32 + (li & 7) * 4);
    return r;
}
__device__ __forceinline__ void norm128(u32x4 raw, const float (&gn)[8], float (&v)[8]) {
    unpack8(raw, v); float ss = 0.f;
#pragma unroll
    for (int j = 0; j < 8; ++j) ss += v[j] * v[j];
    const float rstd = rsqrtf(sum16(ss) * (1.f / 128) + EPS);
#pragma unroll
    for (int j = 0; j < 8; ++j) v[j] = v[j] * rstd * gn[j];
}
__device__ __forceinline__ void mla192(u32x4 rawn, u32x2 rawr, const float (&gn)[8], const float (&gr)[4], f32x4 c, f32x4 s, int li, float (&n8)[8], float (&r4)[4]) {
    unpack8(rawn, n8);
    r4[0] = __uint_as_float(rawr.x << 16); r4[1] = __uint_as_float(rawr.x & 0xffff0000u); r4[2] = __uint_as_float(rawr.y << 16); r4[3] = __uint_as_float(rawr.y & 0xffff0000u);
    float ss = 0.f;
#pragma unroll
    for (int j = 0; j < 8; ++j) ss += n8[j] * n8[j];
#pragma unroll
    for (int j = 0; j < 4; ++j) ss += r4[j] * r4[j];
    const float rstd = rsqrtf(sum16(ss) * (1.f / QKD) + EPS);
#pragma unroll
    for (int j = 0; j < 8; ++j) n8[j] = n8[j] * rstd * gn[j];
#pragma unroll
    for (int j = 0; j < 4; ++j) r4[j] = r4[j] * rstd * gr[j];
    float cs[4] = {c[0], c[1], c[2], c[3]}, sn[4] = {s[0], s[1], s[2], s[3]};
    rope_group<4>(r4, cs, sn, li);
}
__device__ __forceinline__ void prep_phase(const WG& g, const Prep& P) {
    LAS float* kacc = (LAS float*)g.lds;
    const int hl = g.lane >> 4, li = g.lane & 15;
    float gfq[8], gfk[8], gmq[8], gmk[8], gqn[8], gkn[8], gqr[4], gkr[4];
#pragma unroll
    for (int j = 0; j < 8; ++j) { gfq[j] = P.fox_q[li * 8 + j]; gfk[j] = P.fox_k[li * 8 + j]; gmq[j] = P.moba_q[li * 8 + j]; gmk[j] = P.moba_k[li * 8 + j]; gqn[j] = P.q_g[li * 8 + j]; gkn[j] = P.k_g[li * 8 + j]; }
#pragma unroll
    for (int j = 0; j < 4; ++j) { gqr[j] = P.q_g[128 + li * 4 + j]; gkr[j] = P.k_g[128 + li * 4 + j]; }
    const float bfg = (g.lane < 4) ? P.b_forget[g.lane] : 0.f;
    for (int chunk = g.vcu; chunk < M / 64; chunk += g.G) {
        float ksum[8]; float kmx = 0.f;
#pragma unroll
        for (int j = 0; j < 8; ++j) ksum[j] = 0.f;
        const int mb = chunk * 64 + g.wave * 8;
        PrepRaw raw = prep_load(P, mb, hl, li, g.lane);
        for (int rr = 0; rr < 8; ++rr) {
            const int m = mb + rr;
            PrepRaw nxt = raw; if (rr < 7) nxt = prep_load(P, m + 1, hl, li, g.lane);
            bf16* orow = P.OUT + (size_t)m * INP;
            float v[8];
            norm128(raw.aq, gfq, v); *(u32x4*)(orow + C_AQ + hl * 128 + li * 8) = pack8(v);
            norm128(raw.ak, gfk, v); *(u32x4*)(orow + C_AK + hl * 128 + li * 8) = pack8(v);
            { float kn2 = 0.f;
#pragma unroll
              for (int j = 0; j < 8; ++j) kn2 += v[j] * v[j];
              kmx = fmaxf(kmx, sum16(kn2)); }
            float cs[8], sn[8];
#pragma unroll
            for (int j = 0; j < 4; ++j) { cs[j] = raw.cc0[j]; cs[4 + j] = raw.cc1[j]; sn[j] = raw.sc0[j]; sn[4 + j] = raw.sc1[j]; }
            norm128(raw.cq, gmq, v); rope_group<8>(v, cs, sn, li); *(u32x4*)(orow + C_CQ + hl * 128 + li * 8) = pack8(v);
            norm128(raw.ck, gmk, v); rope_group<8>(v, cs, sn, li); *(u32x4*)(orow + C_CK + hl * 128 + li * 8) = pack8(v);
#pragma unroll
            for (int j = 0; j < 8; ++j) ksum[j] += v[j];
            { float n8[8], r4[4];
              mla192(raw.qn, raw.qr, gqn, gqr, raw.cr, raw.sr, li, n8, r4);
              bf16* qo = P.QOUT + (size_t)m * 768 + hl * 192;
              *(u32x4*)(qo + li * 8) = pack8(n8); u32x2 o; o.x = cvt_pk_bf16(r4[0], r4[1]); o.y = cvt_pk_bf16(r4[2], r4[3]); *(u32x2*)(qo + 128 + li * 4) = o; }
            { float n8[8], r4[4];
              mla192(raw.kn, raw.kr, gkn, gkr, raw.cr, raw.sr, li, n8, r4);
              bf16* kp = P.KD + (size_t)m * 768 + hl * 192;
              *(u32x4*)(kp + li * 8) = pack8(n8); u32x2 o; o.x = cvt_pk_bf16(r4[0], r4[1]); o.y = cvt_pk_bf16(r4[2], r4[3]); *(u32x2*)(kp + 128 + li * 4) = o; }
            if (g.lane < 4) P.LF[(size_t)m * 4 + g.lane] = log_sigmoid_f(bf2f(raw.fw) + bfg);
            raw = nxt;
        }
#pragma unroll
        for (int j = 0; j < 8; ++j) kacc[g.wave * 512 + hl * 128 + li * 8 + j] = ksum[j];
        if (li == 0) kacc[4096 + g.wave * 4 + hl] = kmx;
        __syncthreads();
        if (g.tid < 4) { float t = kacc[4096 + g.tid];
#pragma unroll
            for (int w = 1; w < 8; ++w) t = fmaxf(t, kacc[4096 + w * 4 + g.tid]);
            __hip_atomic_fetch_max(P.KMAX + ((chunk >> 6) * 4 + g.tid) * 16, __float_as_uint(t), __ATOMIC_RELAXED, __HIP_MEMORY_SCOPE_AGENT); }
        { float t = 0.f;
#pragma unroll
          for (int w = 0; w < 8; ++w) t += kacc[w * 512 + g.tid];
          P.KMS[(size_t)chunk * 512 + g.tid] = t; }
        __syncthreads();
    }
}

__device__ __forceinline__ void groupnorm_phase(const WG& g, bf16* O, const float* gain, bf16* OUT) {
    const int gw = g.vcu * NWAVES + g.wave, NGW = g.G * NWAVES;
    for (int m = gw; m < M; m += NGW) {
        bf16* row = O + (size_t)m * MIXW + g.lane * 8; bf16* orow = OUT + (size_t)m * MIXW + g.lane * 8;
#pragma unroll
        for (int grp = 0; grp < 4; ++grp) { float v[8]; unpack8(*(const u32x4*)(row + grp * GW), v); float ss = 0.f;
#pragma unroll
            for (int j = 0; j < 8; ++j) ss += v[j] * v[j];
            const float rstd = rsqrtf(wave_sum(ss) * (1.f / GW) + EPS);
            const f32x4 g0 = *(const f32x4*)(gain + grp * GW + g.lane * 8), g1 = *(const f32x4*)(gain + grp * GW + g.lane * 8 + 4);
#pragma unroll
            for (int j = 0; j < 4; ++j) { v[j] = v[j] * rstd * g0[j]; v[4 + j] = v[4 + j] * rstd * g1[j]; }
            *(u32x4*)(orow + grp * GW) = pack8(v); }
    }
}

__device__ __forceinline__ void convgate_phase(const WG& g, const bf16* U, const float* cw, const float* cb, bf16* ACT) {
    const int gw = g.vcu * NWAVES + g.wave, NGW = g.G * NWAVES;
    for (int u = gw; u < (M / 32) * 11; u += NGW) {
        const int cblk = u % 11, rc = u / 11, m0 = rc * 32, c0 = cblk * 512 + g.lane * 8;
        float w0[16], w1[16], w2[16], bb[16];
#pragma unroll
        for (int half = 0; half < 2; ++half) { const int c = c0 + half * DFF;
#pragma unroll
            for (int q = 0; q < 2; ++q) { const f32x4 a = *(const f32x4*)(cw + c + 4 * q), b = *(const f32x4*)(cw + DFF2 + c + 4 * q), d = *(const f32x4*)(cw + 2 * DFF2 + c + 4 * q), e = *(const f32x4*)(cb + c + 4 * q);
#pragma unroll
                for (int j = 0; j < 4; ++j) { w0[half * 8 + q * 4 + j] = a[j]; w1[half * 8 + q * 4 + j] = b[j]; w2[half * 8 + q * 4 + j] = d[j]; bb[half * 8 + q * 4 + j] = e[j]; } } }
        float p2[16], p1[16];
        if ((m0 & (SEQ - 1)) == 0) {
#pragma unroll
            for (int j = 0; j < 16; ++j) { p2[j] = 0.f; p1[j] = 0.f; }
        } else {
            float t[8];
            unpack8(*(const u32x4*)(U + (size_t)(m0 - 2) * DFF2 + c0), t);
#pragma unroll
            for (int j = 0; j < 8; ++j) p2[j] = t[j];
            unpack8(*(const u32x4*)(U + (size_t)(m0 - 2) * DFF2 + DFF + c0), t);
#pragma unroll
            for (int j = 0; j < 8; ++j) p2[8 + j] = t[j];
            unpack8(*(const u32x4*)(U + (size_t)(m0 - 1) * DFF2 + c0), t);
#pragma unroll
            for (int j = 0; j < 8; ++j) p1[j] = t[j];
            unpack8(*(const u32x4*)(U + (size_t)(m0 - 1) * DFF2 + DFF + c0), t);
#pragma unroll
            for (int j = 0; j < 8; ++j) p1[8 + j] = t[j];
        }
        for (int r0 = 0; r0 < 32; r0 += 8) {
            u32x4 gl[8], vl[8];
#pragma unroll
            for (int q = 0; q < 8; ++q) { gl[q] = *(const u32x4*)(U + (size_t)(m0 + r0 + q) * DFF2 + c0); vl[q] = *(const u32x4*)(U + (size_t)(m0 + r0 + q) * DFF2 + DFF + c0); }
#pragma unroll
            for (int q = 0; q < 8; ++q) {
                float cur[16], t[8];
                unpack8(gl[q], t);
#pragma unroll
                for (int j = 0; j < 8; ++j) cur[j] = t[j];
                unpack8(vl[q], t);
#pragma unroll
                for (int j = 0; j < 8; ++j) cur[8 + j] = t[j];
                float o[8];
#pragma unroll
                for (int j = 0; j < 8; ++j) {
                    const float gt = bb[j] + w0[j] * p2[j] + w1[j] * p1[j] + w2[j] * cur[j];
                    const float vl_ = bb[8 + j] + w0[8 + j] * p2[8 + j] + w1[8 + j] * p1[8 + j] + w2[8 + j] * cur[8 + j];
                    o[j] = gt * __builtin_amdgcn_rcpf(1.f + __builtin_amdgcn_exp2f(gt * -1.4426950408889634f)) * vl_;
                }
                if constexpr (FFN_FP8) { u32x2 w; w.x = pack4_fp8(o[0], o[1], o[2], o[3]); w.y = pack4_fp8(o[4], o[5], o[6], o[7]); *(u32x2*)((unsigned char*)ACT + (size_t)(m0 + r0 + q) * DFF + c0) = w; }
                else *(u32x4*)(ACT + (size_t)(m0 + r0 + q) * DFF + c0) = pack8(o);
#pragma unroll
                for (int j = 0; j < 16; ++j) { p2[j] = p1[j]; p1[j] = cur[j]; }
            }
        }
    }
}

namespace att {
enum { T_FOX = 0, T_STICK = 1, T_MOBA = 2, T_MLA = 3 };
#ifndef PROBE_T
#define PROBE_T 0
#endif
#ifndef PROBE_BLK
#define PROBE_BLK 0
#endif
#define ATP_BEGIN(id) do { if (PROBE_T == (id) && blockIdx.x == PROBE_BLK && threadIdx.x == 0) ((volatile LAS unsigned long long*)(lds + MISC_OFF + 96))[1] = __builtin_amdgcn_s_memrealtime(); } while (0)
#define ATP_END(id) do { if (PROBE_T == (id) && blockIdx.x == PROBE_BLK && threadIdx.x == 0) ((volatile LAS unsigned long long*)(lds + MISC_OFF + 96))[0] += __builtin_amdgcn_s_memrealtime() - ((volatile LAS unsigned long long*)(lds + MISC_OFF + 96))[1]; } while (0)
constexpr int KVB = 64, SHM_K = 16384, SHM_V = 16384, SHM_KR = 8192;
constexpr int NSLOT = 3, OFF_K = 0, OFF_V = 49152, OFF_KR = 98304, OFF_AUX = 98304, OFF_WS = 122880, OFF_MISC = 124928;
#define KSWZ(row, colB) ((row) * 256 + ((colB) ^ (((row) & 7) << 4)))
__device__ __forceinline__ int v_st(int k, int c) { const int kk = (k & ~0xC) | ((k & 4) << 1) | ((k & 8) >> 1); return ((kk >> 3) * 4 + (c >> 5)) * 512 + ((kk & 7) * 32 + (c & 31)) * 2; }
__device__ __forceinline__ int v_rd_base(int lane) { return ((lane & 3) << 3) | (((lane >> 2) & 3) << 6) | (((lane >> 4) & 1) << 5) | (((lane >> 5) & 1) << 8); }
constexpr int v_rd_off(int d0, int ks, int half) { return d0 * 512 + ks * 4096 + half * 2048; }
__device__ __forceinline__ int crow(int r, int hi) { return (r & 3) + 8 * (r >> 2) + 4 * hi; }

__device__ __forceinline__ void pack_p(const f32x16& p0, const f32x16& p1, bf16x8& pa0, bf16x8& pa1, bf16x8& pa2, bf16x8& pa3) {
#define PK4(P, B_, OUT) do { unsigned a0 = cvt_pk_bf16(P[B_+0], P[B_+1]), a1 = cvt_pk_bf16(P[B_+2], P[B_+3]);                          \
        unsigned b0 = cvt_pk_bf16(P[B_+4], P[B_+5]), b1 = cvt_pk_bf16(P[B_+6], P[B_+7]);                                             \
        auto r0 = __builtin_amdgcn_permlane32_swap(a0, b0, false, false); auto r1 = __builtin_amdgcn_permlane32_swap(a1, b1, false, false); \
        u32x4 w = {r0[0], r1[0], r0[1], r1[1]}; OUT = *reinterpret_cast<bf16x8*>(&w); } while (0)
    PK4(p0, 0, pa0); PK4(p0, 8, pa1); PK4(p1, 0, pa2); PK4(p1, 8, pa3);
#undef PK4
}
__device__ __forceinline__ void softmax_tile(f32x16& p0, f32x16& p1, float& m_reg, float& l_reg, float& alpha, const float SCALE, const float C2) {
    float pmax = p0[0];
#pragma unroll
    for (int r = 1; r < 16; ++r) pmax = fmaxf(pmax, p0[r]);
#pragma unroll
    for (int r = 0; r < 16; ++r) pmax = fmaxf(pmax, p1[r]);
    { auto rr = __builtin_amdgcn_permlane32_swap(__float_as_uint(pmax), __float_as_uint(pmax), false, false);
      pmax = fmaxf(__uint_as_float(rr[0]), __uint_as_float(rr[1])); }
    float mn;
    if (__builtin_expect(__all((pmax - m_reg) * SCALE <= 8.f), 1)) { mn = m_reg; alpha = 1.f; }
    else { mn = fmaxf(m_reg, pmax); alpha = __builtin_amdgcn_exp2f((m_reg - mn) * C2); m_reg = mn; }
    const float mnL = -mn * C2;
#pragma unroll
    for (int r = 0; r < 16; ++r) { p0[r] = __builtin_amdgcn_exp2f(fmaf(p0[r], C2, mnL)); p1[r] = __builtin_amdgcn_exp2f(fmaf(p1[r], C2, mnL)); }
    float ps = 0.f;
#pragma unroll
    for (int r = 0; r < 16; ++r) ps += p0[r];
#pragma unroll
    for (int r = 0; r < 16; ++r) ps += p1[r];
    { auto rr = __builtin_amdgcn_permlane32_swap(__float_as_uint(ps), __float_as_uint(ps), false, false);
      ps = __uint_as_float(rr[0]) + __uint_as_float(rr[1]); }
    l_reg = l_reg * alpha + ps;
}
__device__ __forceinline__ void pv_tile(f32x16* o, int vb0, bf16x8 pa0, bf16x8 pa1, bf16x8 pa2, bf16x8 pa3) {
#define TRRD(dst, off) asm volatile("ds_read_b64_tr_b16 %0, %1 offset:%2" : "=&v"(dst) : "v"(vb0), "i"(off) : "memory")
#define PV_D0(d0) do { s16x4 l0, l1, l2, l3, h0, h1, h2, h3; constexpr int b_ = v_rd_off(d0, 0, 0);   \
        TRRD(l0, b_); TRRD(h0, b_ + 2048); TRRD(l1, b_ + 4096); TRRD(h1, b_ + 6144); TRRD(l2, b_ + 8192); TRRD(h2, b_ + 10240); TRRD(l3, b_ + 12288); TRRD(h3, b_ + 14336); \
        asm volatile("s_waitcnt lgkmcnt(0)" ::: "memory"); SBAR();   \
        o[d0] = __builtin_amdgcn_mfma_f32_32x32x16_bf16(pa0, (bf16x8){l0[0], l0[1], l0[2], l0[3], h0[0], h0[1], h0[2], h0[3]}, o[d0], 0, 0, 0);   \
        o[d0] = __builtin_amdgcn_mfma_f32_32x32x16_bf16(pa1, (bf16x8){l1[0], l1[1], l1[2], l1[3], h1[0], h1[1], h1[2], h1[3]}, o[d0], 0, 0, 0);   \
        o[d0] = __builtin_amdgcn_mfma_f32_32x32x16_bf16(pa2, (bf16x8){l2[0], l2[1], l2[2], l2[3], h2[0], h2[1], h2[2], h2[3]}, o[d0], 0, 0, 0);   \
        o[d0] = __builtin_amdgcn_mfma_f32_32x32x16_bf16(pa3, (bf16x8){l3[0], l3[1], l3[2], l3[3], h3[0], h3[1], h3[2], h3[3]}, o[d0], 0, 0, 0); } while (0)
    PV_D0(0); PV_D0(1); PV_D0(2); PV_D0(3);
#undef PV_D0
#undef TRRD
}

__device__ __forceinline__ int moba_k0(unsigned um, int i) { unsigned mm = um; for (int j = 0; j < (i >> 2); ++j) mm &= mm - 1; return (__ffs(mm) - 1) * 256 + (i & 3) * 64; }
struct Tensors {
    const bf16* Q; const bf16* K; const bf16* V; int ldq, ldk, ldv;
    int qh, kh, vh, grp;
    bf16* O;
    const float* LF; const float* KMS; const unsigned* KMAX; unsigned long long* SSG;
};

template <int TYPE>
__device__ __forceinline__ void attn_item(const Tensors& T, int b, int h, int qb, LAS unsigned char* lds, unsigned ldsb) {
    constexpr bool FOX = TYPE == T_FOX, STICK = TYPE == T_STICK, MOBA = TYPE == T_MOBA, MLA = TYPE == T_MLA;
    constexpr int NKS = MLA ? 12 : 8;
    const float SCALE = MLA ? 0.07216878364870322f : 0.08838834764831845f;
    const float C2 = SCALE * 1.4426950408889634f;
    int tid_ = threadIdx.x; asm volatile("" : "+v"(tid_));
    const int tid = tid_, wid = __builtin_amdgcn_readfirstlane(tid >> 6), lane = tid & 63, r32 = lane & 31, hi = lane >> 5;
    const int qlo = qb * 256 + wid * 32, qpos = qlo + r32;
    const size_t tok0 = (size_t)b * SEQ;
    LAS unsigned* misc = (LAS unsigned*)(lds + OFF_MISC);
    LAS float* wsf = (LAS float*)(lds + OFF_WS) + wid * 64; LAS float* li_l = wsf; LAS float* al_l = wsf + 32;
    bf16x8 qr[NKS];
    { const bf16* qp = T.Q + (tok0 + qpos) * T.ldq + h * T.qh + hi * 8;
#pragma unroll
      for (int d0 = 0; d0 < NKS; ++d0) qr[d0] = *(const bf16x8*)(qp + d0 * 16); }
    const bf16* Kp = T.K + tok0 * T.ldk + h * T.kh; const bf16* Vp = T.V + tok0 * T.ldv + h * T.vh;
    unsigned um = 0, selmask = 0; int NT = 4 * (qb + 1);
    if constexpr (MOBA) {
        { LAS float* KM = (LAS float*)(lds + OFF_AUX);
          for (int idx = tid; idx < qb * 128; idx += NWAVES * 64) { const int n = idx >> 7, d = idx & 127;
              const float* s = T.KMS + ((size_t)(b * 64 + 4 * n) * 4 + h) * 128 + d;
              KM[idx] = ((s[0] + s[512]) + (s[1024] + s[1536])) * (1.f / 256); }
          __syncthreads();
          float gate[15];
#pragma unroll
          for (int n = 0; n < 15; ++n) { gate[n] = -__builtin_inff();
              if (n < qb) { float a = 0.f;
#pragma unroll
                  for (int d0 = 0; d0 < 8; ++d0) { const f32x4 ka = *(const LAS f32x4*)(KM + n * 128 + d0 * 16 + hi * 8), kb = *(const LAS f32x4*)(KM + n * 128 + d0 * 16 + hi * 8 + 4);
                      const u32x4 w = __builtin_bit_cast(u32x4, qr[d0]);
                      a = fmaf(__uint_as_float(w[0] << 16), ka[0], a); a = fmaf(__uint_as_float(w[0] & 0xffff0000u), ka[1], a);
                      a = fmaf(__uint_as_float(w[1] << 16), ka[2], a); a = fmaf(__uint_as_float(w[1] & 0xffff0000u), ka[3], a);
                      a = fmaf(__uint_as_float(w[2] << 16), kb[0], a); a = fmaf(__uint_as_float(w[2] & 0xffff0000u), kb[1], a);
                      a = fmaf(__uint_as_float(w[3] << 16), kb[2], a); a = fmaf(__uint_as_float(w[3] & 0xffff0000u), kb[3], a); }
                  gate[n] = a + __shfl_xor(a, 32); } }
#pragma unroll
          for (int pass = 0; pass < 3; ++pass) { float best = -__builtin_inff(); int bi = -1;
#pragma unroll
              for (int n = 0; n < 15; ++n) { if (n < qb && !((selmask >> n) & 1u) && gate[n] > best) { best = gate[n]; bi = n; } }
              if (bi >= 0) selmask |= 1u << bi; } }
        unsigned w = selmask;
#pragma unroll
        for (int o = 1; o < 64; o <<= 1) w |= __shfl_xor(w, o);
        if (lane == 0) __hip_atomic_fetch_or(&misc[1], w, __ATOMIC_RELAXED, __HIP_MEMORY_SCOPE_WORKGROUP);
        __syncthreads();
        um = misc[1] | (1u << qb); NT = 4 * __popc(um);
    }
#define tile_k0(i_) ((STICK || FOX) ? 64 * (NT - 1 - (i_)) : MOBA ? moba_k0(um, (i_)) : 64 * (i_))
    int dk[2], dv[2], dr = 0;
#pragma unroll
    for (int c2 = 0; c2 < 2; ++c2) { const int off = (wid + 8 * c2) * 1024 + lane * 16;
        { const int row = off >> 8, ch = ((off >> 4) & 15) ^ (row & 15); dk[c2] = row * T.ldk + ch * 8; }
        { const int sub = off >> 9, within = off & 511, kk = (sub >> 2) * 8 + (within >> 6), key = (kk & ~0xC) | ((kk & 4) << 1) | ((kk & 8) >> 1), col = (sub & 3) * 32 + ((within & 63) >> 1); dv[c2] = key * T.ldv + col; } }
    if constexpr (MLA) { const int off = wid * 1024 + lane * 16, row = off >> 7, ch = ((off >> 4) & 7) ^ ((row >> 1) & 7); dr = row * T.ldk + 128 + ch * 8; }
    LAS float* cfl = (LAS float*)(lds + OFF_AUX);
    if constexpr (FOX) { LAS double* dsum = (LAS double*)(lds + OFF_AUX + 16384);
        const int nk = 256 * (qb + 1); double loc[8], run = 0.0;
        if (8 * tid < nk) {
#pragma unroll
            for (int j = 0; j < 8; ++j) { run += (double)T.LF[(tok0 + 8 * tid + j) * 4 + h]; loc[j] = run; } }
        double inc = run;
#pragma unroll
        for (int o = 1; o < 64; o <<= 1) { const double t = __shfl_up(inc, o); if (lane >= o) inc += t; }
        if (lane == 63) dsum[wid] = inc;
        __syncthreads();
        double off = inc - run;
        for (int w = 0; w < wid; ++w) off += dsum[w];
        if (8 * tid < nk) {
#pragma unroll
            for (int j = 0; j < 8; ++j) cfl[8 * tid + j] = (float)(off + loc[j]); }
        __syncthreads(); }
    constexpr int DMA_CNT = MLA ? 5 : 4;
#define TILE_DMA(k0_, slot_) do { const int k0s = (k0_), sl_ = (slot_); const bf16* kt_ = Kp + (size_t)k0s * T.ldk; const bf16* vt_ = Vp + (size_t)k0s * T.ldv; \
        __builtin_amdgcn_global_load_lds((const unsigned*)(kt_ + dk[0]), (LAS unsigned*)(lds + OFF_K + sl_ * SHM_K + wid * 1024), 16, 0, 0); \
        __builtin_amdgcn_global_load_lds((const unsigned*)(kt_ + dk[1]), (LAS unsigned*)(lds + OFF_K + sl_ * SHM_K + (wid + 8) * 1024), 16, 0, 0); \
        __builtin_amdgcn_global_load_lds((const unsigned*)(vt_ + dv[0]), (LAS unsigned*)(lds + OFF_V + sl_ * SHM_V + wid * 1024), 16, 0, 0); \
        __builtin_amdgcn_global_load_lds((const unsigned*)(vt_ + dv[1]), (LAS unsigned*)(lds + OFF_V + sl_ * SHM_V + (wid + 8) * 1024), 16, 0, 0); \
        if constexpr (MLA) __builtin_amdgcn_global_load_lds((const unsigned*)(kt_ + dr), (LAS unsigned*)(lds + OFF_KR + sl_ * SHM_KR + wid * 1024), 16, 0, 0); } while (0)
    const int vrd = v_rd_base(lane);
    const int kqb = r32 * 256 + ((hi ^ (r32 & 1)) << 4), ksh = (r32 >> 1) & 7;
    float m_reg = -1e30f, l_reg = 0.f, Pst = 1.f; f32x16 o[4] = {};
    const float ci = FOX ? cfl[qpos] * 11.313708498984761f : 0.f;
    float bound_s = 0.f; bool wdone = false;
    if constexpr (FOX) { float ssq = 0.f;
#pragma unroll
        for (int d0 = 0; d0 < 8; ++d0) { const u32x4 w = __builtin_bit_cast(u32x4, qr[d0]);
#pragma unroll
            for (int e = 0; e < 4; ++e) { const float a0 = __uint_as_float(w[e] << 16), a1 = __uint_as_float(w[e] & 0xffff0000u); ssq += a0 * a0 + a1 * a1; } }
        ssq += __shfl_xor(ssq, 32);
        const float kmax2 = __uint_as_float(__hip_atomic_load(T.KMAX + (b * 4 + h) * 16, __ATOMIC_RELAXED, __HIP_MEMORY_SCOPE_AGENT));
        bound_s = sqrtf(ssq) * sqrtf(kmax2) * 1.02f; }
    ATP_BEGIN(321 + TYPE);
    unsigned long long cyc0_ = 0; if (PROBE_T == 341 + TYPE && blockIdx.x == PROBE_BLK && threadIdx.x == 0) cyc0_ = __builtin_amdgcn_s_memtime();
    if (PROBE_T == 331 + TYPE && blockIdx.x == PROBE_BLK && threadIdx.x == 0) ((volatile LAS unsigned long long*)(lds + MISC_OFF + 96))[0] += 100ull * (unsigned long long)NT;
    if (wid >= 4) __builtin_amdgcn_s_setprio(1);
    asm volatile("s_waitcnt vmcnt(0)" ::: "memory");
    TILE_DMA(tile_k0(0), 0);
    if (NT > 1) TILE_DMA(tile_k0(1), 1);
    for (int i = 0; i < NT; ++i) {
        const int cur = i % NSLOT, k0 = tile_k0(i);
        unsigned long long pb0_ = 0; if (MLA && PROBE_T == 354 && blockIdx.x == PROBE_BLK && threadIdx.x == 0) pb0_ = __builtin_amdgcn_s_memtime();
        if (i + 1 < NT) asm volatile("s_waitcnt vmcnt(%0) lgkmcnt(0)\n\ts_barrier" :: "i"(DMA_CNT) : "memory");
        else            asm volatile("s_waitcnt vmcnt(0) lgkmcnt(0)\n\ts_barrier" ::: "memory");
        if (MLA && PROBE_T == 354 && blockIdx.x == PROBE_BLK && threadIdx.x == 0) ((volatile LAS unsigned long long*)(lds + MISC_OFF + 96))[0] += (__builtin_amdgcn_s_memtime() - pb0_) >> 4;
        if constexpr (STICK || FOX) { if (i > 0) { bool alld = true;
#pragma unroll
            for (int w = 0; w < 8; ++w) alld = alld && (misc[4 + ((i - 1) & 1) * 8 + w] != 0u);
            if (alld) break; } }
        if (i + 2 < NT) TILE_DMA(tile_k0(i + 2), (i + 2) % NSLOT);
        bool act = k0 <= qlo;
        if constexpr (MOBA) { const int blk = k0 >> 8; if (blk != qb) act = __any((selmask >> blk) & 1u); }
        if constexpr (FOX) { if (wdone) act = false; }
        if (act) {
            f32x16 p0, p1; unsigned long long pc0_ = 0; if (MLA && (PROBE_T >= 351 && PROBE_T <= 354) && blockIdx.x == PROBE_BLK && threadIdx.x == 0) pc0_ = __builtin_amdgcn_s_memtime();
            if constexpr (FOX) { const LAS float* bp = cfl + k0 + 4 * hi;
#pragma unroll
                for (int gq = 0; gq < 4; ++gq) { const f32x4 c0 = *(const LAS f32x4*)(bp + 8 * gq), c1 = *(const LAS f32x4*)(bp + 32 + 8 * gq);
#pragma unroll
                    for (int q = 0; q < 4; ++q) { p0[4 * gq + q] = fmaf(c0[q], -11.313708498984761f, ci); p1[4 * gq + q] = fmaf(c1[q], -11.313708498984761f, ci); } } }
            else { p0 = f32x16{}; p1 = f32x16{}; }
            { const LAS unsigned char* kb = lds + OFF_K + cur * SHM_K;
#pragma unroll
              for (int d0 = 0; d0 < 8; ++d0) { const int ko = kqb + ((d0 ^ ksh) << 5);
                const bf16x8 b0 = *(const LAS bf16x8*)(kb + ko), b1 = *(const LAS bf16x8*)(kb + ko + 32 * 256);
                p0 = __builtin_amdgcn_mfma_f32_32x32x16_bf16(b0, qr[d0], p0, 0, 0, 0);
                p1 = __builtin_amdgcn_mfma_f32_32x32x16_bf16(b1, qr[d0], p1, 0, 0, 0); } }
            if constexpr (MLA) { const LAS unsigned char* kb = lds + OFF_KR + cur * SHM_KR + r32 * 128; const int sw = (r32 >> 1) & 7;
#pragma unroll
              for (int dd = 0; dd < 4; ++dd) { const int ko = ((2 * dd + hi) ^ sw) << 4;
                const bf16x8 b0 = *(const LAS bf16x8*)(kb + ko), b1 = *(const LAS bf16x8*)(kb + ko + 32 * 128);
                p0 = __builtin_amdgcn_mfma_f32_32x32x16_bf16(b0, qr[8 + dd], p0, 0, 0, 0);
                p1 = __builtin_amdgcn_mfma_f32_32x32x16_bf16(b1, qr[8 + dd], p1, 0, 0, 0); } }
            if (MLA && PROBE_T == 351 && blockIdx.x == PROBE_BLK && threadIdx.x == 0) ((volatile LAS unsigned long long*)(lds + MISC_OFF + 96))[0] += (__builtin_amdgcn_s_memtime() - pc0_) >> 4; if (MLA && (PROBE_T >= 351 && PROBE_T <= 354) && blockIdx.x == PROBE_BLK && threadIdx.x == 0) pc0_ = __builtin_amdgcn_s_memtime();
            bf16x8 pa0, pa1, pa2, pa3;
            if constexpr (!STICK) {
                const float NEG = -__builtin_inff();
                if constexpr (MOBA) { const int blk = k0 >> 8; if (blk != qb && !((selmask >> blk) & 1u)) {
#pragma unroll
                    for (int r = 0; r < 16; ++r) { p0[r] = NEG; p1[r] = NEG; } } }
                if (k0 + 63 > qlo) { const int dq = qpos - k0 - 4 * hi;
#pragma unroll
                    for (int r = 0; r < 16; ++r) { const int c = (r & 3) + 8 * (r >> 2); if (dq - c < 0) p0[r] = NEG; if (dq - c - 32 < 0) p1[r] = NEG; } }
                float alpha;
                softmax_tile(p0, p1, m_reg, l_reg, alpha, SCALE, C2);
                if constexpr (FOX) { const float ck0 = cfl[k0] * 11.313708498984761f;
                    wdone = __all((bound_s + ci - ck0 - m_reg) * SCALE < -30.f); }
                if (__any(alpha < 1.f)) { if (hi == 0) al_l[r32] = alpha; LDS_WAIT();
#pragma unroll
                    for (int d_ = 0; d_ < 4; ++d_)
#pragma unroll
                        for (int r = 0; r < 16; ++r) o[d_][r] *= al_l[crow(r, hi)];
                    LDS_WAIT(); }
                pack_p(p0, p1, pa0, pa1, pa2, pa3);
            } else {
                const bool needmask = k0 + 63 >= qlo; const int dq = qpos - k0 - 4 * hi;
                float Tg[8];
#pragma unroll
                for (int gq = 0; gq < 8; ++gq) {
                    float be[4], om[4];
#pragma unroll
                    for (int q = 0; q < 4; ++q) { const float s = gq < 4 ? p0[4 * gq + q] : p1[4 * (gq - 4) + q];
                        const float z2 = fminf(fmaxf(s * C2, -115.f), 115.f), e = __builtin_amdgcn_exp2f(z2);
                        float omq = __builtin_amdgcn_rcpf(1.f + e), beq = e * omq;
                        const int c = q + 8 * (gq & 3) + 32 * (gq >> 2);
                        if (needmask && !(c < dq)) { omq = 1.f; beq = 0.f; }
                        om[q] = omq; be[q] = beq; }
                    const float s2 = om[3], s1 = s2 * om[2], s0 = s1 * om[1];
                    Tg[gq] = s0 * om[0];
                    const float w0 = be[0] * s0, w1 = be[1] * s1, w2 = be[2] * s2, w3 = be[3];
                    if (gq < 4) { p0[4 * gq] = w0; p0[4 * gq + 1] = w1; p0[4 * gq + 2] = w2; p0[4 * gq + 3] = w3; }
                    else { p1[4 * (gq - 4)] = w0; p1[4 * (gq - 4) + 1] = w1; p1[4 * (gq - 4) + 2] = w2; p1[4 * (gq - 4) + 3] = w3; }
                }
                float S = Pst;
#pragma unroll
                for (int gq = 7; gq >= 0; --gq) {
                    const float oth = __shfl_xor(Tg[gq], 32);
                    const float E = hi ? S : S * oth;
                    S = S * (Tg[gq] * oth);
                    if (gq < 4) { p0[4 * gq] *= E; p0[4 * gq + 1] *= E; p0[4 * gq + 2] *= E; p0[4 * gq + 3] *= E; }
                    else { p1[4 * (gq - 4)] *= E; p1[4 * (gq - 4) + 1] *= E; p1[4 * (gq - 4) + 2] *= E; p1[4 * (gq - 4) + 3] *= E; }
                }
                Pst = S;
                pack_p(p0, p1, pa0, pa1, pa2, pa3);
            }
            if (MLA && PROBE_T == 352 && blockIdx.x == PROBE_BLK && threadIdx.x == 0) ((volatile LAS unsigned long long*)(lds + MISC_OFF + 96))[0] += (__builtin_amdgcn_s_memtime() - pc0_) >> 4; if (MLA && (PROBE_T >= 351 && PROBE_T <= 354) && blockIdx.x == PROBE_BLK && threadIdx.x == 0) pc0_ = __builtin_amdgcn_s_memtime();
            pv_tile(o, (int)(ldsb + OFF_V + cur * SHM_V) + vrd, pa0, pa1, pa2, pa3);
            if (MLA && PROBE_T == 353 && blockIdx.x == PROBE_BLK && threadIdx.x == 0) ((volatile LAS unsigned long long*)(lds + MISC_OFF + 96))[0] += (__builtin_amdgcn_s_memtime() - pc0_) >> 4;
        }
        if constexpr (STICK) { const bool dn = __all(Pst < 1e-30f); if (lane == 0) misc[4 + (i & 1) * 8 + wid] = dn ? 1u : 0u; }
        if constexpr (FOX) { if (lane == 0) misc[4 + (i & 1) * 8 + wid] = wdone ? 1u : 0u; }
    }
    float rli[16];
    if constexpr (!STICK) { if (hi == 0) li_l[r32] = l_reg; LDS_WAIT();
#pragma unroll
        for (int r = 0; r < 16; ++r) rli[r] = __builtin_amdgcn_rcpf(li_l[crow(r, hi)]); }
    ATP_END(321 + TYPE);
    if (PROBE_T == 341 + TYPE && blockIdx.x == PROBE_BLK && threadIdx.x == 0) ((volatile LAS unsigned long long*)(lds + MISC_OFF + 96))[0] += (__builtin_amdgcn_s_memtime() - cyc0_) >> 4;
    __builtin_amdgcn_s_setprio(0);
    asm volatile("s_waitcnt vmcnt(0)" ::: "memory");
    __syncthreads();
    LAS unsigned char* ost = lds + wid * 8192;
    float sq[16];
#pragma unroll
    for (int r = 0; r < 16; ++r) { const int orow = crow(r, hi); sq[r] = 0.f;
#pragma unroll
        for (int d0 = 0; d0 < 4; ++d0) { float v = o[d0][r]; if constexpr (!STICK) v *= rli[r];
            sq[r] += v * v;
            const float vn = __shfl_xor(v, 1);
            if ((r32 & 1) == 0) *(LAS unsigned*)(ost + orow * 256 + (d0 * 32 + r32) * 2) = cvt_pk_bf16(v, vn); } }
    LDS_WAIT();
    { bf16* Ow = T.O + (tok0 + qlo) * MIXW + h * HD;
#pragma unroll
      for (int k = 0; k < 8; ++k) { const int row = (lane >> 4) + 4 * k, ch = lane & 15;
          const u32x4 w = *(const LAS u32x4*)(ost + row * 256 + ch * 16);
          *(u32x4*)(Ow + (size_t)row * MIXW + ch * 8) = w; } }
#pragma unroll
    for (int r = 0; r < 16; ++r) {
#pragma unroll
        for (int s = 1; s < 32; s <<= 1) sq[r] += __shfl_xor(sq[r], s); }
    if (r32 == 0) {
#pragma unroll
        for (int r = 0; r < 16; ++r) __hip_atomic_fetch_add(T.SSG + (tok0 + qlo + crow(r, hi)) * 4 + T.grp, (unsigned long long)(sq[r] * 16777216.f), __ATOMIC_RELAXED, __HIP_MEMORY_SCOPE_AGENT); }
#undef TILE_DMA
#undef tile_k0
}

struct PhaseArgs { const bf16* PROJ; const bf16* QDR; const bf16* KVR; const bf16* KD; bf16* O; const float* LF; const float* KMS; unsigned* queue; const unsigned* KMAX; unsigned long long* SSG; int only; };
struct PairOrder { unsigned char ty[64], qb[64]; };
__host__ __device__ constexpr PairOrder make_pair_order() {
    PairOrder o{}; float cost[64] = {}; int n = 0;
    for (int ty = 0; ty < 4; ++ty) for (int qb = 0; qb < 16; ++qb) {
        const float c = ty == T_MLA ? 1.25f * (qb + 1) : ty == T_MOBA ? 1.0f * (qb + 1) + 0.5f : ty == T_FOX ? (qb + 1 < 5 ? 1.0f * (qb + 1) : 4.5f + 0.05f * qb) : (qb + 1 < 2 ? 0.6f : 0.8f + 0.01f * qb);
        int pos = n; while (pos > 0 && cost[pos - 1] < c) { cost[pos] = cost[pos - 1]; o.ty[pos] = o.ty[pos - 1]; o.qb[pos] = o.qb[pos - 1]; --pos; }
        cost[pos] = c; o.ty[pos] = (unsigned char)ty; o.qb[pos] = (unsigned char)qb; ++n; }
    return o;
}
__constant__ PairOrder PAIR_ORDER = make_pair_order();
__device__ __forceinline__ void attn_phase(const PhaseArgs& A, LAS unsigned char* lds, unsigned ldsb) {
    LAS unsigned* misc = (LAS unsigned*)(lds + OFF_MISC);
    Tensors TD, TA, TC, TB;
    TD.LF = TA.LF = TC.LF = TB.LF = A.LF; TD.KMS = TA.KMS = TC.KMS = TB.KMS = A.KMS; TD.KMAX = TA.KMAX = TC.KMAX = TB.KMAX = A.KMAX; TD.SSG = TA.SSG = TC.SSG = TB.SSG = A.SSG;
    TD.Q = A.QDR; TD.K = A.KD; TD.V = A.KVR + 128; TD.ldq = 768; TD.ldk = 768; TD.ldv = 1024; TD.qh = 192; TD.kh = 192; TD.vh = 256; TD.O = A.O + 3 * GW; TD.grp = 3;
    TA.Q = A.PROJ + C_AQ; TA.K = A.PROJ + C_AK; TA.V = A.PROJ + C_AV; TA.ldq = TA.ldk = TA.ldv = INP; TA.qh = TA.kh = TA.vh = 128; TA.O = A.O; TA.grp = 0;
    TC = TA; TC.Q = A.PROJ + C_CQ; TC.K = A.PROJ + C_CK; TC.V = A.PROJ + C_CV; TC.O = A.O + 2 * GW; TC.grp = 2;
    TB = TA; TB.Q = A.PROJ + C_BQ; TB.K = A.PROJ + C_BK; TB.V = A.PROJ + C_BV; TB.O = A.O + GW; TB.grp = 1;
    const int G = (int)gridDim.x, x0 = (int)blockIdx.x & 7, nstat = (G == 256) ? 32 : 0;
    int kq = 0;
    for (int round = 0;; ++round) {
        if (threadIdx.x == 0) { unsigned code = 0xffffffffu;
            if (round == 0 && nstat) code = (unsigned)(x0 * 128 + ((int)blockIdx.x >> 3));
            else { for (; kq < 8; ++kq) { const int q = (x0 + kq) & 7;
                       const unsigned i = (unsigned)nstat + __hip_atomic_fetch_add(A.queue + 16 * q, 1u, __ATOMIC_RELAXED, __HIP_MEMORY_SCOPE_AGENT);
                       if (i < 128u) { code = (unsigned)q * 128u + i; break; } } }
            misc[0] = code; misc[1] = 0u; }
        __syncthreads();
        const unsigned code = misc[0];
        if (code == 0xffffffffu) break;
        const int q = (int)(code >> 7), i = (int)(code & 127u), pr = i >> 1, bh = q + 8 * (i & 1), ty = PAIR_ORDER.ty[pr], qb = PAIR_ORDER.qb[pr];
        if (ty == T_MLA) attn_item<T_MLA>(TD, bh >> 2, bh & 3, qb, lds, ldsb);
        else if (ty == T_MOBA) attn_item<T_MOBA>(TC, bh >> 2, bh & 3, qb, lds, ldsb);
        else if (ty == T_FOX) attn_item<T_FOX>(TA, bh >> 2, bh & 3, qb, lds, ldsb);
        else attn_item<T_STICK>(TB, bh >> 2, bh & 3, qb, lds, ldsb);
        __syncthreads();
    }
}
}

#ifndef PROBE_DUP
#define PROBE_DUP 0
#endif
#ifndef MK_SPLIT
#define MK_SPLIT 0
#endif
constexpr int N_PHASES = 1 + 8 * DEPTH;
struct Args { const float* in[21]; float* out; unsigned char* ws; int ph_lo, ph_hi; };
__global__ void __launch_bounds__(NWAVES * 64, 2) hybrid_fwd(Args args) {
    extern __shared__ __attribute__((aligned(16))) unsigned char lds_raw[];
#define MKWG() unsigned char* ws_ = args.ws; asm volatile("" : "+s"(ws_)); WG g; { int t_ = threadIdx.x; asm volatile("" : "+v"(t_)); g.lds = (LAS unsigned char*)lds_raw; g.tid = t_; g.lane = t_ & 63; g.wave = __builtin_amdgcn_readfirstlane(t_ >> 6); \
        g.G = gridDim.x; const int bx_ = blockIdx.x; g.vcu = (g.G % 8 == 0) ? (bx_ % 8) * (g.G / 8) + bx_ / 8 : bx_; }
    LAS unsigned char* const lds0 = (LAS unsigned char*)lds_raw; const int tid0 = threadIdx.x, G0 = gridDim.x;
    volatile LAS unsigned* MISC = (volatile LAS unsigned*)(lds0 + MISC_OFF);
    unsigned char* ws = args.ws;
    unsigned* ctl = (unsigned*)(ws + WS_CTL);
    for (int u = tid0; u < (LDS_BYTES - RING_BYTES) / 4; u += NWAVES * 64) ((LAS unsigned*)(lds0 + RING_BYTES))[u] = 0u;
    __syncthreads();
    const int lo = args.ph_lo, hi = args.ph_hi;
    XcdBarrier bar; bar.bar = ctl + CW_BAR; bar.x = 0; bar.st = nullptr;
    if (hi - lo > 1) bar = xcd_barrier_post(ctl + CW_BAR, MISC + 8);
    const unsigned ldsb = (unsigned)(uintptr_t)lds_raw;
#ifndef PH_EN
#define PH_EN 0x1fff
#endif
#ifndef PROBE_T
#define PROBE_T 0
#endif
#ifndef PROBE_BLK
#define PROBE_BLK 0
#endif
    volatile LAS unsigned long long* tpw = (volatile LAS unsigned long long*)(lds0 + MISC_OFF + 96);
#define TP_BEGIN(id) do { if (PROBE_T == (id) && blockIdx.x == PROBE_BLK && tid0 == 0) tpw[1] = __builtin_amdgcn_s_memrealtime(); } while (0)
#define TP_END(id) do { if (PROBE_T == (id) && blockIdx.x == PROBE_BLK && tid0 == 0) tpw[0] += __builtin_amdgcn_s_memrealtime() - tpw[1]; } while (0)
#define IN(k) (lo <= (k) && (k) < hi)
#define EN(j) ((PH_EN >> (j)) & 1)
#if PROBE_DUP == 10
#define SEAM(k) do { if (IN(k) && IN((k) + 1)) { xcd_barrier(bar); xcd_barrier(bar); } } while (0)
#else
#define SEAM(k) do { if (IN(k) && IN((k) + 1)) { TP_BEGIN(299); TP_BEGIN(200 + (((k) + 7) & 7)); xcd_barrier(bar); TP_END(200 + (((k) + 7) & 7)); TP_END(299); } } while (0)
#endif

#define XS ((bf16*)(ws_ + WS_XS))
#define PROJ ((bf16*)(ws_ + WS_PROJ))
#define QDR ((bf16*)(ws_ + WS_QDR))
#define KVR ((bf16*)(ws_ + WS_KVR))
#define KD ((bf16*)(ws_ + WS_KD))
#define OB ((bf16*)(ws_ + WS_O))
#define UB ((bf16*)(ws_ + WS_U))
#define ACT ((bf16*)(ws_ + WS_ACT))
#define X8 ((bf16*)(ws_ + WS_X8))
#define LF ((float*)(ws_ + WS_LF))
#define KMS ((float*)(ws_ + WS_KMS))
#define SS ((unsigned long long*)(ws_ + WS_SS))
#define SSG ((unsigned long long*)(ws_ + WS_SSG))
#define SSD ((unsigned long long*)(ws_ + WS_SSD))
#define cosC ((const float*)(ws_ + WS_COSC))
#define sinC ((const float*)(ws_ + WS_SINC))
#define cosR ((const float*)(ws_ + WS_COSR))
#define sinR ((const float*)(ws_ + WS_SINR))
    if (EN(12) && IN(0)) { MKWG(); prologue_phase(g, args.in, ws_); __syncthreads(); stream_init_phase(g, args.in[0], XS, SS);
#if PROBE_DUP == 4
        __syncthreads(); prologue_phase(g, args.in, ws_); __syncthreads(); stream_init_phase(g, args.in[0], XS, SS);
#endif
    }
    SEAM(0);

    for (int l = 0; l < DEPTH; ++l) {
        const int p0 = 1 + 8 * l;
#define wl (ws_ + WS_W + (size_t)l * W_LAYER)
#define SS1 (SS + (size_t)(2 * l) * M)
#define SS2 (SS1 + M)
#define SSQ (SSD + (size_t)(2 * l) * M)
#define SSKV (SSQ + M)
        if (EN(0) && IN(p0 + 0)) { MKWG(); TP_BEGIN(100); pg8::Gemm gm{XS, (const bf16*)(wl + W_IN), M, INP, DM, DM, nullptr}; pg8::StaticOrder S; S.init(M, INP, g.G, (int)blockIdx.x);
            pg8::EpiBf16 E{PROJ, INP, 1.f, SS1, 1.f / DM, SSQ, SSKV, C_DCQ / 256, C_DCQ / 256 + 1, C_DCKV / 256};
            pg8::gemm_phase<pg8::EpiBf16, pg8::StaticOrder, true, true>(g.lds, gm, S, E);
            if (l + 1 < DEPTH) { MKWG(); const int nwg = (M / 256) * (INP / 256), maxr = (nwg + g.G - 1) / g.G, rem = nwg - (maxr - 1) * g.G, c = (int)blockIdx.x;
                if (rem >= g.G) convert_layer(g, args.in, ws_, l + 1, c * NWAVES + g.wave, g.G * NWAVES, 0, CONV_SPLIT);
                else if (c >= rem) convert_layer(g, args.in, ws_, l + 1, (c - rem) * NWAVES + g.wave, (g.G - rem) * NWAVES, 0, CONV_SPLIT); }
#if PROBE_DUP == 1
            pg8::gemm_phase<pg8::EpiBf16, pg8::StaticOrder, true, true>(g.lds, gm, S, E);
#endif
#if PROBE_DUP == 22
            xcd_barrier(bar); { pg8::EpiBf16 E2{PROJ, INP, 1.f, SS1, 1.f / DM, nullptr, nullptr, 0, 0, 0}; pg8::gemm_phase<pg8::EpiBf16, pg8::StaticOrder, true, true>(g.lds, gm, S, E2); }
#endif
        }
        TP_END(100);
        SEAM(p0 + 0);
        if (EN(2) && IN(p0 + 1)) { MKWG(); TP_BEGIN(101);
            { pg8::Gemm gm{PROJ + C_DCQ, (const bf16*)(wl + W_UQ), M, 768, QRANK, INP, nullptr}; pg8::StaticOrder S; S.init(M, 768, g.G, (int)blockIdx.x);
              pg8::EpiBf16 E{QDR, 768, 1.f, SSQ, 1.f / QRANK, nullptr, nullptr, 0, 0, 0};
              pg8::gemm_phase<pg8::EpiBf16, pg8::StaticOrder, true, true>(g.lds, gm, S, E); }
            { pg8::Gemm gm{PROJ + C_DCKV, (const bf16*)(wl + W_UKV), M, 1024, KVRANK, INP, nullptr}; pg8::StaticOrder S; S.init(M, 1024, g.G, (int)blockIdx.x);
              pg8::EpiBf16 E{KVR, 1024, 1.f, SSKV, 1.f / KVRANK, nullptr, nullptr, 0, 0, 0};
              pg8::gemm_phase<pg8::EpiBf16, pg8::StaticOrder, true, true>(g.lds, gm, S, E); }
        }
        TP_END(101);
        SEAM(p0 + 1);
        if (EN(1) && IN(p0 + 2)) { MKWG(); TP_BEGIN(102); Prep P{PROJ, PROJ, QDR, QDR, KVR, KD, args.in[4] + l * HD, args.in[5] + l * HD, args.in[6] + l * HD, args.in[7] + l * HD, args.in[12] + l * QKD, args.in[13] + l * QKD, args.in[3] + l * GH,
                                                 LF, KMS, cosC, sinC, cosR, sinR, ctl + CW_KMAX + 256 * l};
            prep_phase(g, P);
#if PROBE_DUP == 24
            xcd_barrier(bar); P.OUT = ACT; P.QOUT = ACT + (size_t)M * INP; P.KD = P.QOUT + (size_t)M * 768; P.LF = (float*)(P.KD + (size_t)M * 768); P.KMS = P.LF + (size_t)M * 4; P.KMAX = (unsigned*)(P.KMS + 262144); prep_phase(g, P);
#endif
        }
        TP_END(102);
        SEAM(p0 + 2);
        if (EN(4) && IN(p0 + 3)) { MKWG(); TP_BEGIN(103); att::PhaseArgs A{PROJ, QDR, KVR, KD, OB, LF, KMS, ctl + CW_QUEUE + 256 * l, ctl + CW_KMAX + 256 * l, SSG + (size_t)l * M * 4, -1};
            att::attn_phase(A, g.lds, ldsb);
            if (l + 1 < DEPTH) { MKWG(); volatile LAS unsigned* mq = (volatile LAS unsigned*)(g.lds + MISC_OFF + 64);
                for (;;) { __syncthreads(); if (g.tid == 0) mq[0] = __hip_atomic_fetch_add(ctl + CW_QUEUE + 256 * l + 192, 1u, __ATOMIC_RELAXED, __HIP_MEMORY_SCOPE_AGENT);
                    __syncthreads(); const int base = CONV_SPLIT + 8 * (int)mq[0]; if (base >= CONV_ITEMS) break;
                    if (base + g.wave < CONV_ITEMS) convert_item(g, args.in, ws_, l + 1, base + g.wave); } }
#if PROBE_DUP == 2
            __syncthreads(); A.queue = ctl + CW_QUEUE + 256 * (l + 8); att::attn_phase(A, g.lds, ldsb);
#endif
#if PROBE_DUP >= 30 && PROBE_DUP <= 33
            __syncthreads(); A.queue = ctl + CW_QUEUE + 256 * (l + 8); A.SSG = (unsigned long long*)ACT; A.only = PROBE_DUP - 30; att::attn_phase(A, g.lds, ldsb);
#endif
#if PROBE_DUP == 21
            xcd_barrier(bar); A.queue = ctl + CW_QUEUE + 256 * (l + 8); A.SSG = (unsigned long long*)ACT; att::attn_phase(A, g.lds, ldsb);
#endif
        }
        TP_END(103);
        SEAM(p0 + 3);
        if (EN(6) && IN(p0 + 4)) { MKWG(); TP_BEGIN(104); pg8::Gemm gm{OB, (const bf16*)(wl + W_OUT), M, DM, MIXW, MIXW, SSG + (size_t)l * M * 4}; pg8::StaticOrder S; S.init(M, DM, g.G, (int)blockIdx.x);
            pg8::EpiStream<FFN_FP8> E{XS, nullptr, X8, SS2, DM, 1.f};
            pg8::gemm_phase<pg8::EpiStream<FFN_FP8>, pg8::StaticOrder, true, true, false, true>(g.lds, gm, S, E);
#if PROBE_DUP == 5
            { pg8::EpiStream<FFN_FP8> E2{XS, nullptr, X8, nullptr, DM, 0.f}; pg8::gemm_phase<pg8::EpiStream<FFN_FP8>, pg8::StaticOrder, true, true>(g.lds, gm, S, E2); }
#endif
        }
        TP_END(104);
        SEAM(p0 + 4);
        if (EN(8) && IN(p0 + 5)) { MKWG(); TP_BEGIN(105); constexpr int KD_ = FFN_FP8 ? 2 : 1;
            pg8::Gemm gm{X8, (const bf16*)(wl + W_UP), M, DFF2, DM / KD_, DM / KD_, nullptr}; pg8::StaticOrder S; S.init(M, DFF2, g.G, (int)blockIdx.x);
            pg8::EpiBf16 E{UB, DFF2, 1.f / WUP_SCALE, SS2, 1.f / DM, nullptr, nullptr, 0, 0, 0};
            pg8::gemm_phase<pg8::EpiBf16, pg8::StaticOrder, true, true, FFN_FP8>(g.lds, gm, S, E);
#if PROBE_DUP == 1
            pg8::gemm_phase<pg8::EpiBf16, pg8::StaticOrder, true, true, FFN_FP8>(g.lds, gm, S, E);
#endif
#if PROBE_DUP == 23
            xcd_barrier(bar); pg8::gemm_phase<pg8::EpiBf16, pg8::StaticOrder, true, true, FFN_FP8>(g.lds, gm, S, E);
#endif
        }
        TP_END(105);
        SEAM(p0 + 5);
        if (EN(9) && IN(p0 + 6)) { MKWG(); TP_BEGIN(106); convgate_phase(g, UB, args.in[18] + (size_t)l * 3 * DFF2, args.in[19] + (size_t)l * DFF2, ACT);
#if PROBE_DUP == 3
            convgate_phase(g, UB, args.in[18] + (size_t)l * 3 * DFF2, args.in[19] + (size_t)l * DFF2, ACT);
#endif
#if PROBE_DUP == 12
            xcd_barrier(bar); convgate_phase(g, UB, args.in[18] + (size_t)l * 3 * DFF2, args.in[19] + (size_t)l * DFF2, ACT);
#endif
        }
        TP_END(106);
        SEAM(p0 + 6);
        if (EN(10) && IN(p0 + 7)) { MKWG(); TP_BEGIN(107); constexpr int KD_ = FFN_FP8 ? 2 : 1; const bool last = (l + 1 == DEPTH);
            pg8::Gemm gm{ACT, (const bf16*)(wl + W_DOWN), M, DM, DFF / KD_, DFF / KD_, nullptr}; pg8::StaticOrder S; S.init(M, DM, g.G, (int)blockIdx.x);
            pg8::EpiStream<false> E{XS, last ? args.out : nullptr, nullptr, last ? nullptr : SS1 + 2 * M, DM, 1.f / WDOWN_SCALE};
            pg8::gemm_phase<pg8::EpiStream<false>, pg8::StaticOrder, true, true, FFN_FP8>(g.lds, gm, S, E);
#if PROBE_DUP == 6
            if (!last) { pg8::EpiStream<false> E2{XS, nullptr, nullptr, nullptr, DM, 0.f}; pg8::gemm_phase<pg8::EpiStream<false>, pg8::StaticOrder, true, true, FFN_FP8>(g.lds, gm, S, E2); }
#endif
        }
        TP_END(107);
        if (l + 1 < DEPTH) SEAM(p0 + 7);
    }
#if PROBE_T
    if (blockIdx.x == PROBE_BLK && tid0 == 0) { const unsigned long long t_end = __builtin_amdgcn_s_memrealtime(), wait = 8ull * tpw[0];
        while (__builtin_amdgcn_s_memrealtime() - t_end < wait) __builtin_amdgcn_s_sleep(8); }
#endif
#undef IN
#undef SEAM
#undef XS
#undef PROJ
#undef QDR
#undef KVR
#undef KD
#undef OB
#undef UB
#undef ACT
#undef X8
#undef LF
#undef KMS
#undef SS
#undef SSG
#undef SSD
#undef cosC
#undef sinC
#undef cosR
#undef sinR
#undef wl
#undef SS1
#undef SS2
#undef SSQ
#undef SSKV
#undef MKWG
}

extern "C" void kernel_launch(void* const* d_in, const int* in_sizes, int n_in, void* d_out, int out_size, void* d_ws, size_t ws_size, hipStream_t stream) {
    static int grid = 0;
    if (grid == 0) {
        if (n_in != 21 || in_sizes[0] != M * DM || out_size != M * DM || ws_size < WS_END) {
            fprintf(stderr, "kernel_launch: built for 21 inputs, x and out of %d floats, >= %zu bytes of workspace; got n_in %d, in0 %d, out %d, ws %zu; nothing launched\n", M * DM, (size_t)WS_END, n_in, n_in > 0 ? in_sizes[0] : -1, out_size, ws_size);
            grid = -1; return; }
        int dev = 0, cus = 0, per_cu = 0;
        if (hipGetDevice(&dev) != hipSuccess || hipDeviceGetAttribute(&cus, hipDeviceAttributeMultiprocessorCount, dev) != hipSuccess) { fprintf(stderr, "kernel_launch: device query failed\n"); grid = -1; return; }
        if (hipFuncSetAttribute((const void*)hybrid_fwd, hipFuncAttributeMaxDynamicSharedMemorySize, LDS_BYTES) != hipSuccess) { fprintf(stderr, "kernel_launch: hipFuncSetAttribute(%d B LDS) failed\n", LDS_BYTES); grid = -1; return; }
        if (hipOccupancyMaxActiveBlocksPerMultiprocessor(&per_cu, (const void*)hybrid_fwd, NWAVES * 64, LDS_BYTES) != hipSuccess || per_cu < 1)
            fprintf(stderr, "kernel_launch: note: occupancy query reports %d workgroups per CU\n", per_cu);
        (void)hipGetLastError();
        grid = cus;
    }
    if (grid < 0) return;
    if (hipMemsetAsync((char*)d_ws + WS_CTL, 0, CTL_ZERO_BYTES, stream) != hipSuccess) { fprintf(stderr, "kernel_launch: memset failed\n"); return; }
    Args a{};
    for (int i = 0; i < 21; ++i) a.in[i] = (const float*)d_in[i];
    a.out = (float*)d_out; a.ws = (unsigned char*)d_ws;
#if MK_SPLIT
    for (int p = 0; p < N_PHASES; ++p) { a.ph_lo = p; a.ph_hi = p + 1; hipLaunchKernelGGL(hybrid_fwd, dim3(grid), dim3(NWAVES * 64), LDS_BYTES, stream, a); }
#else
    a.ph_lo = 0; a.ph_hi = N_PHASES;
    hipLaunchKernelGGL(hybrid_fwd, dim3(grid), dim3(NWAVES * 64), LDS_BYTES, stream, a);
#endif
    const hipError_t le = hipPeekAtLastError();
    if (le != hipSuccess) fprintf(stderr, "kernel_launch: launch failed: %s\n", hipGetErrorName(le));
}
```

```cpp
#include <hip/hip_runtime.h>
#include <cstdio>
#include <cstdint>

#define GAS __attribute__((address_space(1)))
#define LAS __attribute__((address_space(3)))
typedef unsigned short bf16;
typedef short bf16x8 __attribute__((ext_vector_type(8)));
typedef short s16x4 __attribute__((ext_vector_type(4)));
typedef float f32x2 __attribute__((ext_vector_type(2)));
typedef float f32x4 __attribute__((ext_vector_type(4)));
typedef float f32x16 __attribute__((ext_vector_type(16)));
typedef unsigned u32x2 __attribute__((ext_vector_type(2)));
typedef unsigned u32x4 __attribute__((ext_vector_type(4)));

constexpr int BATCH = 4, SEQ = 4096, DM = 2048, DEPTH = 4;
constexpr int M = BATCH * SEQ;
constexpr int HD = 128, GH = 4, GW = 512, MIXW = 2048;
constexpr int INW = 5444, INP = 5632;
constexpr int DFF = 5632, DFF2 = 11264;
constexpr int QRANK = 512, KVRANK = 256, QKD = 192;
constexpr float EPS = 1e-6f;
#ifndef FFN_FP8_ON
#define FFN_FP8_ON 1
#endif
constexpr bool FFN_FP8 = FFN_FP8_ON;
constexpr float WUP_SCALE = FFN_FP8 ? 64.f : 1.f, WDOWN_SCALE = FFN_FP8 ? 256.f : 1.f;
#ifndef U_FP8_ON
#define U_FP8_ON 1
#endif
constexpr bool U_FP8 = U_FP8_ON;
constexpr int C_AQ = 0, C_AK = 512, C_AV = 1024, C_BQ = 1536, C_BK = 2048, C_BV = 2560, C_CQ = 3072, C_CK = 3584, C_CV = 4096, C_DCQ = 4608, C_DCKV = 5120, C_DKR = 5376, C_AF = 5440;
__host__ __device__ __forceinline__ int inproj_src_col(int n) {
    if (n < 1536) return n;
    if (n < 5440) return n + 4;
    if (n < 5444) return 1536 + (n - 5440);
    return -1;
}

constexpr size_t MiB = 1u << 20;
constexpr size_t WS_CTL = 0, CTL_ZERO_BYTES = 5 * MiB;
constexpr size_t WS_SS = 1 * MiB;
constexpr size_t WS_SSG = 2 * MiB;
constexpr size_t WS_SSD = 4 * MiB;
constexpr size_t WS_COSC = 5 * MiB, WS_SINC = 6 * MiB;
constexpr size_t WS_COSR = 7 * MiB, WS_SINR = 7 * MiB + 512 * 1024;
constexpr size_t WS_LF = 8 * MiB;
constexpr size_t WS_CF = WS_LF + 256 * 1024;
constexpr size_t WS_KMS = WS_CF + 256 * 1024;
constexpr size_t WS_SEL = WS_KMS + 512 * 1024;
constexpr size_t WS_W = 10 * MiB;
constexpr size_t W_IN = 0, W_UQ = W_IN + (size_t)INP * DM * 2, W_UKV = W_UQ + (size_t)768 * 512 * 2, W_OUT = W_UKV + (size_t)1024 * 256 * 2,
                 W_UP = W_OUT + (size_t)DM * MIXW * 2, W_DOWN = W_UP + (size_t)DFF2 * DM * 2, W_LAYER = W_DOWN + (size_t)DM * DFF * 2;
static_assert(W_LAYER == (size_t)(22 * 1024 + 768 + 512 + 8 * 1024 + 44 * 1024 + 22 * 1024) * 1024, "weights per layer");
constexpr size_t WS_XS = 400 * MiB;
constexpr size_t WS_U = 464 * MiB;
constexpr size_t WS_PROJ = WS_U;
constexpr size_t WS_QDR = WS_PROJ + (size_t)M * INP * 2;
constexpr size_t WS_KVR = WS_QDR + (size_t)M * 768 * 2;
constexpr size_t WS_KD = WS_KVR + (size_t)M * 1024 * 2;
constexpr size_t WS_O = WS_KD + (size_t)M * 768 * 2;
constexpr size_t WS_ACT = WS_U + (size_t)M * DFF2 * 2;
constexpr size_t WS_X8 = WS_ACT + (size_t)M * DFF * 2;
constexpr size_t WS_END = WS_X8 + (size_t)M * DM * 2;
static_assert(WS_W + DEPTH * W_LAYER <= WS_XS && WS_O + (size_t)M * MIXW * 2 <= WS_ACT && WS_XS + (size_t)M * DM * 2 <= WS_U && WS_SEL + 256 * 1024 <= WS_W && WS_SS + (size_t)DEPTH * 2 * M * 8 <= WS_SSG && WS_SSG + (size_t)DEPTH * M * 4 * 8 <= WS_SSD && WS_SSD + (size_t)DEPTH * 2 * M * 8 <= CTL_ZERO_BYTES, "d_ws map");
constexpr int CW_BAR = 4096;
constexpr int CW_KMAX = 32768;
constexpr int CW_QUEUE = 16384;

constexpr int RING_BYTES = 131072;
constexpr int MISC_OFF = RING_BYTES + 320;
constexpr int LDS_BYTES = 147456;
constexpr int NWAVES = 8;

#define LDS_WAIT() asm volatile("s_waitcnt lgkmcnt(0)" ::: "memory")
#define VM_WAIT() asm volatile("s_waitcnt vmcnt(0)" ::: "memory")
#define SBAR() __builtin_amdgcn_sched_barrier(0)

__device__ __forceinline__ float bf2f(unsigned b) { return __uint_as_float(b << 16); }
__device__ __forceinline__ unsigned cvt_pk_bf16(float lo, float hi) { unsigned r; asm volatile("v_cvt_pk_bf16_f32 %0, %1, %2" : "=v"(r) : "v"(lo), "v"(hi)); return r; }
__device__ __forceinline__ void unpack8(u32x4 w, float (&v)[8]) {
#pragma unroll
    for (int i = 0; i < 4; ++i) { v[2 * i] = __uint_as_float(w[i] << 16); v[2 * i + 1] = __uint_as_float(w[i] & 0xffff0000u); }
}
__device__ __forceinline__ u32x4 pack8(const float (&v)[8]) { u32x4 w; w.x = cvt_pk_bf16(v[0], v[1]); w.y = cvt_pk_bf16(v[2], v[3]); w.z = cvt_pk_bf16(v[4], v[5]); w.w = cvt_pk_bf16(v[6], v[7]); return w; }
__device__ __forceinline__ float wave_sum(float v) {
#pragma unroll
    for (int o = 1; o < 64; o <<= 1) v += __shfl_xor(v, o);
    return v;
}
template <int CTRL> __device__ __forceinline__ float dppf(float v) { return __uint_as_float((unsigned)__builtin_amdgcn_update_dpp(0, (int)__float_as_uint(v), CTRL, 0xf, 0xf, true)); }
__device__ __forceinline__ float sum16(float v) {
    v += dppf<0xB1>(v); v += dppf<0x4E>(v); v += dppf<0x141>(v); v += dppf<0x140>(v);
    return v;
}
__device__ __forceinline__ void unpack8_fp8(u32x2 w, float (&v)[8]) {
    const f32x2 a = __builtin_amdgcn_cvt_pk_f32_fp8((int)w.x, false), b = __builtin_amdgcn_cvt_pk_f32_fp8((int)w.x, true), c = __builtin_amdgcn_cvt_pk_f32_fp8((int)w.y, false), d = __builtin_amdgcn_cvt_pk_f32_fp8((int)w.y, true);
    v[0] = a[0]; v[1] = a[1]; v[2] = b[0]; v[3] = b[1]; v[4] = c[0]; v[5] = c[1]; v[6] = d[0]; v[7] = d[1];
}
__device__ __forceinline__ float clamp448(float x) { return __builtin_amdgcn_fmed3f(x, -448.f, 448.f); }
__device__ __forceinline__ unsigned pack4_fp8(float a, float b, float c, float d) {
    unsigned w = 0; w = __builtin_amdgcn_cvt_pk_fp8_f32(clamp448(a), clamp448(b), w, false); w = __builtin_amdgcn_cvt_pk_fp8_f32(clamp448(c), clamp448(d), w, true); return w; }
__constant__ float INVF128[64] = {1.f, 0.865964353f, 0.749894261f, 0.649381638f, 0.562341332f, 0.486967534f, 0.421696514f, 0.365174115f, 0.316227764f, 0.273841977f, 0.237137377f, 0.2053525f, 0.177827939f, 0.153992653f, 0.133352131f, 0.115478203f, 0.100000001f, 0.0865964293f, 0.0749894157f, 0.0649381652f, 0.0562341325f, 0.0486967526f, 0.0421696529f, 0.0365174115f, 0.0316227749f, 0.0273841973f, 0.0237137377f, 0.0205352511f, 0.0177827943f, 0.0153992651f, 0.0133352149f, 0.0115478206f, 0.00999999978f, 0.00865964312f, 0.00749894185f, 0.00649381615f, 0.00562341325f, 0.00486967526f, 0.00421696482f, 0.00365174119f, 0.00316227763f, 0.00273841969f, 0.00237137359f, 0.00205352483f, 0.00177827943f, 0.00153992651f, 0.00133352145f, 0.0011547819f, 0.00100000005f, 0.000865964335f, 0.000749894243f, 0.000649381662f, 0.000562341302f, 0.000486967532f, 0.000421696517f, 0.000365174143f, 0.000316227757f, 0.000273841957f, 0.00023713737f, 0.00020535251f, 0.00017782794f, 0.000153992645f, 0.00013335215f, 0.0001154782f};

namespace pg8 {
#define PG8_LAS __attribute__((address_space(3)))
typedef unsigned short bf16_t;
typedef short bf16x8 __attribute__((ext_vector_type(8)));
typedef float f32x4 __attribute__((ext_vector_type(4)));
typedef unsigned u32x4 __attribute__((ext_vector_type(4)));
typedef int v8i __attribute__((ext_vector_type(8)));
typedef unsigned u32x8 __attribute__((ext_vector_type(8)));
constexpr int BM = 256, BK = 64, HALF = 128, HTB = HALF * BK * 2  , STAGE_BYTES = 8 * HTB, NXCD = 8, WGM = 4;

__host__ __device__ __forceinline__ int lds_byte(int r, int c) { const int st = (r >> 4) * 2 + (c >> 5), rr = r & 15, cc = c & 31, ob = rr * 64 + cc * 2; return st * 1024 + (ob ^ (((ob >> 9) & 1) << 5)); }
__host__ __device__ __forceinline__ void stage_rc(int b, int& R, int& C) { const int st = b / 1024, sb = b % 1024, swz = sb ^ (((sb >> 9) & 1) << 5); R = (st >> 1) * 16 + swz / 64; C = (st & 1) * 32 + (swz % 64) / 2; }
__host__ __device__ __forceinline__ int perm32(int rho) { const int n = rho >> 4, i = rho & 15; return 8 * (i >> 2) + 4 * n + (i & 3); }

struct Unit { int pm, pn; };
struct Gemm { const bf16_t* A; const bf16_t* Bt; int M, N, K, lda; const unsigned long long* ssg; };

struct StaticOrder {
    int nM, nN, nwg, G, c;
    __host__ __device__ void init(int M, int N, int G_, int c_) { nM = M / BM; nN = N / BM; nwg = nM * nN; G = G_; c = c_; }
    __host__ __device__ bool next(int i, Unit& u) const {
        const long L = (long)i * G + c; if (L >= nwg) return false;
        int wgid = (int)L; { const int q = nwg / NXCD, r = nwg % NXCD, xcd = wgid % NXCD, off = wgid / NXCD; wgid = (xcd < r ? xcd * (q + 1) : r * (q + 1) + (xcd - r) * q) + off; }
        const int nig = WGM * nN, gid = wgid / nig, fm = gid * WGM, gsz = (nM - fm) < WGM ? (nM - fm) : WGM;
        u.pm = fm + ((wgid % nig) % gsz); u.pn = (wgid % nig) / gsz; return true;
    }
    __device__ __forceinline__ void a_ready(const Unit&) const {}
    __device__ __forceinline__ void done(const Unit&) const {}
};

__device__ __forceinline__ unsigned cvt_pk_bf16(float lo, float hi) { unsigned r; asm volatile("v_cvt_pk_bf16_f32 %0, %1, %2" : "=v"(r) : "v"(lo), "v"(hi)); return r; }
struct EpiBf16 {
    static constexpr bool PERM = true, AFTER_DRAIN = false;
    bf16_t* O; int ldc; float sc; const unsigned long long* ss; float inv_n;
    unsigned long long* st_a; unsigned long long* st_b; int pn_a0, pn_a1, pn_b; int out8;
    static constexpr bool PREFETCH_SS = true;
    __device__ __forceinline__ void operator()(const f32x4 (&acc)[2][2][4][2], const Unit& u, int wr, int wc, int fr, int fq, const unsigned long long (&pre)[8]) const {
        const int row0 = u.pm * BM + wr * 64 + fr, col0 = u.pn * BM + wc * 32 + 8 * fq;
        unsigned long long* st = nullptr; if (st_a) { if (u.pn >= pn_a0 && u.pn <= pn_a1) st = st_a; else if (u.pn == pn_b) st = st_b; }
#pragma unroll
        for (int ai = 0; ai < 2; ++ai)
#pragma unroll
            for (int m = 0; m < 4; ++m) { const int row = row0 + ai * HALF + m * 16; bf16_t* rowp = O + (size_t)row * ldc + col0; float ssq = 0.f;
                const float s = ss ? sc * rsqrtf((float)pre[ai * 4 + m] * (inv_n * (1.f / 16777216.f)) + 1e-6f) : sc;
#pragma unroll
                for (int bj = 0; bj < 2; ++bj) { const f32x4 v0 = acc[ai][bj][m][0] * s, v1 = acc[ai][bj][m][1] * s;
                    if (st) ssq += (v0[0] * v0[0] + v0[1] * v0[1]) + (v0[2] * v0[2] + v0[3] * v0[3]) + (v1[0] * v1[0] + v1[1] * v1[1]) + (v1[2] * v1[2] + v1[3] * v1[3]);
                    if (out8) { u32x2 w8; w8.x = pack4_fp8(v0[0], v0[1], v0[2], v0[3]); w8.y = pack4_fp8(v1[0], v1[1], v1[2], v1[3]); *(u32x2*)((unsigned char*)O + (size_t)row * ldc + col0 + bj * HALF) = w8; }
                    else { u32x4 w; w.x = cvt_pk_bf16(v0[0], v0[1]); w.y = cvt_pk_bf16(v0[2], v0[3]); w.z = cvt_pk_bf16(v1[0], v1[1]); w.w = cvt_pk_bf16(v1[2], v1[3]);
                    *(u32x4*)(rowp + bj * HALF) = w; } }
                if (st) { ssq += __shfl_xor(ssq, 16); ssq += __shfl_xor(ssq, 32); if (fq == 0) __hip_atomic_fetch_add(st + row, (unsigned long long)(ssq * 16777216.f), __ATOMIC_RELAXED, __HIP_MEMORY_SCOPE_AGENT); } }
    }
};
template <bool COPY_FP8>
struct EpiStream {
    static constexpr bool PERM = true, AFTER_DRAIN = false, PREFETCH_SS = false;
    bf16_t* XS; float* OUT32; void* X8; unsigned long long* ss; int ldc; float sc;
    __device__ __forceinline__ void operator()(const f32x4 (&acc)[2][2][4][2], const Unit& u, int wr, int wc, int fr, int fq, const unsigned long long (&)[8]) const {
        const int row0 = u.pm * BM + wr * 64 + fr, col0 = u.pn * BM + wc * 32 + 8 * fq;
#pragma unroll
        for (int ai = 0; ai < 2; ++ai) {
            u32x4 xall[4][2];
#pragma unroll
            for (int m = 0; m < 4; ++m)
#pragma unroll
                for (int bj = 0; bj < 2; ++bj) xall[m][bj] = *(const u32x4*)(XS + (size_t)(row0 + ai * HALF + m * 16) * ldc + col0 + bj * HALF);
#pragma unroll
            for (int m = 0; m < 4; ++m) { const int row = row0 + ai * HALF + m * 16; const size_t ro = (size_t)row * ldc + col0; float ssq = 0.f;
#pragma unroll
                for (int bj = 0; bj < 2; ++bj) { const u32x4 xw = xall[m][bj];
                    f32x4 v0 = acc[ai][bj][m][0] * sc, v1 = acc[ai][bj][m][1] * sc;
                    v0[0] += __uint_as_float(xw[0] << 16); v0[1] += __uint_as_float(xw[0] & 0xffff0000u); v0[2] += __uint_as_float(xw[1] << 16); v0[3] += __uint_as_float(xw[1] & 0xffff0000u);
                    v1[0] += __uint_as_float(xw[2] << 16); v1[1] += __uint_as_float(xw[2] & 0xffff0000u); v1[2] += __uint_as_float(xw[3] << 16); v1[3] += __uint_as_float(xw[3] & 0xffff0000u);
                    ssq += (v0[0] * v0[0] + v0[1] * v0[1]) + (v0[2] * v0[2] + v0[3] * v0[3]) + (v1[0] * v1[0] + v1[1] * v1[1]) + (v1[2] * v1[2] + v1[3] * v1[3]);
                    if (OUT32) { *(f32x4*)(OUT32 + ro + bj * HALF) = v0; *(f32x4*)(OUT32 + ro + bj * HALF + 4) = v1; }
                    else { u32x4 w; w.x = cvt_pk_bf16(v0[0], v0[1]); w.y = cvt_pk_bf16(v0[2], v0[3]); w.z = cvt_pk_bf16(v1[0], v1[1]); w.w = cvt_pk_bf16(v1[2], v1[3]); *(u32x4*)(XS + ro + bj * HALF) = w; }
                    if (X8) { if constexpr (COPY_FP8) { u32x2 w; w.x = pack4_fp8(v0[0], v0[1], v0[2], v0[3]); w.y = pack4_fp8(v1[0], v1[1], v1[2], v1[3]); *(u32x2*)((unsigned char*)X8 + ro + bj * HALF) = w; }
                              else { u32x4 w; w.x = cvt_pk_bf16(v0[0], v0[1]); w.y = cvt_pk_bf16(v0[2], v0[3]); w.z = cvt_pk_bf16(v1[0], v1[1]); w.w = cvt_pk_bf16(v1[2], v1[3]); *(u32x4*)((bf16_t*)X8 + ro + bj * HALF) = w; } } }
                if (ss) { ssq += __shfl_xor(ssq, 16); ssq += __shfl_xor(ssq, 32); if (fq == 0) __hip_atomic_fetch_add(ss + row, (unsigned long long)(ssq * 16777216.f), __ATOMIC_RELAXED, __HIP_MEMORY_SCOPE_AGENT); } } }
    }
};

template <class Epi, class Sched, bool ALIGN_EPI = false, bool SP2 = false, bool FP8 = false, bool GS = false>
__device__ __forceinline__ void gemm_phase(PG8_LAS unsigned char* lds, const Gemm g, const Sched& S, const Epi& E) {
    int tid_ = threadIdx.x; asm volatile("" : "+v"(tid_));
    const int tid = tid_, wid = __builtin_amdgcn_readfirstlane(tid >> 6), lane = tid & 63, wr = wid >> 2, wc = wid & 3, fr = lane & 15, fq = lane >> 4;
    const int K = g.K, nt = K / BK;
    unsigned voffA[2], voffB[2];
#pragma unroll
    for (int i = 0; i < 2; ++i) { int R, C; stage_rc(tid * 16 + i * 8192, R, C); const int Rb = Epi::PERM ? ((R & ~31) + perm32(R & 31)) : R;
        voffA[i] = (unsigned)(R * g.lda + C) * 2u; voffB[i] = (unsigned)(Rb * K + C) * 2u; }
    const size_t kstep = (size_t)(BK * 2);
    const size_t hstepA = (size_t)HALF * g.lda * 2, hstepB = (size_t)HALF * K * 2;
    const size_t tstepA = 2 * hstepA, tstepB = 2 * hstepB;
    const unsigned ldsw = (unsigned)wid * 1024u;
    const int aoff = lds_byte(wr * 64 + fr, fq * 8), boff = lds_byte(wc * 32 + fr, fq * 8);
#define PG8_SA(b, h) (((b) * 2 + (h)) * HTB)
#define PG8_SB(b, h) ((4 + (b) * 2 + (h)) * HTB)
#define PG8_STAGE(bufoff, gbase, voff) do { _Pragma("unroll") for (int _i = 0; _i < 2; ++_i) \
        __builtin_amdgcn_global_load_lds((const unsigned*)((const char*)(gbase) + (voff)[_i]), (PG8_LAS unsigned*)(lds + (bufoff) + ldsw + _i * 8192), 16, 0, 0); } while (0)
#define PG8_LD2(dst, addr) do { const u32x4 lo_ = *(const PG8_LAS u32x4*)(addr), hi_ = *(const PG8_LAS u32x4*)((addr) + 1024); dst = __builtin_shufflevector(lo_, hi_, 0, 1, 2, 3, 4, 5, 6, 7); } while (0)
#define PG8_LDA(dst, b, h) do { _Pragma("unroll") for (int m = 0; m < 4; ++m) PG8_LD2(dst[m], lds + PG8_SA(b, h) + aoff + m * 2048); } while (0)
#define PG8_LDB(dst, b, h) do { _Pragma("unroll") for (int n = 0; n < 2; ++n) PG8_LD2(dst[n], lds + PG8_SB(b, h) + boff + n * 2048); } while (0)
#define PG8_HALF(X, k) __builtin_bit_cast(bf16x8, __builtin_shufflevector(X, X, 4 * (k), 4 * (k) + 1, 4 * (k) + 2, 4 * (k) + 3))
#define PG8_MMA(ai, bj, At, Bt) do { __builtin_amdgcn_s_setprio(1); \
        if constexpr (FP8) { _Pragma("unroll") for (int m = 0; m < 4; ++m) _Pragma("unroll") for (int n = 0; n < 2; ++n) \
            asm volatile("v_mfma_scale_f32_16x16x128_f8f6f4 %0, %1, %2, %0, %3, %3 op_sel_hi:[0,0,0]" : "+v"(acc[ai][bj][m][n]) : "v"(Bt[n]), "v"(At[m]), "v"(one_scale)); } \
        else { _Pragma("unroll") for (int m = 0; m < 4; ++m) _Pragma("unroll") for (int n = 0; n < 2; ++n) { \
            acc[ai][bj][m][n] = __builtin_amdgcn_mfma_f32_16x16x32_bf16(PG8_HALF(Bt[n], 0), PG8_HALF(At[m], 0), acc[ai][bj][m][n], 0, 0, 0); \
            acc[ai][bj][m][n] = __builtin_amdgcn_mfma_f32_16x16x32_bf16(PG8_HALF(Bt[n], 1), PG8_HALF(At[m], 1), acc[ai][bj][m][n], 0, 0, 0); } } \
        __builtin_amdgcn_s_setprio(0); } while (0)
#define PG8_WAIT_V(n) asm volatile("s_waitcnt vmcnt(" #n ")" ::: "memory")
#define PG8_WAIT_L(n) asm volatile("s_waitcnt lgkmcnt(" #n ")" ::: "memory")
#define PG8_BAR __builtin_amdgcn_s_barrier()
#define PG8_SCHED __builtin_amdgcn_sched_barrier(0)
    Unit cur, nxt; int ui = 0;
    if (!S.next(0, cur)) return;
    PG8_LAS unsigned char* const gs_lds = lds + STAGE_BYTES + 1024;
#define PG8_GS_TABLE(u_, buf_) do { if constexpr (GS) { if (tid < 256) { const unsigned long long* sp_ = g.ssg + ((size_t)(u_).pm * BM + tid) * 4; float r_[4]; \
        _Pragma("unroll") for (int q_ = 0; q_ < 4; ++q_) r_[q_] = rsqrtf((float)__hip_atomic_load(sp_ + q_, __ATOMIC_RELAXED, __HIP_MEMORY_SCOPE_AGENT) * (1.f / 16777216.f / 512.f) + 1e-6f); \
        *(PG8_LAS f32x4*)(gs_lds + (buf_) * 4096 + tid * 16) = (f32x4){r_[0] / r_[1], r_[1] / r_[2], r_[2] / r_[3], r_[3]}; } } } while (0)
#define PG8_GS_SCALE(buf_, col_) do { _Pragma("unroll") for (int ai_ = 0; ai_ < 2; ++ai_) _Pragma("unroll") for (int m_ = 0; m_ < 4; ++m_) { \
        const float f_ = *(const PG8_LAS float*)(gs_lds + (buf_) * 4096 + (wr * 64 + fr + ai_ * HALF + m_ * 16) * 16 + (col_) * 4); \
        _Pragma("unroll") for (int bj_ = 0; bj_ < 2; ++bj_) _Pragma("unroll") for (int n_ = 0; n_ < 2; ++n_) acc[ai_][bj_][m_][n_] = acc[ai_][bj_][m_][n_] * f_; } } while (0)
    f32x4 acc[2][2][4][2];
#pragma unroll
    for (int a = 0; a < 2; ++a)
#pragma unroll
        for (int b = 0; b < 2; ++b)
#pragma unroll
            for (int m = 0; m < 4; ++m)
#pragma unroll
                for (int n = 0; n < 2; ++n) acc[a][b][m][n] = (f32x4){0.f, 0.f, 0.f, 0.f};
    unsigned one_scale = 0x7f7f7f7fu; asm volatile("" : "+v"(one_scale));
    unsigned long long pre[8] = {0, 0, 0, 0, 0, 0, 0, 0};
    u32x8 At[4], B0[2], B1[2];
    const char* cA = (const char*)g.A + (size_t)cur.pm * tstepA; const char* cB = (const char*)g.Bt + (size_t)cur.pn * tstepB;
    S.a_ready(cur); PG8_GS_TABLE(cur, 0);
    if constexpr (SP2) {
        PG8_STAGE(PG8_SB(0, 0), cB, voffB); PG8_STAGE(PG8_SB(0, 1), cB + hstepB, voffB); PG8_STAGE(PG8_SA(0, 0), cA, voffA); PG8_STAGE(PG8_SA(0, 1), cA + hstepA, voffA);
        if (wr == 1) PG8_BAR;
        PG8_WAIT_V(2); PG8_BAR;
        PG8_STAGE(PG8_SB(1, 0), cB + kstep, voffB); PG8_STAGE(PG8_SA(1, 0), cA + kstep, voffA); PG8_STAGE(PG8_SB(1, 1), cB + hstepB + kstep, voffB);
        PG8_WAIT_V(6); PG8_BAR;
    } else {
        PG8_STAGE(PG8_SB(0, 0), cB, voffB); PG8_STAGE(PG8_SA(0, 0), cA, voffA); PG8_STAGE(PG8_SB(0, 1), cB + hstepB, voffB); PG8_STAGE(PG8_SA(0, 1), cA + hstepA, voffA);
        if (wr == 1) PG8_BAR;
        PG8_WAIT_V(4); PG8_BAR;
        PG8_STAGE(PG8_SB(1, 0), cB + kstep, voffB); PG8_STAGE(PG8_SA(1, 0), cA + kstep, voffA); PG8_STAGE(PG8_SB(1, 1), cB + hstepB + kstep, voffB);
        PG8_WAIT_V(6); PG8_BAR;
    }
    for (;;) {
        const bool has_next = S.next(ui + 1, nxt);
        const char* nA = has_next ? (const char*)g.A + (size_t)nxt.pm * tstepA : cA; const char* nB = has_next ? (const char*)g.Bt + (size_t)nxt.pn * tstepB : cB;
        for (int t = 0; t < nt; t += 2) {
            const bool last = (t == nt - 2);
            const char* a1 = cA + (size_t)(t + 1) * kstep;
            const char* a2 = last ? nA : cA + (size_t)(t + 2) * kstep; const char* b2 = last ? nB : cB + (size_t)(t + 2) * kstep;
            const char* a3 = a2 + kstep; const char* b3 = b2 + kstep;
            if (last && has_next) { S.a_ready(nxt); PG8_GS_TABLE(nxt, (ui + 1) & 1); }
            if constexpr (Epi::PREFETCH_SS) { if (last && E.ss) {
#pragma unroll
                for (int q_ = 0; q_ < 8; ++q_) pre[q_] = __hip_atomic_load(E.ss + cur.pm * BM + wr * 64 + fr + (q_ >> 2) * HALF + (q_ & 3) * 16, __ATOMIC_RELAXED, __HIP_MEMORY_SCOPE_AGENT); } }
            if constexpr (GS) { if (t == 8 || t == 16 || t == 24) PG8_GS_SCALE(ui & 1, (t >> 3) - 1); }
            if constexpr (SP2) {
            PG8_LDB(B0, 0, 0); PG8_LDB(B1, 0, 1); PG8_SCHED; PG8_LDA(At, 0, 0); PG8_STAGE(PG8_SA(1, 1), a1 + hstepA, voffA);
            PG8_WAIT_V(8); PG8_WAIT_L(0); PG8_BAR; PG8_MMA(0, 0, At, B0); PG8_MMA(0, 1, At, B1); PG8_BAR; PG8_SCHED;
            PG8_LDA(At, 0, 1); PG8_STAGE(PG8_SB(0, 0), b2, voffB); PG8_STAGE(PG8_SB(0, 1), b2 + hstepB, voffB); PG8_STAGE(PG8_SA(0, 0), a2, voffA);
            PG8_WAIT_V(8); PG8_WAIT_L(0); PG8_BAR; PG8_MMA(1, 0, At, B0); PG8_MMA(1, 1, At, B1); PG8_BAR; PG8_SCHED;
            PG8_LDB(B0, 1, 0); PG8_LDB(B1, 1, 1); PG8_SCHED; PG8_LDA(At, 1, 0); PG8_STAGE(PG8_SA(0, 1), a2 + hstepA, voffA);
            PG8_WAIT_V(8); PG8_WAIT_L(0); PG8_BAR; PG8_MMA(0, 0, At, B0); PG8_MMA(0, 1, At, B1); PG8_BAR; PG8_SCHED;
            PG8_LDA(At, 1, 1); PG8_STAGE(PG8_SB(1, 0), b3, voffB); PG8_STAGE(PG8_SB(1, 1), b3 + hstepB, voffB); PG8_STAGE(PG8_SA(1, 0), a3, voffA);
            PG8_WAIT_V(8); PG8_WAIT_L(0); PG8_BAR; PG8_MMA(1, 0, At, B0); PG8_MMA(1, 1, At, B1); PG8_BAR; PG8_SCHED;
            } else {
            PG8_LDB(B0, 0, 0); PG8_SCHED; PG8_LDA(At, 0, 0); PG8_STAGE(PG8_SA(1, 1), a1 + hstepA, voffA);
            PG8_WAIT_L(8); PG8_BAR; PG8_WAIT_L(0); PG8_MMA(0, 0, At, B0); PG8_BAR; PG8_SCHED;
            PG8_LDB(B1, 0, 1); PG8_STAGE(PG8_SB(0, 0), b2, voffB);
            PG8_BAR; PG8_WAIT_L(0); PG8_MMA(0, 1, At, B1); PG8_BAR;
            PG8_LDA(At, 0, 1); PG8_STAGE(PG8_SA(0, 0), a2, voffA);
            PG8_BAR; PG8_WAIT_L(0); PG8_MMA(1, 0, At, B0); PG8_BAR; PG8_SCHED;
            PG8_STAGE(PG8_SB(0, 1), b2 + hstepB, voffB);
            PG8_WAIT_V(6); PG8_BAR; PG8_MMA(1, 1, At, B1); PG8_BAR;
            PG8_LDB(B0, 1, 0); PG8_SCHED; PG8_LDA(At, 1, 0); PG8_STAGE(PG8_SA(0, 1), a2 + hstepA, voffA);
            PG8_WAIT_L(8); PG8_BAR; PG8_WAIT_L(0); PG8_MMA(0, 0, At, B0); PG8_BAR; PG8_SCHED;
            PG8_LDB(B1, 1, 1); PG8_STAGE(PG8_SB(1, 0), b3, voffB);
            PG8_BAR; PG8_WAIT_L(0); PG8_MMA(0, 1, At, B1); PG8_BAR;
            PG8_LDA(At, 1, 1); PG8_STAGE(PG8_SA(1, 0), a3, voffA);
            PG8_BAR; PG8_WAIT_L(0); PG8_MMA(1, 0, At, B0); PG8_BAR; PG8_SCHED;
            PG8_STAGE(PG8_SB(1, 1), b3 + hstepB, voffB);
            PG8_WAIT_V(6); PG8_BAR; PG8_MMA(1, 1, At, B1); PG8_BAR;
            }
        }
        if constexpr (ALIGN_EPI) { if (wr == 0) PG8_BAR; }
        if constexpr (FP8) asm volatile("s_nop 15\n\ts_nop 15" ::: "memory");
        if constexpr (GS) PG8_GS_SCALE(ui & 1, 3);
        if constexpr (!Epi::AFTER_DRAIN) { E(acc, cur, wr, wc, fr, fq, pre); S.done(cur); }
        if (!has_next) break;
#pragma unroll
        for (int a = 0; a < 2; ++a)
#pragma unroll
            for (int b = 0; b < 2; ++b)
#pragma unroll
                for (int m = 0; m < 4; ++m)
#pragma unroll
                    for (int n = 0; n < 2; ++n) acc[a][b][m][n] = (f32x4){0.f, 0.f, 0.f, 0.f};
        cur = nxt; cA = nA; cB = nB; ++ui;
        if constexpr (ALIGN_EPI) { if (wr == 1) PG8_BAR; }
    }
    PG8_WAIT_V(0);
    if constexpr (!ALIGN_EPI) { if (wr == 0) PG8_BAR; }
    PG8_BAR;
    if constexpr (Epi::AFTER_DRAIN) { E.fused(acc, cur, wr, wc, fr, fq, lds, wid, lane); S.done(cur); }
#undef PG8_GS_TABLE
#undef PG8_GS_SCALE
#undef PG8_SA
#undef PG8_SB
#undef PG8_STAGE
#undef PG8_LDA
#undef PG8_LDB
#undef PG8_MMA
#undef PG8_HALF
#undef PG8_LD2
#undef PG8_WAIT_V
#undef PG8_WAIT_L
#undef PG8_BAR
#undef PG8_SCHED
}
}
#define XB_TMO      128
#define XB_XCNT(j)  (256  + 64 * (j))
#define XB_XSUB(j)  (1280 + 64 * (j))
#define XB_XGEN(j)  (2304 + 64 * (j))
#define XB_TOP      3328
#define XB_TOPGEN   3392
#define XCD_BAR_WORDS 3456
#define XB_SPIN_CAP (1u << 20)

__device__ __forceinline__ unsigned xb_ld(unsigned* p)              { return __hip_atomic_load(p, __ATOMIC_RELAXED, __HIP_MEMORY_SCOPE_AGENT); }
__device__ __forceinline__ unsigned xb_add(unsigned* p, unsigned v) { return __hip_atomic_fetch_add(p, v, __ATOMIC_RELAXED, __HIP_MEMORY_SCOPE_AGENT); }
__device__ __forceinline__ unsigned xb_xcc_id() { return (unsigned)__builtin_amdgcn_s_getreg((3 << 11) | 20) & 0xFu; }
#define XB_SPIN(cond, bar) do { unsigned _sp = 0; while (cond) { __builtin_amdgcn_s_sleep(1); \
    if ((++_sp & 255u) == 0u) { if (xb_ld(&(bar)[XB_TMO])) break; if (_sp > XB_SPIN_CAP) { atomicAdd(&(bar)[XB_TMO], 1u); break; } } } } while (0)

struct XcdBarrier {
    unsigned* bar; unsigned x;
    volatile LAS unsigned* st;
};

__device__ __forceinline__ XcdBarrier xcd_barrier_post(unsigned* bar, volatile LAS unsigned* st) {
    XcdBarrier b; b.bar = bar; b.x = xb_xcc_id(); b.st = st;
    if (threadIdx.x == 0) (void)xb_add(&bar[XB_XCNT(b.x)], 1u);
    return b;
}
__device__ __forceinline__ void xcd_barrier_complete(unsigned* bar, unsigned x, unsigned& nloc, unsigned& nx) {
    const unsigned G = gridDim.x * gridDim.y * gridDim.z;
    unsigned sum, cnt, mine, sp = 0u;
    for (;;) {
        sum = 0u; cnt = 0u; mine = 0u;
#pragma unroll
        for (unsigned j = 0; j < 16; ++j) { const unsigned c = xb_ld(&bar[XB_XCNT(j)]); sum += c; cnt += (c > 0u) ? 1u : 0u; mine = (j == x) ? c : mine; }
        if (sum == G) break;
        __builtin_amdgcn_s_sleep(1);
        if ((++sp & 255u) == 0u) { if (xb_ld(&bar[XB_TMO])) break; if (sp > XB_SPIN_CAP) { atomicAdd(&bar[XB_TMO], 1u); break; } }
    }
    nloc = mine > 0u ? mine : 1u; nx = cnt > 0u ? cnt : 1u;
}

__device__ __forceinline__ void xcd_barrier(const XcdBarrier& b) {
    asm volatile("s_waitcnt vmcnt(0)" ::: "memory");
    __syncthreads();
    if (threadIdx.x == 0) {
        unsigned* bar = b.bar;
        __builtin_amdgcn_s_waitcnt(0);
        unsigned nloc = b.st[0], nx = b.st[1];
        if (nloc == 0u) { xcd_barrier_complete(bar, b.x, nloc, nx); b.st[0] = nloc; b.st[1] = nx; }
        const unsigned old = xb_add(&bar[XB_XSUB(b.x)], 1u);
        const unsigned gen = old / nloc;
        if (old + 1u == (gen + 1u) * nloc) {
            __builtin_amdgcn_fence(__ATOMIC_RELEASE, "agent");
            asm volatile("s_waitcnt vmcnt(0)" ::: "memory");
            const unsigned og = xb_add(&bar[XB_TOP], 1u);
            const unsigned tg = og / nx;
            if (og + 1u == (tg + 1u) * nx) xb_add(&bar[XB_TOPGEN], 1u);
            else XB_SPIN(xb_ld(&bar[XB_TOPGEN]) == tg, bar);
            __builtin_amdgcn_fence(__ATOMIC_ACQUIRE, "agent");
            xb_add(&bar[XB_XGEN(b.x)], 1u);
            asm volatile("s_waitcnt vmcnt(0)" ::: "memory");
        } else {
            XB_SPIN(xb_ld(&bar[XB_XGEN(b.x)]) == gen, bar);
            __builtin_amdgcn_fence(__ATOMIC_ACQUIRE, "agent");
            asm volatile("s_waitcnt vmcnt(0)" ::: "memory");
        }
    }
    __syncthreads();
}

struct WG { int tid, lane, wave, vcu, G; LAS unsigned char* lds; };

template <int MAP, bool F8>
__device__ __forceinline__ void transpose_item(const float* W, int K, int ldw, int Npad, void* WT, LAS unsigned char* scr, int item, int lane, float wscale, const float* kgain) {
    const int nblk = Npad / 128, kb = item / nblk, nb = item % nblk, k0 = 64 * kb, n0 = 128 * nb;
    const int r = lane >> 5, c4 = lane & 31;
    int sc = n0 + 4 * c4; if (MAP == 1) sc = inproj_src_col(sc);
    constexpr int EB = F8 ? 1 : 2;
    constexpr int ROWB = 64 * EB, NCH = ROWB / 16;
#pragma unroll
    for (int hb = 0; hb < 2; ++hb) {
        f32x4 v[16];
#pragma unroll
        for (int i = 0; i < 16; ++i) { const int k = k0 + 32 * r + 16 * hb + i;
            v[i] = (sc >= 0) ? *(const f32x4*)(W + (size_t)k * ldw + sc) : (f32x4){0.f, 0.f, 0.f, 0.f}; }
        if (kgain) {
#pragma unroll
            for (int i = 0; i < 16; ++i) v[i] = v[i] * kgain[k0 + 32 * r + 16 * hb + i]; }
#pragma unroll
        for (int j = 0; j < 4; ++j) { const int n = 4 * c4 + j;
            if constexpr (F8) { u32x4 w;
                w.x = pack4_fp8(v[0][j] * wscale, v[1][j] * wscale, v[2][j] * wscale, v[3][j] * wscale); w.y = pack4_fp8(v[4][j] * wscale, v[5][j] * wscale, v[6][j] * wscale, v[7][j] * wscale);
                w.z = pack4_fp8(v[8][j] * wscale, v[9][j] * wscale, v[10][j] * wscale, v[11][j] * wscale); w.w = pack4_fp8(v[12][j] * wscale, v[13][j] * wscale, v[14][j] * wscale, v[15][j] * wscale);
                *(LAS u32x4*)(scr + n * ROWB + ((((2 * r + hb)) ^ ((n >> 2) & (NCH - 1))) << 4)) = w; }
            else { u32x4 w0, w1;
                w0.x = cvt_pk_bf16(v[0][j], v[1][j]); w0.y = cvt_pk_bf16(v[2][j], v[3][j]); w0.z = cvt_pk_bf16(v[4][j], v[5][j]); w0.w = cvt_pk_bf16(v[6][j], v[7][j]);
                w1.x = cvt_pk_bf16(v[8][j], v[9][j]); w1.y = cvt_pk_bf16(v[10][j], v[11][j]); w1.z = cvt_pk_bf16(v[12][j], v[13][j]); w1.w = cvt_pk_bf16(v[14][j], v[15][j]);
                *(LAS u32x4*)(scr + n * ROWB + (((4 * r + 2 * hb) ^ ((n >> 2) & (NCH - 1))) << 4)) = w0;
                *(LAS u32x4*)(scr + n * ROWB + (((4 * r + 2 * hb + 1) ^ ((n >> 2) & (NCH - 1))) << 4)) = w1; } }
    }
    LDS_WAIT();
#pragma unroll
    for (int t = 0; t < 2 * NCH; ++t) { const int n = lane / NCH + (64 / NCH) * t, c = lane % NCH;
        const u32x4 w = *(const LAS u32x4*)(scr + n * ROWB + ((c ^ ((n >> 2) & (NCH - 1))) << 4));
        *(u32x4*)((unsigned char*)WT + ((size_t)(n0 + n) * K + k0) * EB + c * 16) = w; }
    LDS_WAIT();
}
struct LayerW { const float *w_in, *w_uq, *w_ukv, *w_out, *w_up, *w_down; };
constexpr int CONV_ITEMS = (DM / 64) * (INP / 128) + (QRANK / 64) * (768 / 128) + (KVRANK / 64) * (1024 / 128) + (MIXW / 64) * (DM / 128) + (DM / 64) * (DFF2 / 128) + (DFF / 64) * (DM / 128);
constexpr int CONV_SPLIT = 3456;
__device__ __forceinline__ void convert_item(const WG& g, const float* const* in, unsigned char* ws, int l, int it) {
    LAS unsigned char* scr = g.lds + g.wave * 16384;
    constexpr int I_IN = (DM / 64) * (INP / 128), I_UQ = (QRANK / 64) * (768 / 128), I_UKV = (KVRANK / 64) * (1024 / 128), I_OUT = (MIXW / 64) * (DM / 128),
                  I_UP = (DM / 64) * (DFF2 / 128), I_DOWN = (DFF / 64) * (DM / 128), I_LAYER = I_IN + I_UQ + I_UKV + I_OUT + I_UP + I_DOWN;
    static_assert(I_LAYER == CONV_ITEMS, "item count");
    unsigned char* wl = ws + WS_W + (size_t)l * W_LAYER;
    int r = it;
    if (r < I_IN) { transpose_item<1, false>(in[2] + (size_t)l * DM * INW, DM, INW, INP, wl + W_IN, scr, r, g.lane, 1.f, in[1] + (size_t)l * DM); return; } r -= I_IN;
    if (r < I_UQ) { transpose_item<0, false>(in[10] + (size_t)l * QRANK * 768, QRANK, 768, 768, wl + W_UQ, scr, r, g.lane, 1.f, in[8] + (size_t)l * QRANK); return; } r -= I_UQ;
    if (r < I_UKV) { transpose_item<0, false>(in[11] + (size_t)l * KVRANK * 1024, KVRANK, 1024, 1024, wl + W_UKV, scr, r, g.lane, 1.f, in[9] + (size_t)l * KVRANK); return; } r -= I_UKV;
    if (r < I_OUT) { transpose_item<0, false>(in[15] + (size_t)l * MIXW * DM, MIXW, DM, DM, wl + W_OUT, scr, r, g.lane, 1.f, in[14] + (size_t)l * MIXW); return; } r -= I_OUT;
    if (r < I_UP) { transpose_item<0, FFN_FP8>(in[17] + (size_t)l * DM * DFF2, DM, DFF2, DFF2, wl + W_UP, scr, r, g.lane, WUP_SCALE, in[16] + (size_t)l * DM); return; } r -= I_UP;
    transpose_item<0, FFN_FP8>(in[20] + (size_t)l * DFF * DM, DFF, DM, DM, wl + W_DOWN, scr, r, g.lane, WDOWN_SCALE, nullptr);
}
__device__ __forceinline__ void convert_layer(const WG& g, const float* const* in, unsigned char* ws, int l, int widx, int nw, int it0 = 0, int it1 = CONV_ITEMS) {
    for (int it = it0 + widx; it < it1; it += nw) convert_item(g, in, ws, l, it);
}
__device__ __forceinline__ void prologue_phase(const WG& g, const float* const* in, unsigned char* ws) {
    convert_layer(g, in, ws, 0, g.vcu * NWAVES + g.wave, g.G * NWAVES);
    float* cosC = (float*)(ws + WS_COSC); float* sinC = (float*)(ws + WS_SINC); float* cosR = (float*)(ws + WS_COSR); float* sinR = (float*)(ws + WS_SINR);
    for (int idx = (g.vcu * NWAVES + g.wave) * 64 + g.lane; idx < SEQ * 96; idx += g.G * NWAVES * 64) {
        const bool isC = idx < SEQ * 64; const int j = isC ? idx : idx - SEQ * 64;
        const int pos = isC ? (j >> 6) : (j >> 5), i = isC ? (j & 63) : (j & 31);
        const float ang = (float)pos * (isC ? INVF128[i] : INVF128[2 * i]);
        double rev = (double)ang * 0.15915494309189535; rev -= __builtin_rint(rev);
        const float fr = (float)rev, c = __builtin_amdgcn_cosf(fr), s = __builtin_amdgcn_sinf(fr);
        if (isC) { cosC[j] = c; sinC[j] = s; } else { cosR[j] = c; sinR[j] = s; }
    }
}

__device__ __forceinline__ void stream_init_phase(const WG& g, const float* x, bf16* XS, unsigned long long* SS) {
    const int gw = g.vcu * NWAVES + g.wave, NGW = g.G * NWAVES;
    for (int m = gw; m < M; m += NGW) {
        const f32x4* xr = (const f32x4*)(x + (size_t)m * DM) + g.lane;
        f32x4 v[8]; float s = 0.f;
#pragma unroll
        for (int j = 0; j < 8; ++j) { v[j] = xr[64 * j]; s += (v[j].x * v[j].x + v[j].y * v[j].y) + (v[j].z * v[j].z + v[j].w * v[j].w); }
        s = wave_sum(s);
        if (g.lane == 0) SS[m] = (unsigned long long)(s * 16777216.f);
        u32x2* o8 = (u32x2*)(XS + (size_t)m * DM) + g.lane;
#pragma unroll
        for (int j = 0; j < 8; ++j) { u32x2 w; w.x = cvt_pk_bf16(v[j].x, v[j].y); w.y = cvt_pk_bf16(v[j].z, v[j].w); o8[64 * j] = w; }
    }
}

__device__ __forceinline__ float log_sigmoid_f(float x) { return fminf(x, 0.f) - log1pf(expf(-fabsf(x))); }

__device__ __forceinline__ void head_norm128(const bf16* p, const float* gain, int hl, int li, float (&v)[8]) {
    unpack8(*(const u32x4*)(p + hl * 128 + li * 8), v);
    float ss = 0.f;
#pragma unroll
    for (int j = 0; j < 8; ++j) ss += v[j] * v[j];
    const float rstd = rsqrtf(sum16(ss) * (1.f / 128) + EPS);
    const f32x4 g0 = *(const f32x4*)(gain + li * 8), g1 = *(const f32x4*)(gain + li * 8 + 4);
#pragma unroll
    for (int j = 0; j < 4; ++j) { v[j] = v[j] * rstd * g0[j]; v[4 + j] = v[4 + j] * rstd * g1[j]; }
}
template <int NV>
__device__ __forceinline__ void rope_group(float (&v)[NV], const float* cs, const float* sn, int li) {
#pragma unroll
    for (int j = 0; j < NV; ++j) { const float pv = dppf<0x128>(v[j]); const float c = cs[j], s = sn[j];
        v[j] = (li < 8) ? (v[j] * c - pv * s) : (pv * s + v[j] * c); }
}

struct Prep { bf16* PROJ; bf16* OUT; bf16* QDR; bf16* QOUT; const bf16* KVR; bf16* KD; const float *fox_q, *fox_k, *moba_q, *moba_k, *q_g, *k_g, *b_forget; float* LF; float* KMS;
              const float *cosC, *sinC, *cosR, *sinR; unsigned* KMAX; };
__device__ __forceinline__ void mla_norm_rope(float (&n8)[8], float (&r4)[4], const float* gain, const float* cosR, const float* sinR, int pos, int li) {
    float ss = 0.f;
#pragma unroll
    for (int j = 0; j < 8; ++j) ss += n8[j] * n8[j];
#pragma unroll
    for (int j = 0; j < 4; ++j) ss += r4[j] * r4[j];
    const float rstd = rsqrtf(sum16(ss) * (1.f / QKD) + EPS);
    const f32x4 g0 = *(const f32x4*)(gain + li * 8), g1 = *(const f32x4*)(gain + li * 8 + 4), g2 = *(const f32x4*)(gain + 128 + li * 4);
#pragma unroll
    for (int j = 0; j < 4; ++j) { n8[j] = n8[j] * rstd * g0[j]; n8[4 + j] = n8[4 + j] * rstd * g1[j]; r4[j] = r4[j] * rstd * g2[j]; }
    const f32x4 c = *(const f32x4*)(cosR + pos * 32 + (li & 7) * 4), s = *(const f32x4*)(sinR + pos * 32 + (li & 7) * 4);
    float cs[4] = {c[0], c[1], c[2], c[3]}, sn[4] = {s[0], s[1], s[2], s[3]};
    rope_group<4>(r4, cs, sn, li);
}
struct PrepRaw { u32x4 aq, ak, cq, ck, qn, kn; u32x2 qr, kr; unsigned fw; f32x4 cc0, cc1, sc0, sc1, cr, sr; };
__device__ __forceinline__ PrepRaw prep_load(const Prep& P, int m, int hl, int li, int lane) {
    PrepRaw r; const bf16* row = P.PROJ + (size_t)m * INP; const int pos = m & (SEQ - 1);
    r.aq = *(const u32x4*)(row + C_AQ + hl * 128 + li * 8); r.ak = *(const u32x4*)(row + C_AK + hl * 128 + li * 8);
    r.cq = *(const u32x4*)(row + C_CQ + hl * 128 + li * 8); r.ck = *(const u32x4*)(row + C_CK + hl * 128 + li * 8);
    const bf16* qp = P.QDR + (size_t)m * 768 + hl * 192; r.qn = *(const u32x4*)(qp + li * 8); r.qr = *(const u32x2*)(qp + 128 + li * 4);
    r.kn = *(const u32x4*)(P.KVR + (size_t)m * 1024 + hl * 256 + li * 8); r.kr = *(const u32x2*)(row + C_DKR + li * 4);
    r.fw = (lane < 4) ? (unsigned)row[C_AF + lane] : 0u;
    const float* cp = P.cosC + pos * 64 + (li & 7) * 8; const float* sp = P.sinC + pos * 64 + (li & 7) * 8;
    r.cc0 = *(const f32x4*)cp; r.cc1 = *(const f32x4*)(cp + 4); r.sc0 = *(const f32x4*)sp; r.sc1 = *(const f32x4*)(sp + 4);
    r.cr = *(const f32x4*)(P.cosR + pos * 32 + (li & 7) * 4); r.sr = *(const f32x4*)(P.sinR + pos * 32 + (li & 7) * 4);
    return r;
}
__device__ __forceinline__ void norm128(u32x4 raw, const float (&gn)[8], float (&v)[8]) {
    unpack8(raw, v); float ss = 0.f;
#pragma unroll
    for (int j = 0; j < 8; ++j) ss += v[j] * v[j];
    const float rstd = rsqrtf(sum16(ss) * (1.f / 128) + EPS);
#pragma unroll
    for (int j = 0; j < 8; ++j) v[j] = v[j] * rstd * gn[j];
}
__device__ __forceinline__ void mla192(u32x4 rawn, u32x2 rawr, const float (&gn)[8], const float (&gr)[4], f32x4 c, f32x4 s, int li, float (&n8)[8], float (&r4)[4]) {
    unpack8(rawn, n8);
    r4[0] = __uint_as_float(rawr.x << 16); r4[1] = __uint_as_float(rawr.x & 0xffff0000u); r4[2] = __uint_as_float(rawr.y << 16); r4[3] = __uint_as_float(rawr.y & 0xffff0000u);
    float ss = 0.f;
#pragma unroll
    for (int j = 0; j < 8; ++j) ss += n8[j] * n8[j];
#pragma unroll
    for (int j = 0; j < 4; ++j) ss += r4[j] * r4[j];
    const float rstd = rsqrtf(sum16(ss) * (1.f / QKD) + EPS);
#pragma unroll
    for (int j = 0; j < 8; ++j) n8[j] = n8[j] * rstd * gn[j];
#pragma unroll
    for (int j = 0; j < 4; ++j) r4[j] = r4[j] * rstd * gr[j];
    float cs[4] = {c[0], c[1], c[2], c[3]}, sn[4] = {s[0], s[1], s[2], s[3]};
    rope_group<4>(r4, cs, sn, li);
}
__device__ __forceinline__ void prep_phase(const WG& g, const Prep& P) {
    LAS float* kacc = (LAS float*)g.lds;
    const int hl = g.lane >> 4, li = g.lane & 15;
    float gfq[8], gfk[8], gmq[8], gmk[8], gqn[8], gkn[8], gqr[4], gkr[4];
#pragma unroll
    for (int j = 0; j < 8; ++j) { gfq[j] = P.fox_q[li * 8 + j]; gfk[j] = P.fox_k[li * 8 + j]; gmq[j] = P.moba_q[li * 8 + j]; gmk[j] = P.moba_k[li * 8 + j]; gqn[j] = P.q_g[li * 8 + j]; gkn[j] = P.k_g[li * 8 + j]; }
#pragma unroll
    for (int j = 0; j < 4; ++j) { gqr[j] = P.q_g[128 + li * 4 + j]; gkr[j] = P.k_g[128 + li * 4 + j]; }
    const float bfg = (g.lane < 4) ? P.b_forget[g.lane] : 0.f;
    for (int chunk = g.vcu; chunk < M / 64; chunk += g.G) {
        float ksum[8]; float kmx = 0.f;
#pragma unroll
        for (int j = 0; j < 8; ++j) ksum[j] = 0.f;
        const int mb = chunk * 64 + g.wave * 8;
        PrepRaw raw = prep_load(P, mb, hl, li, g.lane);
        for (int rr = 0; rr < 8; ++rr) {
            const int m = mb + rr;
            PrepRaw nxt = raw; if (rr < 7) nxt = prep_load(P, m + 1, hl, li, g.lane);
            bf16* orow = P.OUT + (size_t)m * INP;
            float v[8];
            norm128(raw.aq, gfq, v); *(u32x4*)(orow + C_AQ + hl * 128 + li * 8) = pack8(v);
            norm128(raw.ak, gfk, v); *(u32x4*)(orow + C_AK + hl * 128 + li * 8) = pack8(v);
            { float kn2 = 0.f;
#pragma unroll
              for (int j = 0; j < 8; ++j) kn2 += v[j] * v[j];
              kmx = fmaxf(kmx, sum16(kn2)); }
            float cs[8], sn[8];
#pragma unroll
            for (int j = 0; j < 4; ++j) { cs[j] = raw.cc0[j]; cs[4 + j] = raw.cc1[j]; sn[j] = raw.sc0[j]; sn[4 + j] = raw.sc1[j]; }
            norm128(raw.cq, gmq, v); rope_group<8>(v, cs, sn, li); *(u32x4*)(orow + C_CQ + hl * 128 + li * 8) = pack8(v);
            norm128(raw.ck, gmk, v); rope_group<8>(v, cs, sn, li); *(u32x4*)(orow + C_CK + hl * 128 + li * 8) = pack8(v);
#pragma unroll
            for (int j = 0; j < 8; ++j) ksum[j] += v[j];
            { float n8[8], r4[4];
              mla192(raw.qn, raw.qr, gqn, gqr, raw.cr, raw.sr, li, n8, r4);
              bf16* qo = P.QOUT + (size_t)m * 768 + hl * 192;
              *(u32x4*)(qo + li * 8) = pack8(n8); u32x2 o; o.x = cvt_pk_bf16(r4[0], r4[1]); o.y = cvt_pk_bf16(r4[2], r4[3]); *(u32x2*)(qo + 128 + li * 4) = o; }
            { float n8[8], r4[4];
              mla192(raw.kn, raw.kr, gkn, gkr, raw.cr, raw.sr, li, n8, r4);
              bf16* kp = P.KD + (size_t)m * 768 + hl * 192;
              *(u32x4*)(kp + li * 8) = pack8(n8); u32x2 o; o.x = cvt_pk_bf16(r4[0], r4[1]); o.y = cvt_pk_bf16(r4[2], r4[3]); *(u32x2*)(kp + 128 + li * 4) = o; }
            if (g.lane < 4) P.LF[(size_t)m * 4 + g.lane] = log_sigmoid_f(bf2f(raw.fw) + bfg);
            raw = nxt;
        }
#pragma unroll
        for (int j = 0; j < 8; ++j) kacc[g.wave * 512 + hl * 128 + li * 8 + j] = ksum[j];
        if (li == 0) kacc[4096 + g.wave * 4 + hl] = kmx;
        __syncthreads();
        if (g.tid < 4) { float t = kacc[4096 + g.tid];
#pragma unroll
            for (int w = 1; w < 8; ++w) t = fmaxf(t, kacc[4096 + w * 4 + g.tid]);
            __hip_atomic_fetch_max(P.KMAX + ((chunk >> 6) * 4 + g.tid) * 16, __float_as_uint(t), __ATOMIC_RELAXED, __HIP_MEMORY_SCOPE_AGENT); }
        { float t = 0.f;
#pragma unroll
          for (int w = 0; w < 8; ++w) t += kacc[w * 512 + g.tid];
          P.KMS[(size_t)chunk * 512 + g.tid] = t; }
        __syncthreads();
    }
}

__device__ __forceinline__ void groupnorm_phase(const WG& g, bf16* O, const float* gain, bf16* OUT) {
    const int gw = g.vcu * NWAVES + g.wave, NGW = g.G * NWAVES;
    for (int m = gw; m < M; m += NGW) {
        bf16* row = O + (size_t)m * MIXW + g.lane * 8; bf16* orow = OUT + (size_t)m * MIXW + g.lane * 8;
#pragma unroll
        for (int grp = 0; grp < 4; ++grp) { float v[8]; unpack8(*(const u32x4*)(row + grp * GW), v); float ss = 0.f;
#pragma unroll
            for (int j = 0; j < 8; ++j) ss += v[j] * v[j];
            const float rstd = rsqrtf(wave_sum(ss) * (1.f / GW) + EPS);
            const f32x4 g0 = *(const f32x4*)(gain + grp * GW + g.lane * 8), g1 = *(const f32x4*)(gain + grp * GW + g.lane * 8 + 4);
#pragma unroll
            for (int j = 0; j < 4; ++j) { v[j] = v[j] * rstd * g0[j]; v[4 + j] = v[4 + j] * rstd * g1[j]; }
            *(u32x4*)(orow + grp * GW) = pack8(v); }
    }
}

__device__ __forceinline__ void convgate_phase(const WG& g, const bf16* U_, const float* cw, const float* cb, bf16* ACT) {
    const unsigned char* U = (const unsigned char*)U_; constexpr int UE = U_FP8 ? 1 : 2;
#define U_LD8(dst, rowi, coli) do { if constexpr (U_FP8) unpack8_fp8(*(const u32x2*)(U + ((size_t)(rowi) * DFF2 + (coli)) * UE), dst); else unpack8(*(const u32x4*)(U + ((size_t)(rowi) * DFF2 + (coli)) * UE), dst); } while (0)
    const int gw = g.vcu * NWAVES + g.wave, NGW = g.G * NWAVES;
    for (int u = gw; u < (M / 32) * 11; u += NGW) {
        const int cblk = u % 11, rc = u / 11, m0 = rc * 32, c0 = cblk * 512 + g.lane * 8;
        float w0[16], w1[16], w2[16], bb[16];
#pragma unroll
        for (int half = 0; half < 2; ++half) { const int c = c0 + half * DFF;
#pragma unroll
            for (int q = 0; q < 2; ++q) { const f32x4 a = *(const f32x4*)(cw + c + 4 * q), b = *(const f32x4*)(cw + DFF2 + c + 4 * q), d = *(const f32x4*)(cw + 2 * DFF2 + c + 4 * q), e = *(const f32x4*)(cb + c + 4 * q);
#pragma unroll
                for (int j = 0; j < 4; ++j) { w0[half * 8 + q * 4 + j] = a[j]; w1[half * 8 + q * 4 + j] = b[j]; w2[half * 8 + q * 4 + j] = d[j]; bb[half * 8 + q * 4 + j] = e[j]; } } }
        float p2[16], p1[16];
        if ((m0 & (SEQ - 1)) == 0) {
#pragma unroll
            for (int j = 0; j < 16; ++j) { p2[j] = 0.f; p1[j] = 0.f; }
        } else {
            float t[8];
            U_LD8(t, m0 - 2, c0);
#pragma unroll
            for (int j = 0; j < 8; ++j) p2[j] = t[j];
            U_LD8(t, m0 - 2, DFF + c0);
#pragma unroll
            for (int j = 0; j < 8; ++j) p2[8 + j] = t[j];
            U_LD8(t, m0 - 1, c0);
#pragma unroll
            for (int j = 0; j < 8; ++j) p1[j] = t[j];
            U_LD8(t, m0 - 1, DFF + c0);
#pragma unroll
            for (int j = 0; j < 8; ++j) p1[8 + j] = t[j];
        }
        for (int r0 = 0; r0 < 32; r0 += 8) {
            u32x4 gl[8], vl[8];
#pragma unroll
            for (int q = 0; q < 8; ++q) { if constexpr (U_FP8) { const u32x2 a = *(const u32x2*)(U + (size_t)(m0 + r0 + q) * DFF2 + c0), b = *(const u32x2*)(U + (size_t)(m0 + r0 + q) * DFF2 + DFF + c0); gl[q].x = a.x; gl[q].y = a.y; vl[q].x = b.x; vl[q].y = b.y; }
                else { gl[q] = *(const u32x4*)(U + ((size_t)(m0 + r0 + q) * DFF2 + c0) * 2); vl[q] = *(const u32x4*)(U + ((size_t)(m0 + r0 + q) * DFF2 + DFF + c0) * 2); } }
#pragma unroll
            for (int q = 0; q < 8; ++q) {
                float cur[16], t[8];
                if constexpr (U_FP8) unpack8_fp8((u32x2){gl[q].x, gl[q].y}, t); else unpack8(gl[q], t);
#pragma unroll
                for (int j = 0; j < 8; ++j) cur[j] = t[j];
                if constexpr (U_FP8) unpack8_fp8((u32x2){vl[q].x, vl[q].y}, t); else unpack8(vl[q], t);
#pragma unroll
                for (int j = 0; j < 8; ++j) cur[8 + j] = t[j];
                float o[8];
#pragma unroll
                for (int j = 0; j < 8; ++j) {
                    const float gt = bb[j] + w0[j] * p2[j] + w1[j] * p1[j] + w2[j] * cur[j];
                    const float vl_ = bb[8 + j] + w0[8 + j] * p2[8 + j] + w1[8 + j] * p1[8 + j] + w2[8 + j] * cur[8 + j];
                    o[j] = gt * __builtin_amdgcn_rcpf(1.f + __builtin_amdgcn_exp2f(gt * -1.4426950408889634f)) * vl_;
                }
                if constexpr (FFN_FP8) { u32x2 w; w.x = pack4_fp8(o[0], o[1], o[2], o[3]); w.y = pack4_fp8(o[4], o[5], o[6], o[7]); *(u32x2*)((unsigned char*)ACT + (size_t)(m0 + r0 + q) * DFF + c0) = w; }
                else *(u32x4*)(ACT + (size_t)(m0 + r0 + q) * DFF + c0) = pack8(o);
#pragma unroll
                for (int j = 0; j < 16; ++j) { p2[j] = p1[j]; p1[j] = cur[j]; }
            }
        }
    }
#undef U_LD8
}

namespace att {
enum { T_FOX = 0, T_STICK = 1, T_MOBA = 2, T_MLA = 3 };
constexpr int KVB = 64, SHM_K = 16384, SHM_V = 16384, SHM_KR = 8192;
constexpr int OFF_K = 0, OFF_V = 32768, OFF_KR = 65536, OFF_WS = 82432, OFF_MISC = 84480, OFF_AUX = 86016;
#define KSWZ(row, colB) ((row) * 256 + ((colB) ^ (((row) & 7) << 4)))
__device__ __forceinline__ int v_st(int k, int c) { const int kk = (k & ~0xC) | ((k & 4) << 1) | ((k & 8) >> 1); return ((kk >> 3) * 4 + (c >> 5)) * 512 + ((kk & 7) * 32 + (c & 31)) * 2; }
__device__ __forceinline__ int v_rd_base(int lane) { return ((lane & 3) << 3) | (((lane >> 2) & 3) << 6) | (((lane >> 4) & 1) << 5) | (((lane >> 5) & 1) << 8); }
constexpr int v_rd_off(int d0, int ks, int half) { return d0 * 512 + ks * 4096 + half * 2048; }
__device__ __forceinline__ int crow(int r, int hi) { return (r & 3) + 8 * (r >> 2) + 4 * hi; }

__device__ __forceinline__ void pack_p(const f32x16& p0, const f32x16& p1, bf16x8& pa0, bf16x8& pa1, bf16x8& pa2, bf16x8& pa3) {
#define PK4(P, B_, OUT) do { unsigned a0 = cvt_pk_bf16(P[B_+0], P[B_+1]), a1 = cvt_pk_bf16(P[B_+2], P[B_+3]);                          \
        unsigned b0 = cvt_pk_bf16(P[B_+4], P[B_+5]), b1 = cvt_pk_bf16(P[B_+6], P[B_+7]);                                             \
        auto r0 = __builtin_amdgcn_permlane32_swap(a0, b0, false, false); auto r1 = __builtin_amdgcn_permlane32_swap(a1, b1, false, false); \
        u32x4 w = {r0[0], r1[0], r0[1], r1[1]}; OUT = *reinterpret_cast<bf16x8*>(&w); } while (0)
    PK4(p0, 0, pa0); PK4(p0, 8, pa1); PK4(p1, 0, pa2); PK4(p1, 8, pa3);
#undef PK4
}
__device__ __forceinline__ void softmax_tile(f32x16& p0, f32x16& p1, float& m_reg, float& l_reg, float& alpha, const float SCALE, const float C2) {
    float pmax = p0[0];
#pragma unroll
    for (int r = 1; r < 16; ++r) pmax = fmaxf(pmax, p0[r]);
#pragma unroll
    for (int r = 0; r < 16; ++r) pmax = fmaxf(pmax, p1[r]);
    { auto rr = __builtin_amdgcn_permlane32_swap(__float_as_uint(pmax), __float_as_uint(pmax), false, false);
      pmax = fmaxf(__uint_as_float(rr[0]), __uint_as_float(rr[1])); }
    float mn;
    if (__builtin_expect(__all((pmax - m_reg) * SCALE <= 8.f), 1)) { mn = m_reg; alpha = 1.f; }
    else { mn = fmaxf(m_reg, pmax); alpha = __builtin_amdgcn_exp2f((m_reg - mn) * C2); m_reg = mn; }
    const float mnL = -mn * C2;
#pragma unroll
    for (int r = 0; r < 16; ++r) { p0[r] = __builtin_amdgcn_exp2f(fmaf(p0[r], C2, mnL)); p1[r] = __builtin_amdgcn_exp2f(fmaf(p1[r], C2, mnL)); }
    float ps = 0.f;
#pragma unroll
    for (int r = 0; r < 16; ++r) ps += p0[r];
#pragma unroll
    for (int r = 0; r < 16; ++r) ps += p1[r];
    { auto rr = __builtin_amdgcn_permlane32_swap(__float_as_uint(ps), __float_as_uint(ps), false, false);
      ps = __uint_as_float(rr[0]) + __uint_as_float(rr[1]); }
    l_reg = l_reg * alpha + ps;
}
__device__ __forceinline__ void pv_tile(f32x16* o, int vb0, bf16x8 pa0, bf16x8 pa1, bf16x8 pa2, bf16x8 pa3) {
#define TRRD(dst, off) asm volatile("ds_read_b64_tr_b16 %0, %1 offset:%2" : "=&v"(dst) : "v"(vb0), "i"(off) : "memory")
#define PV_D0(d0) do { s16x4 l0, l1, l2, l3, h0, h1, h2, h3; constexpr int b_ = v_rd_off(d0, 0, 0);   \
        TRRD(l0, b_); TRRD(h0, b_ + 2048); TRRD(l1, b_ + 4096); TRRD(h1, b_ + 6144); TRRD(l2, b_ + 8192); TRRD(h2, b_ + 10240); TRRD(l3, b_ + 12288); TRRD(h3, b_ + 14336); \
        asm volatile("s_waitcnt lgkmcnt(0)" ::: "memory"); SBAR();   \
        o[d0] = __builtin_amdgcn_mfma_f32_32x32x16_bf16(pa0, (bf16x8){l0[0], l0[1], l0[2], l0[3], h0[0], h0[1], h0[2], h0[3]}, o[d0], 0, 0, 0);   \
        o[d0] = __builtin_amdgcn_mfma_f32_32x32x16_bf16(pa1, (bf16x8){l1[0], l1[1], l1[2], l1[3], h1[0], h1[1], h1[2], h1[3]}, o[d0], 0, 0, 0);   \
        o[d0] = __builtin_amdgcn_mfma_f32_32x32x16_bf16(pa2, (bf16x8){l2[0], l2[1], l2[2], l2[3], h2[0], h2[1], h2[2], h2[3]}, o[d0], 0, 0, 0);   \
        o[d0] = __builtin_amdgcn_mfma_f32_32x32x16_bf16(pa3, (bf16x8){l3[0], l3[1], l3[2], l3[3], h3[0], h3[1], h3[2], h3[3]}, o[d0], 0, 0, 0); } while (0)
    PV_D0(0); PV_D0(1); PV_D0(2); PV_D0(3);
#undef PV_D0
#undef TRRD
}

__device__ __forceinline__ int moba_k0(unsigned um, int i) { unsigned mm = um; for (int j = 0; j < (i >> 2); ++j) mm &= mm - 1; return (__ffs(mm) - 1) * 256 + (i & 3) * 64; }
struct Tensors {
    const bf16* Q; const bf16* K; const bf16* V; int ldq, ldk, ldv;
    int qh, kh, vh, grp;
    bf16* O;
    const float* LF; const float* KMS; const unsigned* KMAX; unsigned long long* SSG;
};

template <int TYPE>
__device__ __forceinline__ void attn_item(const Tensors& T, int b, int h, int qb, LAS unsigned char* lds, unsigned ldsb) {
    constexpr bool FOX = TYPE == T_FOX, STICK = TYPE == T_STICK, MOBA = TYPE == T_MOBA, MLA = TYPE == T_MLA;
    constexpr int NKS = MLA ? 12 : 8;
    const float SCALE = MLA ? 0.07216878364870322f : 0.08838834764831845f;
    const float C2 = SCALE * 1.4426950408889634f;
    int tid_ = threadIdx.x; asm volatile("" : "+v"(tid_));
    const int tid = tid_, wid = __builtin_amdgcn_readfirstlane(tid >> 6), lane = tid & 63, r32 = lane & 31, hi = lane >> 5;
    const int qlo = qb * 256 + wid * 32, qpos = qlo + r32;
    const size_t tok0 = (size_t)b * SEQ;
    LAS unsigned* misc = (LAS unsigned*)(lds + OFF_MISC);
    LAS float* wsf = (LAS float*)(lds + OFF_WS) + wid * 64; LAS float* li_l = wsf; LAS float* al_l = wsf + 32;
    bf16x8 qr[NKS];
    { const bf16* qp = T.Q + (tok0 + qpos) * T.ldq + h * T.qh + hi * 8;
#pragma unroll
      for (int d0 = 0; d0 < NKS; ++d0) qr[d0] = *(const bf16x8*)(qp + d0 * 16); }
    const bf16* Kp = T.K + tok0 * T.ldk + h * T.kh; const bf16* Vp = T.V + tok0 * T.ldv + h * T.vh;
    unsigned um = 0, selmask = 0; int NT = 4 * (qb + 1);
    if constexpr (MOBA) {
        { LAS float* KM = (LAS float*)(lds + OFF_AUX);
          for (int idx = tid; idx < qb * 128; idx += NWAVES * 64) { const int n = idx >> 7, d = idx & 127;
              const float* s = T.KMS + ((size_t)(b * 64 + 4 * n) * 4 + h) * 128 + d;
              KM[idx] = ((s[0] + s[512]) + (s[1024] + s[1536])) * (1.f / 256); }
          __syncthreads();
          float gate[15];
#pragma unroll
          for (int n = 0; n < 15; ++n) { gate[n] = -__builtin_inff();
              if (n < qb) { float a = 0.f;
#pragma unroll
                  for (int d0 = 0; d0 < 8; ++d0) { const f32x4 ka = *(const LAS f32x4*)(KM + n * 128 + d0 * 16 + hi * 8), kb = *(const LAS f32x4*)(KM + n * 128 + d0 * 16 + hi * 8 + 4);
                      const u32x4 w = __builtin_bit_cast(u32x4, qr[d0]);
                      a = fmaf(__uint_as_float(w[0] << 16), ka[0], a); a = fmaf(__uint_as_float(w[0] & 0xffff0000u), ka[1], a);
                      a = fmaf(__uint_as_float(w[1] << 16), ka[2], a); a = fmaf(__uint_as_float(w[1] & 0xffff0000u), ka[3], a);
                      a = fmaf(__uint_as_float(w[2] << 16), kb[0], a); a = fmaf(__uint_as_float(w[2] & 0xffff0000u), kb[1], a);
                      a = fmaf(__uint_as_float(w[3] << 16), kb[2], a); a = fmaf(__uint_as_float(w[3] & 0xffff0000u), kb[3], a); }
                  gate[n] = a + __shfl_xor(a, 32); } }
#pragma unroll
          for (int pass = 0; pass < 3; ++pass) { float best = -__builtin_inff(); int bi = -1;
#pragma unroll
              for (int n = 0; n < 15; ++n) { if (n < qb && !((selmask >> n) & 1u) && gate[n] > best) { best = gate[n]; bi = n; } }
              if (bi >= 0) selmask |= 1u << bi; } }
        unsigned w = selmask;
#pragma unroll
        for (int o = 1; o < 64; o <<= 1) w |= __shfl_xor(w, o);
        if (lane == 0) __hip_atomic_fetch_or(&misc[1], w, __ATOMIC_RELAXED, __HIP_MEMORY_SCOPE_WORKGROUP);
        __syncthreads();
        um = misc[1] | (1u << qb); NT = 4 * __popc(um);
    }
#define tile_k0(i_) ((STICK || FOX) ? 64 * (NT - 1 - (i_)) : MOBA ? moba_k0(um, (i_)) : 64 * (i_))
    const int sr = tid >> 4, sc = (tid & 15) * 8, kws = KSWZ(sr, sc * 2), vst0 = v_st(sr, sc), vst1 = v_st(32 + sr, sc);
    const int krr = tid >> 3, krc = tid & 7, krw = krr * 128 + ((krc ^ ((krr >> 1) & 7)) << 4);
    bf16x8 st_k0, st_k1, st_v0, st_v1, st_kr;
    LAS float* cfl = (LAS float*)(lds + OFF_AUX);
    if constexpr (FOX) { LAS double* dsum = (LAS double*)(lds + OFF_AUX + 16384);
        const int nk = 256 * (qb + 1); double loc[8], run = 0.0;
        if (8 * tid < nk) {
#pragma unroll
            for (int j = 0; j < 8; ++j) { run += (double)T.LF[(tok0 + 8 * tid + j) * 4 + h]; loc[j] = run; } }
        double inc = run;
#pragma unroll
        for (int o = 1; o < 64; o <<= 1) { const double t = __shfl_up(inc, o); if (lane >= o) inc += t; }
        if (lane == 63) dsum[wid] = inc;
        __syncthreads();
        double off = inc - run;
        for (int w = 0; w < wid; ++w) off += dsum[w];
        if (8 * tid < nk) {
#pragma unroll
            for (int j = 0; j < 8; ++j) cfl[8 * tid + j] = (float)(off + loc[j]); }
        __syncthreads(); }
#define SLOAD(k0_) do { const int k0s = (k0_); const bf16* kp_ = Kp + (size_t)(k0s + sr) * T.ldk + sc; const bf16* vp_ = Vp + (size_t)(k0s + sr) * T.ldv + sc; \
        st_k0 = *(const bf16x8*)kp_; st_k1 = *(const bf16x8*)(kp_ + (size_t)32 * T.ldk); st_v0 = *(const bf16x8*)vp_; st_v1 = *(const bf16x8*)(vp_ + (size_t)32 * T.ldv); \
        if constexpr (MLA) st_kr = *(const bf16x8*)(Kp + (size_t)(k0s + krr) * T.ldk + 128 + krc * 8); \
        } while (0)
#define SWRITE(bf) do { *(LAS bf16x8*)(lds + OFF_K + (bf) * SHM_K + kws) = st_k0; *(LAS bf16x8*)(lds + OFF_K + (bf) * SHM_K + kws + 32 * 256) = st_k1; \
        *(LAS bf16x8*)(lds + OFF_V + (bf) * SHM_V + vst0) = st_v0; *(LAS bf16x8*)(lds + OFF_V + (bf) * SHM_V + vst1) = st_v1; \
        if constexpr (MLA) *(LAS bf16x8*)(lds + OFF_KR + (bf) * SHM_KR + krw) = st_kr; \
        } while (0)
    const int vrd = v_rd_base(lane);
    const int kq0 = KSWZ(r32, (0 * 16 + hi * 8) * 2), kq1 = KSWZ(r32, (1 * 16 + hi * 8) * 2), kq2 = KSWZ(r32, (2 * 16 + hi * 8) * 2), kq3 = KSWZ(r32, (3 * 16 + hi * 8) * 2);
    float m_reg = -1e30f, l_reg = 0.f, Pst = 1.f; f32x16 o[4] = {};
    const float ci = FOX ? cfl[qpos] * 11.313708498984761f : 0.f;
    float bound_s = 0.f; bool wdone = false;
    if constexpr (FOX) { float ssq = 0.f;
#pragma unroll
        for (int d0 = 0; d0 < 8; ++d0) { const u32x4 w = __builtin_bit_cast(u32x4, qr[d0]);
#pragma unroll
            for (int e = 0; e < 4; ++e) { const float a0 = __uint_as_float(w[e] << 16), a1 = __uint_as_float(w[e] & 0xffff0000u); ssq += a0 * a0 + a1 * a1; } }
        ssq += __shfl_xor(ssq, 32);
        const float kmax2 = __uint_as_float(__hip_atomic_load(T.KMAX + (b * 4 + h) * 16, __ATOMIC_RELAXED, __HIP_MEMORY_SCOPE_AGENT));
        bound_s = sqrtf(ssq) * sqrtf(kmax2) * 1.02f; }
    SLOAD(tile_k0(0)); SWRITE(0);
    for (int i = 0; i < NT; ++i) {
        const int cur = i & 1, k0 = tile_k0(i);
        if (i + 1 < NT) SLOAD(tile_k0(i + 1));
        __syncthreads();
        if constexpr (STICK || FOX) { if (i > 0) { bool alld = true;
#pragma unroll
            for (int w = 0; w < 8; ++w) alld = alld && (misc[4 + ((i - 1) & 1) * 8 + w] != 0u);
            if (alld) break; } }
        bool act = k0 <= qlo;
        if constexpr (MOBA) { const int blk = k0 >> 8; if (blk != qb) act = __any((selmask >> blk) & 1u); }
        if constexpr (FOX) { if (wdone) act = false; }
        if (act) {
            f32x16 p0, p1;
            if constexpr (FOX) { const LAS float* bp = cfl + k0 + 4 * hi;
#pragma unroll
                for (int gq = 0; gq < 4; ++gq) { const f32x4 c0 = *(const LAS f32x4*)(bp + 8 * gq), c1 = *(const LAS f32x4*)(bp + 32 + 8 * gq);
#pragma unroll
                    for (int q = 0; q < 4; ++q) { p0[4 * gq + q] = fmaf(c0[q], -11.313708498984761f, ci); p1[4 * gq + q] = fmaf(c1[q], -11.313708498984761f, ci); } } }
            else { p0 = f32x16{}; p1 = f32x16{}; }
            { const LAS unsigned char* kb = lds + OFF_K + cur * SHM_K;
#pragma unroll
              for (int d0 = 0; d0 < 8; ++d0) { const int ko = ((d0 & 3) == 0 ? kq0 : (d0 & 3) == 1 ? kq1 : (d0 & 3) == 2 ? kq2 : kq3) + (d0 >> 2) * 128;
                const bf16x8 b0 = *(const LAS bf16x8*)(kb + ko), b1 = *(const LAS bf16x8*)(kb + ko + 32 * 256);
                p0 = __builtin_amdgcn_mfma_f32_32x32x16_bf16(b0, qr[d0], p0, 0, 0, 0);
                p1 = __builtin_amdgcn_mfma_f32_32x32x16_bf16(b1, qr[d0], p1, 0, 0, 0); } }
            if constexpr (MLA) { const LAS unsigned char* kb = lds + OFF_KR + cur * SHM_KR + r32 * 128; const int sw = (r32 >> 1) & 7;
#pragma unroll
              for (int dd = 0; dd < 4; ++dd) { const int ko = ((2 * dd + hi) ^ sw) << 4;
                const bf16x8 b0 = *(const LAS bf16x8*)(kb + ko), b1 = *(const LAS bf16x8*)(kb + ko + 32 * 128);
                p0 = __builtin_amdgcn_mfma_f32_32x32x16_bf16(b0, qr[8 + dd], p0, 0, 0, 0);
                p1 = __builtin_amdgcn_mfma_f32_32x32x16_bf16(b1, qr[8 + dd], p1, 0, 0, 0); } }
            bf16x8 pa0, pa1, pa2, pa3;
            if constexpr (!STICK) {
                const float NEG = -__builtin_inff();
                if constexpr (MOBA) { const int blk = k0 >> 8; if (blk != qb && !((selmask >> blk) & 1u)) {
#pragma unroll
                    for (int r = 0; r < 16; ++r) { p0[r] = NEG; p1[r] = NEG; } } }
                if (k0 + 63 > qlo) { const int dq = qpos - k0 - 4 * hi;
#pragma unroll
                    for (int r = 0; r < 16; ++r) { const int c = (r & 3) + 8 * (r >> 2); if (dq - c < 0) p0[r] = NEG; if (dq - c - 32 < 0) p1[r] = NEG; } }
                float alpha;
                softmax_tile(p0, p1, m_reg, l_reg, alpha, SCALE, C2);
                if constexpr (FOX) { const float ck0 = cfl[k0] * 11.313708498984761f;
                    wdone = __all((bound_s + ci - ck0 - m_reg) * SCALE < -30.f); }
                if (__any(alpha < 1.f)) { if (hi == 0) al_l[r32] = alpha; LDS_WAIT();
#pragma unroll
                    for (int d_ = 0; d_ < 4; ++d_)
#pragma unroll
                        for (int r = 0; r < 16; ++r) o[d_][r] *= al_l[crow(r, hi)];
                    LDS_WAIT(); }
                pack_p(p0, p1, pa0, pa1, pa2, pa3);
            } else {
                const bool needmask = k0 + 63 >= qlo; const int dq = qpos - k0 - 4 * hi;
                float Tg[8];
#pragma unroll
                for (int gq = 0; gq < 8; ++gq) {
                    float be[4], om[4];
#pragma unroll
                    for (int q = 0; q < 4; ++q) { const float s = gq < 4 ? p0[4 * gq + q] : p1[4 * (gq - 4) + q];
                        const float z2 = fminf(fmaxf(s * C2, -115.f), 115.f), e = __builtin_amdgcn_exp2f(z2);
                        float omq = __builtin_amdgcn_rcpf(1.f + e), beq = e * omq;
                        const int c = q + 8 * (gq & 3) + 32 * (gq >> 2);
                        if (needmask && !(c < dq)) { omq = 1.f; beq = 0.f; }
                        om[q] = omq; be[q] = beq; }
                    const float s2 = om[3], s1 = s2 * om[2], s0 = s1 * om[1];
                    Tg[gq] = s0 * om[0];
                    const float w0 = be[0] * s0, w1 = be[1] * s1, w2 = be[2] * s2, w3 = be[3];
                    if (gq < 4) { p0[4 * gq] = w0; p0[4 * gq + 1] = w1; p0[4 * gq + 2] = w2; p0[4 * gq + 3] = w3; }
                    else { p1[4 * (gq - 4)] = w0; p1[4 * (gq - 4) + 1] = w1; p1[4 * (gq - 4) + 2] = w2; p1[4 * (gq - 4) + 3] = w3; }
                }
                float S = Pst;
#pragma unroll
                for (int gq = 7; gq >= 0; --gq) {
                    const float oth = __shfl_xor(Tg[gq], 32);
                    const float E = hi ? S : S * oth;
                    S = S * (Tg[gq] * oth);
                    if (gq < 4) { p0[4 * gq] *= E; p0[4 * gq + 1] *= E; p0[4 * gq + 2] *= E; p0[4 * gq + 3] *= E; }
                    else { p1[4 * (gq - 4)] *= E; p1[4 * (gq - 4) + 1] *= E; p1[4 * (gq - 4) + 2] *= E; p1[4 * (gq - 4) + 3] *= E; }
                }
                Pst = S;
                pack_p(p0, p1, pa0, pa1, pa2, pa3);
            }
            pv_tile(o, (int)(ldsb + OFF_V + cur * SHM_V) + vrd, pa0, pa1, pa2, pa3);
        }
        if constexpr (STICK) { const bool dn = __all(Pst < 1e-30f); if (lane == 0) misc[4 + (i & 1) * 8 + wid] = dn ? 1u : 0u; }
        if constexpr (FOX) { if (lane == 0) misc[4 + (i & 1) * 8 + wid] = wdone ? 1u : 0u; }
        if (i + 1 < NT) SWRITE(cur ^ 1);
    }
    float rli[16];
    if constexpr (!STICK) { if (hi == 0) li_l[r32] = l_reg; LDS_WAIT();
#pragma unroll
        for (int r = 0; r < 16; ++r) rli[r] = __builtin_amdgcn_rcpf(li_l[crow(r, hi)]); }
    __syncthreads();
    LAS unsigned char* ost = lds + wid * 8192;
    float sq[16];
#pragma unroll
    for (int r = 0; r < 16; ++r) { const int orow = crow(r, hi); sq[r] = 0.f;
#pragma unroll
        for (int d0 = 0; d0 < 4; ++d0) { float v = o[d0][r]; if constexpr (!STICK) v *= rli[r];
            sq[r] += v * v;
            const float vn = __shfl_xor(v, 1);
            if ((r32 & 1) == 0) *(LAS unsigned*)(ost + orow * 256 + (d0 * 32 + r32) * 2) = cvt_pk_bf16(v, vn); } }
    LDS_WAIT();
    { bf16* Ow = T.O + (tok0 + qlo) * MIXW + h * HD;
#pragma unroll
      for (int k = 0; k < 8; ++k) { const int row = (lane >> 4) + 4 * k, ch = lane & 15;
          const u32x4 w = *(const LAS u32x4*)(ost + row * 256 + ch * 16);
          *(u32x4*)(Ow + (size_t)row * MIXW + ch * 8) = w; } }
#pragma unroll
    for (int r = 0; r < 16; ++r) {
#pragma unroll
        for (int s = 1; s < 32; s <<= 1) sq[r] += __shfl_xor(sq[r], s); }
    if (r32 == 0) {
#pragma unroll
        for (int r = 0; r < 16; ++r) __hip_atomic_fetch_add(T.SSG + (tok0 + qlo + crow(r, hi)) * 4 + T.grp, (unsigned long long)(sq[r] * 16777216.f), __ATOMIC_RELAXED, __HIP_MEMORY_SCOPE_AGENT); }
#undef SLOAD
#undef SWRITE
#undef tile_k0
}

struct PhaseArgs { const bf16* PROJ; const bf16* QDR; const bf16* KVR; const bf16* KD; bf16* O; const float* LF; const float* KMS; unsigned* queue; const unsigned* KMAX; unsigned long long* SSG; int only; };
struct PairOrder { unsigned char ty[64], qb[64]; };
__host__ __device__ constexpr PairOrder make_pair_order() {
    PairOrder o{}; float cost[64] = {}; int n = 0;
    for (int ty = 0; ty < 4; ++ty) for (int qb = 0; qb < 16; ++qb) {
        const float c = ty == T_MLA ? 1.25f * (qb + 1) : ty == T_MOBA ? 1.0f * (qb + 1) + 0.5f : ty == T_FOX ? (qb + 1 < 5 ? 1.0f * (qb + 1) : 4.5f + 0.05f * qb) : (qb + 1 < 2 ? 0.6f : 0.8f + 0.01f * qb);
        int pos = n; while (pos > 0 && cost[pos - 1] < c) { cost[pos] = cost[pos - 1]; o.ty[pos] = o.ty[pos - 1]; o.qb[pos] = o.qb[pos - 1]; --pos; }
        cost[pos] = c; o.ty[pos] = (unsigned char)ty; o.qb[pos] = (unsigned char)qb; ++n; }
    return o;
}
__constant__ PairOrder PAIR_ORDER = make_pair_order();
__device__ __forceinline__ void attn_phase(const PhaseArgs& A, LAS unsigned char* lds, unsigned ldsb) {
    LAS unsigned* misc = (LAS unsigned*)(lds + OFF_MISC);
    Tensors TD, TA, TC, TB;
    TD.LF = TA.LF = TC.LF = TB.LF = A.LF; TD.KMS = TA.KMS = TC.KMS = TB.KMS = A.KMS; TD.KMAX = TA.KMAX = TC.KMAX = TB.KMAX = A.KMAX; TD.SSG = TA.SSG = TC.SSG = TB.SSG = A.SSG;
    TD.Q = A.QDR; TD.K = A.KD; TD.V = A.KVR + 128; TD.ldq = 768; TD.ldk = 768; TD.ldv = 1024; TD.qh = 192; TD.kh = 192; TD.vh = 256; TD.O = A.O + 3 * GW; TD.grp = 3;
    TA.Q = A.PROJ + C_AQ; TA.K = A.PROJ + C_AK; TA.V = A.PROJ + C_AV; TA.ldq = TA.ldk = TA.ldv = INP; TA.qh = TA.kh = TA.vh = 128; TA.O = A.O; TA.grp = 0;
    TC = TA; TC.Q = A.PROJ + C_CQ; TC.K = A.PROJ + C_CK; TC.V = A.PROJ + C_CV; TC.O = A.O + 2 * GW; TC.grp = 2;
    TB = TA; TB.Q = A.PROJ + C_BQ; TB.K = A.PROJ + C_BK; TB.V = A.PROJ + C_BV; TB.O = A.O + GW; TB.grp = 1;
    const int G = (int)gridDim.x, x0 = (int)blockIdx.x & 7, nstat = (G == 256) ? 32 : 0;
    int kq = 0;
    for (int round = 0;; ++round) {
        if (threadIdx.x == 0) { unsigned code = 0xffffffffu;
            if (round == 0 && nstat) code = (unsigned)(x0 * 128 + ((int)blockIdx.x >> 3));
            else { for (; kq < 8; ++kq) { const int q = (x0 + kq) & 7;
                       const unsigned i = (unsigned)nstat + __hip_atomic_fetch_add(A.queue + 16 * q, 1u, __ATOMIC_RELAXED, __HIP_MEMORY_SCOPE_AGENT);
                       if (i < 128u) { code = (unsigned)q * 128u + i; break; } } }
            misc[0] = code; misc[1] = 0u; }
        __syncthreads();
        const unsigned code = misc[0];
        if (code == 0xffffffffu) break;
        const int q = (int)(code >> 7), i = (int)(code & 127u), pr = i >> 1, bh = q + 8 * (i & 1), ty = PAIR_ORDER.ty[pr], qb = PAIR_ORDER.qb[pr];
        if (ty == T_MLA) attn_item<T_MLA>(TD, bh >> 2, bh & 3, qb, lds, ldsb);
        else if (ty == T_MOBA) attn_item<T_MOBA>(TC, bh >> 2, bh & 3, qb, lds, ldsb);
        else if (ty == T_FOX) attn_item<T_FOX>(TA, bh >> 2, bh & 3, qb, lds, ldsb);
        else attn_item<T_STICK>(TB, bh >> 2, bh & 3, qb, lds, ldsb);
        __syncthreads();
    }
}
}

#ifndef PROBE_DUP
#define PROBE_DUP 0
#endif
#ifndef MK_SPLIT
#define MK_SPLIT 0
#endif
constexpr int N_PHASES = 1 + 8 * DEPTH;
struct Args { const float* in[21]; float* out; unsigned char* ws; int ph_lo, ph_hi; };
__global__ void __launch_bounds__(NWAVES * 64, 2) hybrid_fwd(Args args) {
    extern __shared__ __attribute__((aligned(16))) unsigned char lds_raw[];
#define MKWG() WG g; { int t_ = threadIdx.x; asm volatile("" : "+v"(t_)); g.lds = (LAS unsigned char*)lds_raw; g.tid = t_; g.lane = t_ & 63; g.wave = __builtin_amdgcn_readfirstlane(t_ >> 6); \
        g.G = gridDim.x; const int bx_ = blockIdx.x; g.vcu = (g.G % 8 == 0) ? (bx_ % 8) * (g.G / 8) + bx_ / 8 : bx_; }
    LAS unsigned char* const lds0 = (LAS unsigned char*)lds_raw; const int tid0 = threadIdx.x, G0 = gridDim.x;
    volatile LAS unsigned* MISC = (volatile LAS unsigned*)(lds0 + MISC_OFF);
    unsigned char* ws = args.ws;
    unsigned* ctl = (unsigned*)(ws + WS_CTL);
    for (int u = tid0; u < (LDS_BYTES - RING_BYTES) / 4; u += NWAVES * 64) ((LAS unsigned*)(lds0 + RING_BYTES))[u] = 0u;
    __syncthreads();
    const int lo = args.ph_lo, hi = args.ph_hi;
    XcdBarrier bar; bar.bar = ctl + CW_BAR; bar.x = 0; bar.st = nullptr;
    if (hi - lo > 1) bar = xcd_barrier_post(ctl + CW_BAR, MISC + 8);
    const unsigned ldsb = (unsigned)(uintptr_t)lds_raw;
#ifndef PH_EN
#define PH_EN 0x1fff
#endif
#define IN(k) (lo <= (k) && (k) < hi)
#define EN(j) ((PH_EN >> (j)) & 1)
#if PROBE_DUP == 10
#define SEAM(k) do { if (IN(k) && IN((k) + 1)) { xcd_barrier(bar); xcd_barrier(bar); } } while (0)
#else
#define SEAM(k) do { if (IN(k) && IN((k) + 1)) xcd_barrier(bar); } while (0)
#endif

    bf16* XS = (bf16*)(ws + WS_XS); bf16* PROJ = (bf16*)(ws + WS_PROJ); bf16* QDR = (bf16*)(ws + WS_QDR); bf16* KVR = (bf16*)(ws + WS_KVR); bf16* KD = (bf16*)(ws + WS_KD);
    bf16* OB = (bf16*)(ws + WS_O); bf16* UB = (bf16*)(ws + WS_U); bf16* ACT = (bf16*)(ws + WS_ACT); bf16* X8 = (bf16*)(ws + WS_X8);
    float* LF = (float*)(ws + WS_LF); float* KMS = (float*)(ws + WS_KMS); unsigned long long* SS = (unsigned long long*)(ws + WS_SS); unsigned long long* SSG = (unsigned long long*)(ws + WS_SSG); unsigned long long* SSD = (unsigned long long*)(ws + WS_SSD);
    const float* cosC = (const float*)(ws + WS_COSC); const float* sinC = (const float*)(ws + WS_SINC); const float* cosR = (const float*)(ws + WS_COSR); const float* sinR = (const float*)(ws + WS_SINR);

    if (EN(12) && IN(0)) { MKWG(); prologue_phase(g, args.in, ws); __syncthreads(); stream_init_phase(g, args.in[0], XS, SS);
#if PROBE_DUP == 4
        __syncthreads(); prologue_phase(g, args.in, ws); __syncthreads(); stream_init_phase(g, args.in[0], XS, SS);
#endif
    }
    SEAM(0);

    for (int l = 0; l < DEPTH; ++l) {
        const int p0 = 1 + 8 * l;
        const unsigned char* wl = ws + WS_W + (size_t)l * W_LAYER;
        unsigned long long* SS1 = SS + (size_t)(2 * l) * M; unsigned long long* SS2 = SS1 + M;
        unsigned long long* SSQ = SSD + (size_t)(2 * l) * M; unsigned long long* SSKV = SSQ + M;
        if (EN(0) && IN(p0 + 0)) { MKWG(); pg8::Gemm gm{XS, (const bf16*)(wl + W_IN), M, INP, DM, DM, nullptr}; pg8::StaticOrder S; S.init(M, INP, g.G, (int)blockIdx.x);
            pg8::EpiBf16 E{PROJ, INP, 1.f, SS1, 1.f / DM, SSQ, SSKV, C_DCQ / 256, C_DCQ / 256 + 1, C_DCKV / 256, 0};
            pg8::gemm_phase<pg8::EpiBf16, pg8::StaticOrder, true, true>(g.lds, gm, S, E);
            if (l + 1 < DEPTH) { MKWG(); const int nwg = (M / 256) * (INP / 256), maxr = (nwg + g.G - 1) / g.G, rem = nwg - (maxr - 1) * g.G, c = (int)blockIdx.x;
                if (rem >= g.G) convert_layer(g, args.in, ws, l + 1, c * NWAVES + g.wave, g.G * NWAVES, 0, CONV_SPLIT);
                else if (c >= rem) convert_layer(g, args.in, ws, l + 1, (c - rem) * NWAVES + g.wave, (g.G - rem) * NWAVES, 0, CONV_SPLIT); }
#if PROBE_DUP == 1
            pg8::gemm_phase<pg8::EpiBf16, pg8::StaticOrder, true, true>(g.lds, gm, S, E);
#endif
#if PROBE_DUP == 22
            xcd_barrier(bar); { pg8::EpiBf16 E2{PROJ, INP, 1.f, SS1, 1.f / DM, nullptr, nullptr, 0, 0, 0, 0}; pg8::gemm_phase<pg8::EpiBf16, pg8::StaticOrder, true, true>(g.lds, gm, S, E2); }
#endif
        }
        SEAM(p0 + 0);
        if (EN(2) && IN(p0 + 1)) { MKWG();
            { pg8::Gemm gm{PROJ + C_DCQ, (const bf16*)(wl + W_UQ), M, 768, QRANK, INP, nullptr}; pg8::StaticOrder S; S.init(M, 768, g.G, (int)blockIdx.x);
              pg8::EpiBf16 E{QDR, 768, 1.f, SSQ, 1.f / QRANK, nullptr, nullptr, 0, 0, 0, 0};
              pg8::gemm_phase<pg8::EpiBf16, pg8::StaticOrder, true, true>(g.lds, gm, S, E); }
            { pg8::Gemm gm{PROJ + C_DCKV, (const bf16*)(wl + W_UKV), M, 1024, KVRANK, INP, nullptr}; pg8::StaticOrder S; S.init(M, 1024, g.G, (int)blockIdx.x);
              pg8::EpiBf16 E{KVR, 1024, 1.f, SSKV, 1.f / KVRANK, nullptr, nullptr, 0, 0, 0, 0};
              pg8::gemm_phase<pg8::EpiBf16, pg8::StaticOrder, true, true>(g.lds, gm, S, E); }
        }
        SEAM(p0 + 1);
        if (EN(1) && IN(p0 + 2)) { MKWG(); Prep P{PROJ, PROJ, QDR, QDR, KVR, KD, args.in[4] + l * HD, args.in[5] + l * HD, args.in[6] + l * HD, args.in[7] + l * HD, args.in[12] + l * QKD, args.in[13] + l * QKD, args.in[3] + l * GH,
                                                 LF, KMS, cosC, sinC, cosR, sinR, ctl + CW_KMAX + 256 * l};
            prep_phase(g, P);
#if PROBE_DUP == 24
            xcd_barrier(bar); P.OUT = ACT; P.QOUT = ACT + (size_t)M * INP; P.KD = P.QOUT + (size_t)M * 768; P.LF = (float*)(P.KD + (size_t)M * 768); P.KMS = P.LF + (size_t)M * 4; P.KMAX = (unsigned*)(P.KMS + 262144); prep_phase(g, P);
#endif
        }
        SEAM(p0 + 2);
        if (EN(4) && IN(p0 + 3)) { MKWG(); att::PhaseArgs A{PROJ, QDR, KVR, KD, OB, LF, KMS, ctl + CW_QUEUE + 256 * l, ctl + CW_KMAX + 256 * l, SSG + (size_t)l * M * 4, -1};
            att::attn_phase(A, g.lds, ldsb);
            if (l + 1 < DEPTH) { MKWG(); volatile LAS unsigned* mq = (volatile LAS unsigned*)(g.lds + MISC_OFF + 64);
                for (;;) { __syncthreads(); if (g.tid == 0) mq[0] = __hip_atomic_fetch_add(ctl + CW_QUEUE + 256 * l + 192, 1u, __ATOMIC_RELAXED, __HIP_MEMORY_SCOPE_AGENT);
                    __syncthreads(); const int base = CONV_SPLIT + 8 * (int)mq[0]; if (base >= CONV_ITEMS) break;
                    if (base + g.wave < CONV_ITEMS) convert_item(g, args.in, ws, l + 1, base + g.wave); } }
#if PROBE_DUP == 2
            __syncthreads(); A.queue = ctl + CW_QUEUE + 256 * (l + 8); att::attn_phase(A, g.lds, ldsb);
#endif
#if PROBE_DUP >= 30 && PROBE_DUP <= 33
            __syncthreads(); A.queue = ctl + CW_QUEUE + 256 * (l + 8); A.SSG = (unsigned long long*)ACT; A.only = PROBE_DUP - 30; att::attn_phase(A, g.lds, ldsb);
#endif
#if PROBE_DUP == 21
            xcd_barrier(bar); A.queue = ctl + CW_QUEUE + 256 * (l + 8); A.SSG = (unsigned long long*)ACT; att::attn_phase(A, g.lds, ldsb);
#endif
        }
        SEAM(p0 + 3);
        if (EN(6) && IN(p0 + 4)) { MKWG(); pg8::Gemm gm{OB, (const bf16*)(wl + W_OUT), M, DM, MIXW, MIXW, SSG + (size_t)l * M * 4}; pg8::StaticOrder S; S.init(M, DM, g.G, (int)blockIdx.x);
            pg8::EpiStream<FFN_FP8> E{XS, nullptr, X8, SS2, DM, 1.f};
            pg8::gemm_phase<pg8::EpiStream<FFN_FP8>, pg8::StaticOrder, true, true, false, true>(g.lds, gm, S, E);
#if PROBE_DUP == 5
            { pg8::EpiStream<FFN_FP8> E2{XS, nullptr, X8, nullptr, DM, 0.f}; pg8::gemm_phase<pg8::EpiStream<FFN_FP8>, pg8::StaticOrder, true, true>(g.lds, gm, S, E2); }
#endif
        }
        SEAM(p0 + 4);
        if (EN(8) && IN(p0 + 5)) { MKWG(); constexpr int KD_ = FFN_FP8 ? 2 : 1;
            pg8::Gemm gm{X8, (const bf16*)(wl + W_UP), M, DFF2, DM / KD_, DM / KD_, nullptr}; pg8::StaticOrder S; S.init(M, DFF2, g.G, (int)blockIdx.x);
            pg8::EpiBf16 E{UB, DFF2, 1.f / WUP_SCALE, SS2, 1.f / DM, nullptr, nullptr, 0, 0, 0, U_FP8 ? 1 : 0};
            pg8::gemm_phase<pg8::EpiBf16, pg8::StaticOrder, true, true, FFN_FP8>(g.lds, gm, S, E);
#if PROBE_DUP == 1
            pg8::gemm_phase<pg8::EpiBf16, pg8::StaticOrder, true, true, FFN_FP8>(g.lds, gm, S, E);
#endif
#if PROBE_DUP == 23
            xcd_barrier(bar); pg8::gemm_phase<pg8::EpiBf16, pg8::StaticOrder, true, true, FFN_FP8>(g.lds, gm, S, E);
#endif
        }
        SEAM(p0 + 5);
        if (EN(9) && IN(p0 + 6)) { MKWG(); convgate_phase(g, UB, args.in[18] + (size_t)l * 3 * DFF2, args.in[19] + (size_t)l * DFF2, ACT);
#if PROBE_DUP == 3
            convgate_phase(g, UB, args.in[18] + (size_t)l * 3 * DFF2, args.in[19] + (size_t)l * DFF2, ACT);
#endif
#if PROBE_DUP == 12
            xcd_barrier(bar); convgate_phase(g, UB, args.in[18] + (size_t)l * 3 * DFF2, args.in[19] + (size_t)l * DFF2, ACT);
#endif
        }
        SEAM(p0 + 6);
        if (EN(10) && IN(p0 + 7)) { MKWG(); constexpr int KD_ = FFN_FP8 ? 2 : 1; const bool last = (l + 1 == DEPTH);
            pg8::Gemm gm{ACT, (const bf16*)(wl + W_DOWN), M, DM, DFF / KD_, DFF / KD_, nullptr}; pg8::StaticOrder S; S.init(M, DM, g.G, (int)blockIdx.x);
            pg8::EpiStream<false> E{XS, last ? args.out : nullptr, nullptr, last ? nullptr : SS1 + 2 * M, DM, 1.f / WDOWN_SCALE};
            pg8::gemm_phase<pg8::EpiStream<false>, pg8::StaticOrder, true, true, FFN_FP8>(g.lds, gm, S, E);
#if PROBE_DUP == 6
            if (!last) { pg8::EpiStream<false> E2{XS, nullptr, nullptr, nullptr, DM, 0.f}; pg8::gemm_phase<pg8::EpiStream<false>, pg8::StaticOrder, true, true, FFN_FP8>(g.lds, gm, S, E2); }
#endif
        }
        if (l + 1 < DEPTH) SEAM(p0 + 7);
    }
#undef IN
#undef SEAM
#undef MKWG
}

extern "C" void kernel_launch(void* const* d_in, const int* in_sizes, int n_in, void* d_out, int out_size, void* d_ws, size_t ws_size, hipStream_t stream) {
    static int grid = 0;
    if (grid == 0) {
        if (n_in != 21 || in_sizes[0] != M * DM || out_size != M * DM || ws_size < WS_END) {
            fprintf(stderr, "kernel_launch: built for 21 inputs, x and out of %d floats, >= %zu bytes of workspace; got n_in %d, in0 %d, out %d, ws %zu; nothing launched\n", M * DM, (size_t)WS_END, n_in, n_in > 0 ? in_sizes[0] : -1, out_size, ws_size);
            grid = -1; return; }
        int dev = 0, cus = 0, per_cu = 0;
        if (hipGetDevice(&dev) != hipSuccess || hipDeviceGetAttribute(&cus, hipDeviceAttributeMultiprocessorCount, dev) != hipSuccess) { fprintf(stderr, "kernel_launch: device query failed\n"); grid = -1; return; }
        if (hipFuncSetAttribute((const void*)hybrid_fwd, hipFuncAttributeMaxDynamicSharedMemorySize, LDS_BYTES) != hipSuccess) { fprintf(stderr, "kernel_launch: hipFuncSetAttribute(%d B LDS) failed\n", LDS_BYTES); grid = -1; return; }
        if (hipOccupancyMaxActiveBlocksPerMultiprocessor(&per_cu, (const void*)hybrid_fwd, NWAVES * 64, LDS_BYTES) != hipSuccess || per_cu < 1)
            fprintf(stderr, "kernel_launch: note: occupancy query reports %d workgroups per CU\n", per_cu);
        (void)hipGetLastError();
        grid = cus;
    }
    if (grid < 0) return;
    if (hipMemsetAsync((char*)d_ws + WS_CTL, 0, CTL_ZERO_BYTES, stream) != hipSuccess) { fprintf(stderr, "kernel_launch: memset failed\n"); return; }
    Args a{};
    for (int i = 0; i < 21; ++i) a.in[i] = (const float*)d_in[i];
    a.out = (float*)d_out; a.ws = (unsigned char*)d_ws;
#if MK_SPLIT
    for (int p = 0; p < N_PHASES; ++p) { a.ph_lo = p; a.ph_hi = p + 1; hipLaunchKernelGGL(hybrid_fwd, dim3(grid), dim3(NWAVES * 64), LDS_BYTES, stream, a); }
#else
    a.ph_lo = 0; a.ph_hi = N_PHASES;
    hipLaunchKernelGGL(hybrid_fwd, dim3(grid), dim3(NWAVES * 64), LDS_BYTES, stream, a);
#endif
    const hipError_t le = hipPeekAtLastError();
    if (le != hipSuccess) fprintf(stderr, "kernel_launch: launch failed: %s\n", hipGetErrorName(le));
}
```

```cpp
#include <hip/hip_runtime.h>
#include <cstdio>
#include <cstdint>

#define GAS __attribute__((address_space(1)))
#define LAS __attribute__((address_space(3)))
typedef unsigned short bf16;
typedef short bf16x8 __attribute__((ext_vector_type(8)));
typedef short s16x4 __attribute__((ext_vector_type(4)));
typedef float f32x2 __attribute__((ext_vector_type(2)));
typedef float f32x4 __attribute__((ext_vector_type(4)));
typedef float f32x16 __attribute__((ext_vector_type(16)));
typedef unsigned u32x2 __attribute__((ext_vector_type(2)));
typedef unsigned u32x4 __attribute__((ext_vector_type(4)));

constexpr int BATCH = 4, SEQ = 4096, DM = 2048, DEPTH = 4;
constexpr int M = BATCH * SEQ;
constexpr int HD = 128, GH = 4, GW = 512, MIXW = 2048;
constexpr int INW = 5444, INP = 5632;
constexpr int DFF = 5632, DFF2 = 11264;
constexpr int QRANK = 512, KVRANK = 256, QKD = 192;
constexpr float EPS = 1e-6f;
#ifndef FFN_FP8_ON
#define FFN_FP8_ON 1
#endif
constexpr bool FFN_FP8 = FFN_FP8_ON;
constexpr float WUP_SCALE = FFN_FP8 ? 64.f : 1.f, WDOWN_SCALE = FFN_FP8 ? 256.f : 1.f;
#ifndef U_FP8_ON
#define U_FP8_ON 1
#endif
constexpr bool U_FP8 = U_FP8_ON;
constexpr int C_AQ = 0, C_AK = 512, C_CQ = 1024, C_CK = 1536, C_CV = 2048, C_DCQ = 2560, C_DCKV = 3072, C_DKR = 3328, C_AF = 3392, C_AV = 3584, C_BQ = 4096, C_BK = 4608, C_BV = 5120;
constexpr int INP_A = 3584, INP_B = INP - INP_A;
constexpr float WINB_SCALE = 64.f;
__host__ __device__ __forceinline__ int inproj_src_col(int n) {
    if (n < 1024) return n;
    if (n < 2560) return 3076 + (n - 1024);
    if (n < 3392) return 4612 + (n - 2560);
    if (n < 3396) return 1536 + (n - 3392);
    if (n < 3584) return -1;
    if (n < 4096) return 1024 + (n - 3584);
    return 1540 + (n - 4096);
}

constexpr size_t MiB = 1u << 20;
constexpr size_t WS_CTL = 0, CTL_ZERO_BYTES = 5 * MiB;
constexpr size_t WS_SS = 1 * MiB;
constexpr size_t WS_SSG = 2 * MiB;
constexpr size_t WS_SSD = 4 * MiB;
constexpr size_t WS_COSC = 5 * MiB, WS_SINC = 6 * MiB;
constexpr size_t WS_COSR = 7 * MiB, WS_SINR = 7 * MiB + 512 * 1024;
constexpr size_t WS_LF = 8 * MiB;
constexpr size_t WS_CF = WS_LF + 256 * 1024;
constexpr size_t WS_KMS = WS_CF + 256 * 1024;
constexpr size_t WS_SEL = WS_KMS + 512 * 1024;
constexpr size_t WS_W = 10 * MiB;
constexpr size_t W_IN = 0, W_UQ = W_IN + (size_t)INP * DM * 2, W_UKV = W_UQ + (size_t)768 * 512 * 2, W_OUT = W_UKV + (size_t)1024 * 256 * 2,
                 W_UP = W_OUT + (size_t)DM * MIXW * 2, W_DOWN = W_UP + (size_t)DFF2 * DM * 2, W_LAYER = W_DOWN + (size_t)DM * DFF * 2;
static_assert(W_LAYER == (size_t)(22 * 1024 + 768 + 512 + 8 * 1024 + 44 * 1024 + 22 * 1024) * 1024, "weights per layer");
constexpr size_t WS_XS = 400 * MiB;
constexpr size_t WS_U = 464 * MiB;
constexpr size_t WS_PROJ = WS_U;
constexpr size_t WS_QDR = WS_PROJ + (size_t)M * INP * 2;
constexpr size_t WS_KVR = WS_QDR + (size_t)M * 768 * 2;
constexpr size_t WS_KD = WS_KVR + (size_t)M * 1024 * 2;
constexpr size_t WS_O = WS_KD + (size_t)M * 768 * 2;
constexpr size_t WS_ACT = WS_U + (size_t)M * DFF2 * 2;
constexpr size_t WS_X8 = WS_ACT + (size_t)M * DFF * 2;
constexpr size_t WS_X8B = WS_X8 + (size_t)M * DM;
constexpr size_t W_INB = W_IN + (size_t)INP_A * DM * 2;
constexpr size_t WS_END = WS_X8 + (size_t)M * DM * 2;
static_assert(WS_W + DEPTH * W_LAYER <= WS_XS && WS_O + (size_t)M * MIXW * 2 <= WS_ACT && WS_XS + (size_t)M * DM * 2 <= WS_U && WS_SEL + 256 * 1024 <= WS_W && WS_SS + (size_t)DEPTH * 2 * M * 8 <= WS_SSG && WS_SSG + (size_t)DEPTH * M * 4 * 8 <= WS_SSD && WS_SSD + (size_t)DEPTH * 2 * M * 8 <= CTL_ZERO_BYTES, "d_ws map");
constexpr int CW_BAR = 4096;
constexpr int CW_KMAX = 32768;
constexpr int CW_QUEUE = 16384;

constexpr int RING_BYTES = 131072;
constexpr int MISC_OFF = RING_BYTES + 320;
constexpr int LDS_BYTES = 147456;
constexpr int NWAVES = 8;

#define LDS_WAIT() asm volatile("s_waitcnt lgkmcnt(0)" ::: "memory")
#define VM_WAIT() asm volatile("s_waitcnt vmcnt(0)" ::: "memory")
#define SBAR() __builtin_amdgcn_sched_barrier(0)

__device__ __forceinline__ float bf2f(unsigned b) { return __uint_as_float(b << 16); }
__device__ __forceinline__ unsigned cvt_pk_bf16(float lo, float hi) { unsigned r; asm volatile("v_cvt_pk_bf16_f32 %0, %1, %2" : "=v"(r) : "v"(lo), "v"(hi)); return r; }
__device__ __forceinline__ void unpack8(u32x4 w, float (&v)[8]) {
#pragma unroll
    for (int i = 0; i < 4; ++i) { v[2 * i] = __uint_as_float(w[i] << 16); v[2 * i + 1] = __uint_as_float(w[i] & 0xffff0000u); }
}
__device__ __forceinline__ u32x4 pack8(const float (&v)[8]) { u32x4 w; w.x = cvt_pk_bf16(v[0], v[1]); w.y = cvt_pk_bf16(v[2], v[3]); w.z = cvt_pk_bf16(v[4], v[5]); w.w = cvt_pk_bf16(v[6], v[7]); return w; }
__device__ __forceinline__ float wave_sum(float v) {
#pragma unroll
    for (int o = 1; o < 64; o <<= 1) v += __shfl_xor(v, o);
    return v;
}
template <int CTRL> __device__ __forceinline__ float dppf(float v) { return __uint_as_float((unsigned)__builtin_amdgcn_update_dpp(0, (int)__float_as_uint(v), CTRL, 0xf, 0xf, true)); }
__device__ __forceinline__ float sum16(float v) {
    v += dppf<0xB1>(v); v += dppf<0x4E>(v); v += dppf<0x141>(v); v += dppf<0x140>(v);
    return v;
}
__device__ __forceinline__ void unpack8_fp8(u32x2 w, float (&v)[8]) {
    const f32x2 a = __builtin_amdgcn_cvt_pk_f32_fp8((int)w.x, false), b = __builtin_amdgcn_cvt_pk_f32_fp8((int)w.x, true), c = __builtin_amdgcn_cvt_pk_f32_fp8((int)w.y, false), d = __builtin_amdgcn_cvt_pk_f32_fp8((int)w.y, true);
    v[0] = a[0]; v[1] = a[1]; v[2] = b[0]; v[3] = b[1]; v[4] = c[0]; v[5] = c[1]; v[6] = d[0]; v[7] = d[1];
}
__device__ __forceinline__ float clamp448(float x) { return __builtin_amdgcn_fmed3f(x, -448.f, 448.f); }
__device__ __forceinline__ unsigned pack4_fp8(float a, float b, float c, float d) {
    unsigned w = 0; w = __builtin_amdgcn_cvt_pk_fp8_f32(clamp448(a), clamp448(b), w, false); w = __builtin_amdgcn_cvt_pk_fp8_f32(clamp448(c), clamp448(d), w, true); return w; }
__constant__ float INVF128[64] = {1.f, 0.865964353f, 0.749894261f, 0.649381638f, 0.562341332f, 0.486967534f, 0.421696514f, 0.365174115f, 0.316227764f, 0.273841977f, 0.237137377f, 0.2053525f, 0.177827939f, 0.153992653f, 0.133352131f, 0.115478203f, 0.100000001f, 0.0865964293f, 0.0749894157f, 0.0649381652f, 0.0562341325f, 0.0486967526f, 0.0421696529f, 0.0365174115f, 0.0316227749f, 0.0273841973f, 0.0237137377f, 0.0205352511f, 0.0177827943f, 0.0153992651f, 0.0133352149f, 0.0115478206f, 0.00999999978f, 0.00865964312f, 0.00749894185f, 0.00649381615f, 0.00562341325f, 0.00486967526f, 0.00421696482f, 0.00365174119f, 0.00316227763f, 0.00273841969f, 0.00237137359f, 0.00205352483f, 0.00177827943f, 0.00153992651f, 0.00133352145f, 0.0011547819f, 0.00100000005f, 0.000865964335f, 0.000749894243f, 0.000649381662f, 0.000562341302f, 0.000486967532f, 0.000421696517f, 0.000365174143f, 0.000316227757f, 0.000273841957f, 0.00023713737f, 0.00020535251f, 0.00017782794f, 0.000153992645f, 0.00013335215f, 0.0001154782f};

namespace pg8 {
#define PG8_LAS __attribute__((address_space(3)))
typedef unsigned short bf16_t;
typedef short bf16x8 __attribute__((ext_vector_type(8)));
typedef float f32x4 __attribute__((ext_vector_type(4)));
typedef unsigned u32x4 __attribute__((ext_vector_type(4)));
typedef int v8i __attribute__((ext_vector_type(8)));
typedef unsigned u32x8 __attribute__((ext_vector_type(8)));
constexpr int BM = 256, BK = 64, HALF = 128, HTB = HALF * BK * 2  , STAGE_BYTES = 8 * HTB, NXCD = 8, WGM = 4;

__host__ __device__ __forceinline__ int lds_byte(int r, int c) { const int st = (r >> 4) * 2 + (c >> 5), rr = r & 15, cc = c & 31, ob = rr * 64 + cc * 2; return st * 1024 + (ob ^ (((ob >> 9) & 1) << 5)); }
__host__ __device__ __forceinline__ void stage_rc(int b, int& R, int& C) { const int st = b / 1024, sb = b % 1024, swz = sb ^ (((sb >> 9) & 1) << 5); R = (st >> 1) * 16 + swz / 64; C = (st & 1) * 32 + (swz % 64) / 2; }
__host__ __device__ __forceinline__ int perm32(int rho) { const int n = rho >> 4, i = rho & 15; return 8 * (i >> 2) + 4 * n + (i & 3); }

struct Unit { int pm, pn; };
struct Gemm { const bf16_t* A; const bf16_t* Bt; int M, N, K, lda; const unsigned long long* ssg; };

struct StaticOrder {
    int nM, nN, nwg, G, c;
    __host__ __device__ void init(int M, int N, int G_, int c_) { nM = M / BM; nN = N / BM; nwg = nM * nN; G = G_; c = c_; }
    __host__ __device__ bool next(int i, Unit& u) const {
        const long L = (long)i * G + c; if (L >= nwg) return false;
        int wgid = (int)L; { const int q = nwg / NXCD, r = nwg % NXCD, xcd = wgid % NXCD, off = wgid / NXCD; wgid = (xcd < r ? xcd * (q + 1) : r * (q + 1) + (xcd - r) * q) + off; }
        const int nig = WGM * nN, gid = wgid / nig, fm = gid * WGM, gsz = (nM - fm) < WGM ? (nM - fm) : WGM;
        u.pm = fm + ((wgid % nig) % gsz); u.pn = (wgid % nig) / gsz; return true;
    }
    __device__ __forceinline__ void a_ready(const Unit&) const {}
    __device__ __forceinline__ void done(const Unit&) const {}
};

struct SkewOrder {
    StaticOrder b;
    __host__ __device__ void init(int M, int N, int G_, int c_) { b.init(M, N, G_, 0); b.G = G_; b.c = c_; }
    __host__ __device__ bool next(int i, Unit& u) const {
        const int h = b.G / 2; StaticOrder t = b;
        if (b.c >= h) { if (i >= 3) return false; t.c = (b.c - h) + h * i; } else { if (i >= 1) return false; t.c = 3 * h + b.c; }
        return t.next(0, u);
    }
    __device__ __forceinline__ void a_ready(const Unit&) const {}
    __device__ __forceinline__ void done(const Unit&) const {}
};

__device__ __forceinline__ unsigned cvt_pk_bf16(float lo, float hi) { unsigned r; asm volatile("v_cvt_pk_bf16_f32 %0, %1, %2" : "=v"(r) : "v"(lo), "v"(hi)); return r; }
struct EpiBf16 {
    static constexpr bool PERM = true, AFTER_DRAIN = false;
    bf16_t* O; int ldc; float sc; const unsigned long long* ss; float inv_n;
    unsigned long long* st_a; unsigned long long* st_b; int pn_a0, pn_a1, pn_b; int out8;
    static constexpr bool PREFETCH_SS = true;
    __device__ __forceinline__ void operator()(const f32x4 (&acc)[2][2][4][2], const Unit& u, int wr, int wc, int fr, int fq, const unsigned long long (&pre)[8]) const {
        const int row0 = u.pm * BM + wr * 64 + fr, col0 = u.pn * BM + wc * 64 + 16 * fq;
        unsigned long long* st = nullptr; if (st_a) { if (u.pn >= pn_a0 && u.pn <= pn_a1) st = st_a; else if (u.pn == pn_b) st = st_b; }
#pragma unroll
        for (int ai = 0; ai < 2; ++ai)
#pragma unroll
            for (int m = 0; m < 4; ++m) { const int row = row0 + ai * HALF + m * 16; bf16_t* rowp = O + (size_t)row * ldc + col0; float ssq = 0.f;
                const float s = ss ? sc * rsqrtf((float)pre[ai * 4 + m] * (inv_n * (1.f / 16777216.f)) + 1e-6f) : sc;
                u32x4 w16;
#pragma unroll
                for (int bj = 0; bj < 2; ++bj) { const f32x4 v0 = acc[ai][bj][m][0] * s, v1 = acc[ai][bj][m][1] * s;
                    if (st) ssq += (v0[0] * v0[0] + v0[1] * v0[1]) + (v0[2] * v0[2] + v0[3] * v0[3]) + (v1[0] * v1[0] + v1[1] * v1[1]) + (v1[2] * v1[2] + v1[3] * v1[3]);
                    if (out8) { const unsigned lo = pack4_fp8(v0[0], v0[1], v0[2], v0[3]), hi = pack4_fp8(v1[0], v1[1], v1[2], v1[3]); if (bj == 0) { w16.x = lo; w16.y = hi; } else { w16.z = lo; w16.w = hi; } }
                    else { u32x4 w; w.x = cvt_pk_bf16(v0[0], v0[1]); w.y = cvt_pk_bf16(v0[2], v0[3]); w.z = cvt_pk_bf16(v1[0], v1[1]); w.w = cvt_pk_bf16(v1[2], v1[3]);
                    *(u32x4*)(rowp + bj * 8) = w; } }
                if (out8) *(u32x4*)((unsigned char*)O + (size_t)row * ldc + col0) = w16;
                if (st) { ssq += __shfl_xor(ssq, 16); ssq += __shfl_xor(ssq, 32); if (fq == 0) __hip_atomic_fetch_add(st + row, (unsigned long long)(ssq * 16777216.f), __ATOMIC_RELAXED, __HIP_MEMORY_SCOPE_AGENT); } }
    }
};
template <bool COPY_FP8>
struct EpiStream {
    static constexpr bool PERM = true, AFTER_DRAIN = false, PREFETCH_SS = false;
    bf16_t* XS; float* OUT32; void* X8; unsigned long long* ss; int ldc; float sc;
    __device__ __forceinline__ void operator()(const f32x4 (&acc)[2][2][4][2], const Unit& u, int wr, int wc, int fr, int fq, const unsigned long long (&)[8]) const {
        const int row0 = u.pm * BM + wr * 64 + fr, col0 = u.pn * BM + wc * 64 + 16 * fq;
#pragma unroll
        for (int ai = 0; ai < 2; ++ai) {
            u32x4 xall[4][2];
#pragma unroll
            for (int m = 0; m < 4; ++m)
#pragma unroll
                for (int bj = 0; bj < 2; ++bj) xall[m][bj] = *(const u32x4*)(XS + (size_t)(row0 + ai * HALF + m * 16) * ldc + col0 + bj * 8);
#pragma unroll
            for (int m = 0; m < 4; ++m) { const int row = row0 + ai * HALF + m * 16; const size_t ro = (size_t)row * ldc + col0; float ssq = 0.f; u32x4 w16;
#pragma unroll
                for (int bj = 0; bj < 2; ++bj) { const u32x4 xw = xall[m][bj];
                    f32x4 v0 = acc[ai][bj][m][0] * sc, v1 = acc[ai][bj][m][1] * sc;
                    v0[0] += __uint_as_float(xw[0] << 16); v0[1] += __uint_as_float(xw[0] & 0xffff0000u); v0[2] += __uint_as_float(xw[1] << 16); v0[3] += __uint_as_float(xw[1] & 0xffff0000u);
                    v1[0] += __uint_as_float(xw[2] << 16); v1[1] += __uint_as_float(xw[2] & 0xffff0000u); v1[2] += __uint_as_float(xw[3] << 16); v1[3] += __uint_as_float(xw[3] & 0xffff0000u);
                    ssq += (v0[0] * v0[0] + v0[1] * v0[1]) + (v0[2] * v0[2] + v0[3] * v0[3]) + (v1[0] * v1[0] + v1[1] * v1[1]) + (v1[2] * v1[2] + v1[3] * v1[3]);
                    if (OUT32) { *(f32x4*)(OUT32 + ro + bj * 8) = v0; *(f32x4*)(OUT32 + ro + bj * 8 + 4) = v1; }
                    else { u32x4 w; w.x = cvt_pk_bf16(v0[0], v0[1]); w.y = cvt_pk_bf16(v0[2], v0[3]); w.z = cvt_pk_bf16(v1[0], v1[1]); w.w = cvt_pk_bf16(v1[2], v1[3]); *(u32x4*)(XS + ro + bj * 8) = w; }
                    if (X8) { if constexpr (COPY_FP8) { const unsigned lo = pack4_fp8(v0[0], v0[1], v0[2], v0[3]), hi = pack4_fp8(v1[0], v1[1], v1[2], v1[3]); if (bj == 0) { w16.x = lo; w16.y = hi; } else { w16.z = lo; w16.w = hi; } }
                              else { u32x4 w; w.x = cvt_pk_bf16(v0[0], v0[1]); w.y = cvt_pk_bf16(v0[2], v0[3]); w.z = cvt_pk_bf16(v1[0], v1[1]); w.w = cvt_pk_bf16(v1[2], v1[3]); *(u32x4*)((bf16_t*)X8 + ro + bj * 8) = w; } } }
                if constexpr (COPY_FP8) { if (X8) *(u32x4*)((unsigned char*)X8 + ro) = w16; }
                if (ss) { ssq += __shfl_xor(ssq, 16); ssq += __shfl_xor(ssq, 32); if (fq == 0) __hip_atomic_fetch_add(ss + row, (unsigned long long)(ssq * 16777216.f), __ATOMIC_RELAXED, __HIP_MEMORY_SCOPE_AGENT); } } }
    }
};

template <class Epi, class Sched, bool ALIGN_EPI = false, bool SP2 = false, bool FP8 = false, bool GS = false>
__device__ __forceinline__ void gemm_phase(PG8_LAS unsigned char* lds, const Gemm g, const Sched& S, const Epi& E) {
    int tid_ = threadIdx.x; asm volatile("" : "+v"(tid_));
    const int tid = tid_, wid = __builtin_amdgcn_readfirstlane(tid >> 6), lane = tid & 63, wr = wid >> 2, wc = wid & 3, fr = lane & 15, fq = lane >> 4;
    const int K = g.K, nt = K / BK;
    unsigned voffA[2], voffB[2];
#pragma unroll
    for (int i = 0; i < 2; ++i) { int R, C; stage_rc(tid * 16 + i * 8192, R, C); const int Rb = Epi::PERM ? ((R & ~31) + perm32(R & 31)) : R;
        voffA[i] = (unsigned)(R * g.lda + C) * 2u; const int Rg = Epi::PERM ? (((Rb >> 3) << 4) + (Rb & 7)) : Rb;
        voffB[i] = (unsigned)(Rg * K + C) * 2u; }
    const size_t kstep = (size_t)(BK * 2);
    const size_t hstepA = (size_t)HALF * g.lda * 2, hstepB = (size_t)(Epi::PERM ? 8 : HALF) * K * 2;
    const size_t tstepA = 2 * hstepA, tstepB = (size_t)2 * HALF * K * 2;
    const unsigned ldsw = (unsigned)wid * 1024u;
    const int aoff = lds_byte(wr * 64 + fr, fq * 8), boff = lds_byte(wc * 32 + fr, fq * 8);
#define PG8_SA(b, h) (((b) * 2 + (h)) * HTB)
#define PG8_SB(b, h) ((4 + (b) * 2 + (h)) * HTB)
#define PG8_STAGE(bufoff, gbase, voff) do { _Pragma("unroll") for (int _i = 0; _i < 2; ++_i) \
        __builtin_amdgcn_global_load_lds((const unsigned*)((const char*)(gbase) + (voff)[_i]), (PG8_LAS unsigned*)(lds + (bufoff) + ldsw + _i * 8192), 16, 0, 0); } while (0)
#define PG8_LD2(dst, addr) do { const u32x4 lo_ = *(const PG8_LAS u32x4*)(addr), hi_ = *(const PG8_LAS u32x4*)((addr) + 1024); dst = __builtin_shufflevector(lo_, hi_, 0, 1, 2, 3, 4, 5, 6, 7); } while (0)
#define PG8_LDA(dst, b, h) do { _Pragma("unroll") for (int m = 0; m < 4; ++m) PG8_LD2(dst[m], lds + PG8_SA(b, h) + aoff + m * 2048); } while (0)
#define PG8_LDB(dst, b, h) do { _Pragma("unroll") for (int n = 0; n < 2; ++n) PG8_LD2(dst[n], lds + PG8_SB(b, h) + boff + n * 2048); } while (0)
#define PG8_HALF(X, k) __builtin_bit_cast(bf16x8, __builtin_shufflevector(X, X, 4 * (k), 4 * (k) + 1, 4 * (k) + 2, 4 * (k) + 3))
#define PG8_MMA(ai, bj, At, Bt) do { __builtin_amdgcn_s_setprio(1); \
        if constexpr (FP8) { _Pragma("unroll") for (int m = 0; m < 4; ++m) _Pragma("unroll") for (int n = 0; n < 2; ++n) \
            asm volatile("v_mfma_scale_f32_16x16x128_f8f6f4 %0, %1, %2, %0, %3, %3 op_sel_hi:[0,0,0]" : "+v"(acc[ai][bj][m][n]) : "v"(Bt[n]), "v"(At[m]), "v"(one_scale)); } \
        else { _Pragma("unroll") for (int m = 0; m < 4; ++m) _Pragma("unroll") for (int n = 0; n < 2; ++n) { \
            acc[ai][bj][m][n] = __builtin_amdgcn_mfma_f32_16x16x32_bf16(PG8_HALF(Bt[n], 0), PG8_HALF(At[m], 0), acc[ai][bj][m][n], 0, 0, 0); \
            acc[ai][bj][m][n] = __builtin_amdgcn_mfma_f32_16x16x32_bf16(PG8_HALF(Bt[n], 1), PG8_HALF(At[m], 1), acc[ai][bj][m][n], 0, 0, 0); } } \
        __builtin_amdgcn_s_setprio(0); } while (0)
#define PG8_WAIT_V(n) asm volatile("s_waitcnt vmcnt(" #n ")" ::: "memory")
#define PG8_WAIT_L(n) asm volatile("s_waitcnt lgkmcnt(" #n ")" ::: "memory")
#define PG8_BAR __builtin_amdgcn_s_barrier()
#define PG8_SCHED __builtin_amdgcn_sched_barrier(0)
    Unit cur, nxt; int ui = 0;
    if (!S.next(0, cur)) return;
    PG8_LAS unsigned char* const gs_lds = lds + STAGE_BYTES + 1024;
#define PG8_GS_TABLE(u_, buf_) do { if constexpr (GS) { if (tid < 256) { const unsigned long long* sp_ = g.ssg + ((size_t)(u_).pm * BM + tid) * 4; float r_[4]; \
        _Pragma("unroll") for (int q_ = 0; q_ < 4; ++q_) r_[q_] = rsqrtf((float)__hip_atomic_load(sp_ + q_, __ATOMIC_RELAXED, __HIP_MEMORY_SCOPE_AGENT) * (1.f / 16777216.f / 512.f) + 1e-6f); \
        *(PG8_LAS f32x4*)(gs_lds + (buf_) * 4096 + tid * 16) = (f32x4){r_[0] / r_[1], r_[1] / r_[2], r_[2] / r_[3], r_[3]}; } } } while (0)
#define PG8_GS_SCALE(buf_, col_) do { _Pragma("unroll") for (int ai_ = 0; ai_ < 2; ++ai_) _Pragma("unroll") for (int m_ = 0; m_ < 4; ++m_) { \
        const float f_ = *(const PG8_LAS float*)(gs_lds + (buf_) * 4096 + (wr * 64 + fr + ai_ * HALF + m_ * 16) * 16 + (col_) * 4); \
        _Pragma("unroll") for (int bj_ = 0; bj_ < 2; ++bj_) _Pragma("unroll") for (int n_ = 0; n_ < 2; ++n_) acc[ai_][bj_][m_][n_] = acc[ai_][bj_][m_][n_] * f_; } } while (0)
    f32x4 acc[2][2][4][2];
#pragma unroll
    for (int a = 0; a < 2; ++a)
#pragma unroll
        for (int b = 0; b < 2; ++b)
#pragma unroll
            for (int m = 0; m < 4; ++m)
#pragma unroll
                for (int n = 0; n < 2; ++n) acc[a][b][m][n] = (f32x4){0.f, 0.f, 0.f, 0.f};
    unsigned one_scale = 0x7f7f7f7fu; asm volatile("" : "+v"(one_scale));
    unsigned long long pre[8] = {0, 0, 0, 0, 0, 0, 0, 0};
    u32x8 At[4], B0[2], B1[2];
    const char* cA = (const char*)g.A + (size_t)cur.pm * tstepA; const char* cB = (const char*)g.Bt + (size_t)cur.pn * tstepB;
    S.a_ready(cur); PG8_GS_TABLE(cur, 0);
    if constexpr (SP2) {
        PG8_STAGE(PG8_SB(0, 0), cB, voffB); PG8_STAGE(PG8_SB(0, 1), cB + hstepB, voffB); PG8_STAGE(PG8_SA(0, 0), cA, voffA); PG8_STAGE(PG8_SA(0, 1), cA + hstepA, voffA);
        if (wr == 1) PG8_BAR;
        PG8_WAIT_V(2); PG8_BAR;
        PG8_STAGE(PG8_SB(1, 0), cB + kstep, voffB); PG8_STAGE(PG8_SA(1, 0), cA + kstep, voffA); PG8_STAGE(PG8_SB(1, 1), cB + hstepB + kstep, voffB);
        PG8_WAIT_V(6); PG8_BAR;
    } else {
        PG8_STAGE(PG8_SB(0, 0), cB, voffB); PG8_STAGE(PG8_SA(0, 0), cA, voffA); PG8_STAGE(PG8_SB(0, 1), cB + hstepB, voffB); PG8_STAGE(PG8_SA(0, 1), cA + hstepA, voffA);
        if (wr == 1) PG8_BAR;
        PG8_WAIT_V(4); PG8_BAR;
        PG8_STAGE(PG8_SB(1, 0), cB + kstep, voffB); PG8_STAGE(PG8_SA(1, 0), cA + kstep, voffA); PG8_STAGE(PG8_SB(1, 1), cB + hstepB + kstep, voffB);
        PG8_WAIT_V(6); PG8_BAR;
    }
    for (;;) {
        const bool has_next = S.next(ui + 1, nxt);
        const char* nA = has_next ? (const char*)g.A + (size_t)nxt.pm * tstepA : cA; const char* nB = has_next ? (const char*)g.Bt + (size_t)nxt.pn * tstepB : cB;
        for (int t = 0; t < nt; t += 2) {
            const bool last = (t == nt - 2);
            const char* a1 = cA + (size_t)(t + 1) * kstep;
            const char* a2 = last ? nA : cA + (size_t)(t + 2) * kstep; const char* b2 = last ? nB : cB + (size_t)(t + 2) * kstep;
            const char* a3 = a2 + kstep; const char* b3 = b2 + kstep;
            if (last && has_next) { S.a_ready(nxt); PG8_GS_TABLE(nxt, (ui + 1) & 1); }
            if constexpr (Epi::PREFETCH_SS) { if (last && E.ss) {
#pragma unroll
                for (int q_ = 0; q_ < 8; ++q_) pre[q_] = __hip_atomic_load(E.ss + cur.pm * BM + wr * 64 + fr + (q_ >> 2) * HALF + (q_ & 3) * 16, __ATOMIC_RELAXED, __HIP_MEMORY_SCOPE_AGENT); } }
            if constexpr (GS) { if (t == 8 || t == 16 || t == 24) PG8_GS_SCALE(ui & 1, (t >> 3) - 1); }
            if constexpr (SP2) {
            PG8_LDB(B0, 0, 0); PG8_LDB(B1, 0, 1); PG8_SCHED; PG8_LDA(At, 0, 0); PG8_STAGE(PG8_SA(1, 1), a1 + hstepA, voffA);
            PG8_WAIT_V(8); PG8_WAIT_L(0); PG8_BAR; PG8_MMA(0, 0, At, B0); PG8_MMA(0, 1, At, B1); PG8_BAR; PG8_SCHED;
            PG8_LDA(At, 0, 1); PG8_STAGE(PG8_SB(0, 0), b2, voffB); PG8_STAGE(PG8_SB(0, 1), b2 + hstepB, voffB); PG8_STAGE(PG8_SA(0, 0), a2, voffA);
            PG8_WAIT_V(8); PG8_WAIT_L(0); PG8_BAR; PG8_MMA(1, 0, At, B0); PG8_MMA(1, 1, At, B1); PG8_BAR; PG8_SCHED;
            PG8_LDB(B0, 1, 0); PG8_LDB(B1, 1, 1); PG8_SCHED; PG8_LDA(At, 1, 0); PG8_STAGE(PG8_SA(0, 1), a2 + hstepA, voffA);
            PG8_WAIT_V(8); PG8_WAIT_L(0); PG8_BAR; PG8_MMA(0, 0, At, B0); PG8_MMA(0, 1, At, B1); PG8_BAR; PG8_SCHED;
            PG8_LDA(At, 1, 1); PG8_STAGE(PG8_SB(1, 0), b3, voffB); PG8_STAGE(PG8_SB(1, 1), b3 + hstepB, voffB); PG8_STAGE(PG8_SA(1, 0), a3, voffA);
            PG8_WAIT_V(8); PG8_WAIT_L(0); PG8_BAR; PG8_MMA(1, 0, At, B0); PG8_MMA(1, 1, At, B1); PG8_BAR; PG8_SCHED;
            } else {
            PG8_LDB(B0, 0, 0); PG8_SCHED; PG8_LDA(At, 0, 0); PG8_STAGE(PG8_SA(1, 1), a1 + hstepA, voffA);
            PG8_WAIT_L(8); PG8_BAR; PG8_WAIT_L(0); PG8_MMA(0, 0, At, B0); PG8_BAR; PG8_SCHED;
            PG8_LDB(B1, 0, 1); PG8_STAGE(PG8_SB(0, 0), b2, voffB);
            PG8_BAR; PG8_WAIT_L(0); PG8_MMA(0, 1, At, B1); PG8_BAR;
            PG8_LDA(At, 0, 1); PG8_STAGE(PG8_SA(0, 0), a2, voffA);
            PG8_BAR; PG8_WAIT_L(0); PG8_MMA(1, 0, At, B0); PG8_BAR; PG8_SCHED;
            PG8_STAGE(PG8_SB(0, 1), b2 + hstepB, voffB);
            PG8_WAIT_V(6); PG8_BAR; PG8_MMA(1, 1, At, B1); PG8_BAR;
            PG8_LDB(B0, 1, 0); PG8_SCHED; PG8_LDA(At, 1, 0); PG8_STAGE(PG8_SA(0, 1), a2 + hstepA, voffA);
            PG8_WAIT_L(8); PG8_BAR; PG8_WAIT_L(0); PG8_MMA(0, 0, At, B0); PG8_BAR; PG8_SCHED;
            PG8_LDB(B1, 1, 1); PG8_STAGE(PG8_SB(1, 0), b3, voffB);
            PG8_BAR; PG8_WAIT_L(0); PG8_MMA(0, 1, At, B1); PG8_BAR;
            PG8_LDA(At, 1, 1); PG8_STAGE(PG8_SA(1, 0), a3, voffA);
            PG8_BAR; PG8_WAIT_L(0); PG8_MMA(1, 0, At, B0); PG8_BAR; PG8_SCHED;
            PG8_STAGE(PG8_SB(1, 1), b3 + hstepB, voffB);
            PG8_WAIT_V(6); PG8_BAR; PG8_MMA(1, 1, At, B1); PG8_BAR;
            }
        }
        if constexpr (ALIGN_EPI) { if (wr == 0) PG8_BAR; }
        if constexpr (FP8) asm volatile("s_nop 15\n\ts_nop 15" ::: "memory");
        if constexpr (GS) PG8_GS_SCALE(ui & 1, 3);
        if constexpr (!Epi::AFTER_DRAIN) { E(acc, cur, wr, wc, fr, fq, pre); S.done(cur); }
        if (!has_next) break;
#pragma unroll
        for (int a = 0; a < 2; ++a)
#pragma unroll
            for (int b = 0; b < 2; ++b)
#pragma unroll
                for (int m = 0; m < 4; ++m)
#pragma unroll
                    for (int n = 0; n < 2; ++n) acc[a][b][m][n] = (f32x4){0.f, 0.f, 0.f, 0.f};
        cur = nxt; cA = nA; cB = nB; ++ui;
        if constexpr (ALIGN_EPI) { if (wr == 1) PG8_BAR; }
    }
    PG8_WAIT_V(0);
    if constexpr (!ALIGN_EPI) { if (wr == 0) PG8_BAR; }
    PG8_BAR;
    if constexpr (Epi::AFTER_DRAIN) { E.fused(acc, cur, wr, wc, fr, fq, lds, wid, lane); S.done(cur); }
#undef PG8_GS_TABLE
#undef PG8_GS_SCALE
#undef PG8_SA
#undef PG8_SB
#undef PG8_STAGE
#undef PG8_LDA
#undef PG8_LDB
#undef PG8_MMA
#undef PG8_HALF
#undef PG8_LD2
#undef PG8_WAIT_V
#undef PG8_WAIT_L
#undef PG8_BAR
#undef PG8_SCHED
}
}
#define XB_TMO      128
#define XB_XCNT(j)  (256  + 64 * (j))
#define XB_XSUB(j)  (1280 + 64 * (j))
#define XB_XGEN(j)  (2304 + 64 * (j))
#define XB_TOP      3328
#define XB_TOPGEN   3392
#define XCD_BAR_WORDS 3456
#define XB_SPIN_CAP (1u << 20)

__device__ __forceinline__ unsigned xb_ld(unsigned* p)              { return __hip_atomic_load(p, __ATOMIC_RELAXED, __HIP_MEMORY_SCOPE_AGENT); }
__device__ __forceinline__ unsigned xb_add(unsigned* p, unsigned v) { return __hip_atomic_fetch_add(p, v, __ATOMIC_RELAXED, __HIP_MEMORY_SCOPE_AGENT); }
__device__ __forceinline__ unsigned xb_xcc_id() { return (unsigned)__builtin_amdgcn_s_getreg((3 << 11) | 20) & 0xFu; }
#define XB_SPIN(cond, bar) do { unsigned _sp = 0; while (cond) { __builtin_amdgcn_s_sleep(1); \
    if ((++_sp & 255u) == 0u) { if (xb_ld(&(bar)[XB_TMO])) break; if (_sp > XB_SPIN_CAP) { atomicAdd(&(bar)[XB_TMO], 1u); break; } } } } while (0)

struct XcdBarrier {
    unsigned* bar; unsigned x;
    volatile LAS unsigned* st;
};

__device__ __forceinline__ XcdBarrier xcd_barrier_post(unsigned* bar, volatile LAS unsigned* st) {
    XcdBarrier b; b.bar = bar; b.x = xb_xcc_id(); b.st = st;
    if (threadIdx.x == 0) (void)xb_add(&bar[XB_XCNT(b.x)], 1u);
    return b;
}
__device__ __forceinline__ void xcd_barrier_complete(unsigned* bar, unsigned x, unsigned& nloc, unsigned& nx) {
    const unsigned G = gridDim.x * gridDim.y * gridDim.z;
    unsigned sum, cnt, mine, sp = 0u;
    for (;;) {
        sum = 0u; cnt = 0u; mine = 0u;
#pragma unroll
        for (unsigned j = 0; j < 16; ++j) { const unsigned c = xb_ld(&bar[XB_XCNT(j)]); sum += c; cnt += (c > 0u) ? 1u : 0u; mine = (j == x) ? c : mine; }
        if (sum == G) break;
        __builtin_amdgcn_s_sleep(1);
        if ((++sp & 255u) == 0u) { if (xb_ld(&bar[XB_TMO])) break; if (sp > XB_SPIN_CAP) { atomicAdd(&bar[XB_TMO], 1u); break; } }
    }
    nloc = mine > 0u ? mine : 1u; nx = cnt > 0u ? cnt : 1u;
}

__device__ __forceinline__ void xcd_barrier(const XcdBarrier& b) {
    asm volatile("s_waitcnt vmcnt(0)" ::: "memory");
    __syncthreads();
    if (threadIdx.x == 0) {
        unsigned* bar = b.bar;
        __builtin_amdgcn_s_waitcnt(0);
        unsigned nloc = b.st[0], nx = b.st[1];
        if (nloc == 0u) { xcd_barrier_complete(bar, b.x, nloc, nx); b.st[0] = nloc; b.st[1] = nx; }
        const unsigned old = xb_add(&bar[XB_XSUB(b.x)], 1u);
        const unsigned gen = old / nloc;
        if (old + 1u == (gen + 1u) * nloc) {
            __builtin_amdgcn_fence(__ATOMIC_RELEASE, "agent");
            asm volatile("s_waitcnt vmcnt(0)" ::: "memory");
            const unsigned og = xb_add(&bar[XB_TOP], 1u);
            const unsigned tg = og / nx;
            if (og + 1u == (tg + 1u) * nx) xb_add(&bar[XB_TOPGEN], 1u);
            else XB_SPIN(xb_ld(&bar[XB_TOPGEN]) == tg, bar);
            __builtin_amdgcn_fence(__ATOMIC_ACQUIRE, "agent");
            xb_add(&bar[XB_XGEN(b.x)], 1u);
            asm volatile("s_waitcnt vmcnt(0)" ::: "memory");
        } else {
            XB_SPIN(xb_ld(&bar[XB_XGEN(b.x)]) == gen, bar);
            __builtin_amdgcn_fence(__ATOMIC_ACQUIRE, "agent");
            asm volatile("s_waitcnt vmcnt(0)" ::: "memory");
        }
    }
    __syncthreads();
}

__device__ __forceinline__ void class_barrier(unsigned* ctr, unsigned target, unsigned* bar) {
    asm volatile("s_waitcnt vmcnt(0)" ::: "memory");
    __syncthreads();
    if (threadIdx.x == 0) {
        __builtin_amdgcn_s_waitcnt(0);
        (void)xb_add(ctr, 1u);
        XB_SPIN(xb_ld(ctr) < target, bar);
        __builtin_amdgcn_fence(__ATOMIC_ACQUIRE, "agent");
        asm volatile("s_waitcnt vmcnt(0)" ::: "memory");
    }
    __syncthreads();
}

struct WG { int tid, lane, wave, vcu, G; LAS unsigned char* lds; };

template <int MAP, bool F8>
__device__ __forceinline__ void transpose_item(const float* W, int K, int ldw, int Npad, void* WT, LAS unsigned char* scr, int item, int lane, float wscale, const float* kgain) {
    const int nblk = Npad / 128, kb = item / nblk, nb = item % nblk, k0 = 64 * kb, n0 = 128 * nb;
    const int r = lane >> 5, c4 = lane & 31;
    int sc = n0 + 4 * c4; if (MAP == 1) sc = inproj_src_col(sc); if (MAP == 3) sc = inproj_src_col(INP_A + sc);
    constexpr int EB = F8 ? 1 : 2;
    constexpr int ROWB = 64 * EB, NCH = ROWB / 16;
#pragma unroll
    for (int hb = 0; hb < 2; ++hb) {
        f32x4 v[16];
#pragma unroll
        for (int i = 0; i < 16; ++i) { const int k = k0 + 32 * r + 16 * hb + i;
            v[i] = (sc >= 0) ? *(const f32x4*)(W + (size_t)k * ldw + sc) : (f32x4){0.f, 0.f, 0.f, 0.f}; }
        if (kgain) {
#pragma unroll
            for (int i = 0; i < 16; ++i) v[i] = v[i] * kgain[k0 + 32 * r + 16 * hb + i]; }
#pragma unroll
        for (int j = 0; j < 4; ++j) { const int n = 4 * c4 + j;
            if constexpr (F8) { u32x4 w;
                w.x = pack4_fp8(v[0][j] * wscale, v[1][j] * wscale, v[2][j] * wscale, v[3][j] * wscale); w.y = pack4_fp8(v[4][j] * wscale, v[5][j] * wscale, v[6][j] * wscale, v[7][j] * wscale);
                w.z = pack4_fp8(v[8][j] * wscale, v[9][j] * wscale, v[10][j] * wscale, v[11][j] * wscale); w.w = pack4_fp8(v[12][j] * wscale, v[13][j] * wscale, v[14][j] * wscale, v[15][j] * wscale);
                *(LAS u32x4*)(scr + n * ROWB + ((((2 * r + hb)) ^ ((n >> 2) & (NCH - 1))) << 4)) = w; }
            else { u32x4 w0, w1;
                w0.x = cvt_pk_bf16(v[0][j], v[1][j]); w0.y = cvt_pk_bf16(v[2][j], v[3][j]); w0.z = cvt_pk_bf16(v[4][j], v[5][j]); w0.w = cvt_pk_bf16(v[6][j], v[7][j]);
                w1.x = cvt_pk_bf16(v[8][j], v[9][j]); w1.y = cvt_pk_bf16(v[10][j], v[11][j]); w1.z = cvt_pk_bf16(v[12][j], v[13][j]); w1.w = cvt_pk_bf16(v[14][j], v[15][j]);
                *(LAS u32x4*)(scr + n * ROWB + (((4 * r + 2 * hb) ^ ((n >> 2) & (NCH - 1))) << 4)) = w0;
                *(LAS u32x4*)(scr + n * ROWB + (((4 * r + 2 * hb + 1) ^ ((n >> 2) & (NCH - 1))) << 4)) = w1; } }
    }
    LDS_WAIT();
#pragma unroll
    for (int t = 0; t < 2 * NCH; ++t) { const int n = lane / NCH + (64 / NCH) * t, c = lane % NCH;
        const u32x4 w = *(const LAS u32x4*)(scr + n * ROWB + ((c ^ ((n >> 2) & (NCH - 1))) << 4));
        *(u32x4*)((unsigned char*)WT + ((size_t)(n0 + n) * K + k0) * EB + c * 16) = w; }
    LDS_WAIT();
}
struct LayerW { const float *w_in, *w_uq, *w_ukv, *w_out, *w_up, *w_down; };
constexpr int CONV_ITEMS = (DM / 64) * (INP / 128) + (QRANK / 64) * (768 / 128) + (KVRANK / 64) * (1024 / 128) + (MIXW / 64) * (DM / 128) + (DM / 64) * (DFF2 / 128) + (DFF / 64) * (DM / 128);
constexpr int CONV_SPLIT = 3456;
__device__ __forceinline__ void convert_item(const WG& g, const float* const* in, unsigned char* ws, int l, int it) {
    LAS unsigned char* scr = g.lds + g.wave * 16384;
    constexpr int I_IN = (DM / 64) * (INP / 128), I_UQ = (QRANK / 64) * (768 / 128), I_UKV = (KVRANK / 64) * (1024 / 128), I_OUT = (MIXW / 64) * (DM / 128),
                  I_UP = (DM / 64) * (DFF2 / 128), I_DOWN = (DFF / 64) * (DM / 128), I_LAYER = I_IN + I_UQ + I_UKV + I_OUT + I_UP + I_DOWN;
    static_assert(I_LAYER == CONV_ITEMS, "item count");
    unsigned char* wl = ws + WS_W + (size_t)l * W_LAYER;
    int r = it;
    constexpr int I_INA = (DM / 64) * (INP_A / 128);
    if (r < I_INA) { transpose_item<1, false>(in[2] + (size_t)l * DM * INW, DM, INW, INP_A, wl + W_IN, scr, r, g.lane, 1.f, in[1] + (size_t)l * DM); return; }
    if (r < I_IN) { transpose_item<3, true>(in[2] + (size_t)l * DM * INW, DM, INW, INP_B, wl + W_INB, scr, r - I_INA, g.lane, WINB_SCALE, in[1] + (size_t)l * DM); return; } r -= I_IN;
    if (r < I_UQ) { transpose_item<0, false>(in[10] + (size_t)l * QRANK * 768, QRANK, 768, 768, wl + W_UQ, scr, r, g.lane, 1.f, in[8] + (size_t)l * QRANK); return; } r -= I_UQ;
    if (r < I_UKV) { transpose_item<0, false>(in[11] + (size_t)l * KVRANK * 1024, KVRANK, 1024, 1024, wl + W_UKV, scr, r, g.lane, 1.f, in[9] + (size_t)l * KVRANK); return; } r -= I_UKV;
    if (r < I_OUT) { transpose_item<0, false>(in[15] + (size_t)l * MIXW * DM, MIXW, DM, DM, wl + W_OUT, scr, r, g.lane, 1.f, in[14] + (size_t)l * MIXW); return; } r -= I_OUT;
    if (r < I_UP) { transpose_item<0, FFN_FP8>(in[17] + (size_t)l * DM * DFF2, DM, DFF2, DFF2, wl + W_UP, scr, r, g.lane, WUP_SCALE, in[16] + (size_t)l * DM); return; } r -= I_UP;
    transpose_item<0, FFN_FP8>(in[20] + (size_t)l * DFF * DM, DFF, DM, DM, wl + W_DOWN, scr, r, g.lane, WDOWN_SCALE, nullptr);
}
__device__ __forceinline__ void convert_layer(const WG& g, const float* const* in, unsigned char* ws, int l, int widx, int nw, int it0 = 0, int it1 = CONV_ITEMS) {
    for (int it = it0 + widx; it < it1; it += nw) convert_item(g, in, ws, l, it);
}
__device__ __forceinline__ void prologue_phase(const WG& g, const float* const* in, unsigned char* ws) {
    convert_layer(g, in, ws, 0, g.vcu * NWAVES + g.wave, g.G * NWAVES);
    float* cosC = (float*)(ws + WS_COSC); float* sinC = (float*)(ws + WS_SINC); float* cosR = (float*)(ws + WS_COSR); float* sinR = (float*)(ws + WS_SINR);
    for (int idx = (g.vcu * NWAVES + g.wave) * 64 + g.lane; idx < SEQ * 96; idx += g.G * NWAVES * 64) {
        const bool isC = idx < SEQ * 64; const int j = isC ? idx : idx - SEQ * 64;
        const int pos = isC ? (j >> 6) : (j >> 5), i = isC ? (j & 63) : (j & 31);
        const float ang = (float)pos * (isC ? INVF128[i] : INVF128[2 * i]);
        double rev = (double)ang * 0.15915494309189535; rev -= __builtin_rint(rev);
        const float fr = (float)rev, c = __builtin_amdgcn_cosf(fr), s = __builtin_amdgcn_sinf(fr);
        if (isC) { cosC[j] = c; sinC[j] = s; } else { cosR[j] = c; sinR[j] = s; }
    }
}

__device__ __forceinline__ void stream_init_phase(const WG& g, const float* x, bf16* XS, unsigned long long* SS, unsigned char* X8B) {
    const int gw = g.vcu * NWAVES + g.wave, NGW = g.G * NWAVES;
    for (int m = gw; m < M; m += NGW) {
        const f32x4* xr = (const f32x4*)(x + (size_t)m * DM) + g.lane;
        f32x4 v[8]; float s = 0.f;
#pragma unroll
        for (int j = 0; j < 8; ++j) { v[j] = xr[64 * j]; s += (v[j].x * v[j].x + v[j].y * v[j].y) + (v[j].z * v[j].z + v[j].w * v[j].w); }
        s = wave_sum(s);
        if (g.lane == 0) SS[m] = (unsigned long long)(s * 16777216.f);
        u32x2* o8 = (u32x2*)(XS + (size_t)m * DM) + g.lane;
#pragma unroll
        for (int j = 0; j < 8; ++j) { u32x2 w; w.x = cvt_pk_bf16(v[j].x, v[j].y); w.y = cvt_pk_bf16(v[j].z, v[j].w); o8[64 * j] = w; }
        unsigned* o4 = (unsigned*)(X8B + (size_t)m * DM) + g.lane;
#pragma unroll
        for (int j = 0; j < 8; ++j) o4[64 * j] = pack4_fp8(v[j].x, v[j].y, v[j].z, v[j].w);
    }
}

__device__ __forceinline__ float log_sigmoid_f(float x) { return fminf(x, 0.f) - log1pf(expf(-fabsf(x))); }

__device__ __forceinline__ void head_norm128(const bf16* p, const float* gain, int hl, int li, float (&v)[8]) {
    unpack8(*(const u32x4*)(p + hl * 128 + li * 8), v);
    float ss = 0.f;
#pragma unroll
    for (int j = 0; j < 8; ++j) ss += v[j] * v[j];
    const float rstd = rsqrtf(sum16(ss) * (1.f / 128) + EPS);
    const f32x4 g0 = *(const f32x4*)(gain + li * 8), g1 = *(const f32x4*)(gain + li * 8 + 4);
#pragma unroll
    for (int j = 0; j < 4; ++j) { v[j] = v[j] * rstd * g0[j]; v[4 + j] = v[4 + j] * rstd * g1[j]; }
}
template <int NV>
__device__ __forceinline__ void rope_group(float (&v)[NV], const float* cs, const float* sn, int li) {
#pragma unroll
    for (int j = 0; j < NV; ++j) { const float pv = dppf<0x128>(v[j]); const float c = cs[j], s = sn[j];
        v[j] = (li < 8) ? (v[j] * c - pv * s) : (pv * s + v[j] * c); }
}

struct Prep { bf16* PROJ; bf16* OUT; bf16* QDR; bf16* QOUT; const bf16* KVR; bf16* KD; const float *fox_q, *fox_k, *moba_q, *moba_k, *q_g, *k_g, *b_forget; float* LF; float* KMS;
              const float *cosC, *sinC, *cosR, *sinR; unsigned* KMAX; };
__device__ __forceinline__ void mla_norm_rope(float (&n8)[8], float (&r4)[4], const float* gain, const float* cosR, const float* sinR, int pos, int li) {
    float ss = 0.f;
#pragma unroll
    for (int j = 0; j < 8; ++j) ss += n8[j] * n8[j];
#pragma unroll
    for (int j = 0; j < 4; ++j) ss += r4[j] * r4[j];
    const float rstd = rsqrtf(sum16(ss) * (1.f / QKD) + EPS);
    const f32x4 g0 = *(const f32x4*)(gain + li * 8), g1 = *(const f32x4*)(gain + li * 8 + 4), g2 = *(const f32x4*)(gain + 128 + li * 4);
#pragma unroll
    for (int j = 0; j < 4; ++j) { n8[j] = n8[j] * rstd * g0[j]; n8[4 + j] = n8[4 + j] * rstd * g1[j]; r4[j] = r4[j] * rstd * g2[j]; }
    const f32x4 c = *(const f32x4*)(cosR + pos * 32 + (li & 7) * 4), s = *(const f32x4*)(sinR + pos * 32 + (li & 7) * 4);
    float cs[4] = {c[0], c[1], c[2], c[3]}, sn[4] = {s[0], s[1], s[2], s[3]};
    rope_group<4>(r4, cs, sn, li);
}
struct PrepRaw { u32x4 aq, ak, cq, ck, qn, kn; u32x2 qr, kr; unsigned fw; f32x4 cc0, cc1, sc0, sc1, cr, sr; };
__device__ __forceinline__ PrepRaw prep_load(const Prep& P, int m, int hl, int li, int lane) {
    PrepRaw r; const bf16* row = P.PROJ + (size_t)m * INP; const int pos = m & (SEQ - 1);
    r.aq = *(const u32x4*)(row + C_AQ + hl * 128 + li * 8); r.ak = *(const u32x4*)(row + C_AK + hl * 128 + li * 8);
    r.cq = *(const u32x4*)(row + C_CQ + hl * 128 + li * 8); r.ck = *(const u32x4*)(row + C_CK + hl * 128 + li * 8);
    const bf16* qp = P.QDR + (size_t)m * 768 + hl * 192; r.qn = *(const u32x4*)(qp + li * 8); r.qr = *(const u32x2*)(qp + 128 + li * 4);
    r.kn = *(const u32x4*)(P.KVR + (size_t)m * 1024 + hl * 256 + li * 8); r.kr = *(const u32x2*)(row + C_DKR + li * 4);
    r.fw = (lane < 4) ? (unsigned)row[C_AF + lane] : 0u;
    const float* cp = P.cosC + pos * 64 + (li & 7) * 8; const float* sp = P.sinC + pos * 64 + (li & 7) * 8;
    r.cc0 = *(const f32x4*)cp; r.cc1 = *(const f32x4*)(cp + 4); r.sc0 = *(const f32x4*)sp; r.sc1 = *(const f32x4*)(sp + 4);
    r.cr = *(const f32x4*)(P.cosR + pos * 32 + (li & 7) * 4); r.sr = *(const f32x4*)(P.sinR + pos * 32 + (li & 7) * 4);
    return r;
}
__device__ __forceinline__ void norm128(u32x4 raw, const float (&gn)[8], float (&v)[8]) {
    unpack8(raw, v); float ss = 0.f;
#pragma unroll
    for (int j = 0; j < 8; ++j) ss += v[j] * v[j];
    const float rstd = rsqrtf(sum16(ss) * (1.f / 128) + EPS);
#pragma unroll
    for (int j = 0; j < 8; ++j) v[j] = v[j] * rstd * gn[j];
}
__device__ __forceinline__ void mla192(u32x4 rawn, u32x2 rawr, const float (&gn)[8], const float (&gr)[4], f32x4 c, f32x4 s, int li, float (&n8)[8], float (&r4)[4]) {
    unpack8(rawn, n8);
    r4[0] = __uint_as_float(rawr.x << 16); r4[1] = __uint_as_float(rawr.x & 0xffff0000u); r4[2] = __uint_as_float(rawr.y << 16); r4[3] = __uint_as_float(rawr.y & 0xffff0000u);
    float ss = 0.f;
#pragma unroll
    for (int j = 0; j < 8; ++j) ss += n8[j] * n8[j];
#pragma unroll
    for (int j = 0; j < 4; ++j) ss += r4[j] * r4[j];
    const float rstd = rsqrtf(sum16(ss) * (1.f / QKD) + EPS);
#pragma unroll
    for (int j = 0; j < 8; ++j) n8[j] = n8[j] * rstd * gn[j];
#pragma unroll
    for (int j = 0; j < 4; ++j) r4[j] = r4[j] * rstd * gr[j];
    float cs[4] = {c[0], c[1], c[2], c[3]}, sn[4] = {s[0], s[1], s[2], s[3]};
    rope_group<4>(r4, cs, sn, li);
}
__device__ __forceinline__ void prep_phase(const WG& g, const Prep& P) {
    LAS float* kacc = (LAS float*)g.lds;
    const int hl = g.lane >> 4, li = g.lane & 15;
    float gfq[8], gfk[8], gmq[8], gmk[8], gqn[8], gkn[8], gqr[4], gkr[4];
#pragma unroll
    for (int j = 0; j < 8; ++j) { gfq[j] = P.fox_q[li * 8 + j]; gfk[j] = P.fox_k[li * 8 + j]; gmq[j] = P.moba_q[li * 8 + j]; gmk[j] = P.moba_k[li * 8 + j]; gqn[j] = P.q_g[li * 8 + j]; gkn[j] = P.k_g[li * 8 + j]; }
#pragma unroll
    for (int j = 0; j < 4; ++j) { gqr[j] = P.q_g[128 + li * 4 + j]; gkr[j] = P.k_g[128 + li * 4 + j]; }
    const float bfg = (g.lane < 4) ? P.b_forget[g.lane] : 0.f;
    for (int chunk = g.vcu; chunk < M / 64; chunk += g.G) {
        float ksum[8]; float kmx = 0.f;
#pragma unroll
        for (int j = 0; j < 8; ++j) ksum[j] = 0.f;
        const int mb = chunk * 64 + g.wave * 8;
        PrepRaw raw = prep_load(P, mb, hl, li, g.lane);
        for (int rr = 0; rr < 8; ++rr) {
            const int m = mb + rr;
            PrepRaw nxt = raw; if (rr < 7) nxt = prep_load(P, m + 1, hl, li, g.lane);
            bf16* orow = P.OUT + (size_t)m * INP;
            float v[8];
            norm128(raw.aq, gfq, v); *(u32x4*)(orow + C_AQ + hl * 128 + li * 8) = pack8(v);
            norm128(raw.ak, gfk, v); *(u32x4*)(orow + C_AK + hl * 128 + li * 8) = pack8(v);
            { float kn2 = 0.f;
#pragma unroll
              for (int j = 0; j < 8; ++j) kn2 += v[j] * v[j];
              kmx = fmaxf(kmx, sum16(kn2)); }
            float cs[8], sn[8];
#pragma unroll
            for (int j = 0; j < 4; ++j) { cs[j] = raw.cc0[j]; cs[4 + j] = raw.cc1[j]; sn[j] = raw.sc0[j]; sn[4 + j] = raw.sc1[j]; }
            norm128(raw.cq, gmq, v); rope_group<8>(v, cs, sn, li); *(u32x4*)(orow + C_CQ + hl * 128 + li * 8) = pack8(v);
            norm128(raw.ck, gmk, v); rope_group<8>(v, cs, sn, li); *(u32x4*)(orow + C_CK + hl * 128 + li * 8) = pack8(v);
#pragma unroll
            for (int j = 0; j < 8; ++j) ksum[j] += v[j];
            { float n8[8], r4[4];
              mla192(raw.qn, raw.qr, gqn, gqr, raw.cr, raw.sr, li, n8, r4);
              bf16* qo = P.QOUT + (size_t)m * 768 + hl * 192;
              *(u32x4*)(qo + li * 8) = pack8(n8); u32x2 o; o.x = cvt_pk_bf16(r4[0], r4[1]); o.y = cvt_pk_bf16(r4[2], r4[3]); *(u32x2*)(qo + 128 + li * 4) = o; }
            { float n8[8], r4[4];
              mla192(raw.kn, raw.kr, gkn, gkr, raw.cr, raw.sr, li, n8, r4);
              bf16* kp = P.KD + (size_t)m * 768 + hl * 192;
              *(u32x4*)(kp + li * 8) = pack8(n8); u32x2 o; o.x = cvt_pk_bf16(r4[0], r4[1]); o.y = cvt_pk_bf16(r4[2], r4[3]); *(u32x2*)(kp + 128 + li * 4) = o; }
            if (g.lane < 4) P.LF[(size_t)m * 4 + g.lane] = log_sigmoid_f(bf2f(raw.fw) + bfg);
            raw = nxt;
        }
#pragma unroll
        for (int j = 0; j < 8; ++j) kacc[g.wave * 512 + hl * 128 + li * 8 + j] = ksum[j];
        if (li == 0) kacc[4096 + g.wave * 4 + hl] = kmx;
        __syncthreads();
        if (g.tid < 4) { float t = kacc[4096 + g.tid];
#pragma unroll
            for (int w = 1; w < 8; ++w) t = fmaxf(t, kacc[4096 + w * 4 + g.tid]);
            __hip_atomic_fetch_max(P.KMAX + ((chunk >> 6) * 4 + g.tid) * 16, __float_as_uint(t), __ATOMIC_RELAXED, __HIP_MEMORY_SCOPE_AGENT); }
        { float t = 0.f;
#pragma unroll
          for (int w = 0; w < 8; ++w) t += kacc[w * 512 + g.tid];
          P.KMS[(size_t)chunk * 512 + g.tid] = t; }
        __syncthreads();
    }
}

__device__ __forceinline__ void groupnorm_phase(const WG& g, bf16* O, const float* gain, bf16* OUT) {
    const int gw = g.vcu * NWAVES + g.wave, NGW = g.G * NWAVES;
    for (int m = gw; m < M; m += NGW) {
        bf16* row = O + (size_t)m * MIXW + g.lane * 8; bf16* orow = OUT + (size_t)m * MIXW + g.lane * 8;
#pragma unroll
        for (int grp = 0; grp < 4; ++grp) { float v[8]; unpack8(*(const u32x4*)(row + grp * GW), v); float ss = 0.f;
#pragma unroll
            for (int j = 0; j < 8; ++j) ss += v[j] * v[j];
            const float rstd = rsqrtf(wave_sum(ss) * (1.f / GW) + EPS);
            const f32x4 g0 = *(const f32x4*)(gain + grp * GW + g.lane * 8), g1 = *(const f32x4*)(gain + grp * GW + g.lane * 8 + 4);
#pragma unroll
            for (int j = 0; j < 4; ++j) { v[j] = v[j] * rstd * g0[j]; v[4 + j] = v[4 + j] * rstd * g1[j]; }
            *(u32x4*)(orow + grp * GW) = pack8(v); }
    }
}

__device__ __forceinline__ void convgate_phase(const WG& g, const bf16* U_, const float* cw, const float* cb, bf16* ACT) {
    const unsigned char* U = (const unsigned char*)U_; constexpr int UE = U_FP8 ? 1 : 2;
#define U_LD8(dst, rowi, coli) do { if constexpr (U_FP8) unpack8_fp8(*(const u32x2*)(U + ((size_t)(rowi) * DFF2 + (coli)) * UE), dst); else unpack8(*(const u32x4*)(U + ((size_t)(rowi) * DFF2 + (coli)) * UE), dst); } while (0)
    const int gw = g.vcu * NWAVES + g.wave, NGW = g.G * NWAVES;
    for (int u = gw; u < (M / 32) * 11; u += NGW) {
        const int cblk = u % 11, rc = u / 11, m0 = rc * 32, c0 = cblk * 512 + g.lane * 8;
        f32x2 w0[8], w1[8], w2[8], bb[8];
#pragma unroll
        for (int half = 0; half < 2; ++half) { const int c = c0 + half * DFF; const float ks = half == 0 ? -1.4426950408889634f : -0.6931471805599453f;
#pragma unroll
            for (int q = 0; q < 2; ++q) { const f32x4 a = *(const f32x4*)(cw + c + 4 * q) * ks, b = *(const f32x4*)(cw + DFF2 + c + 4 * q) * ks, d = *(const f32x4*)(cw + 2 * DFF2 + c + 4 * q) * ks, e = *(const f32x4*)(cb + c + 4 * q) * ks;
#pragma unroll
                for (int jp = 0; jp < 2; ++jp) { const int k = half * 4 + q * 2 + jp; w0[k] = (f32x2){a[2 * jp], a[2 * jp + 1]}; w1[k] = (f32x2){b[2 * jp], b[2 * jp + 1]}; w2[k] = (f32x2){d[2 * jp], d[2 * jp + 1]}; bb[k] = (f32x2){e[2 * jp], e[2 * jp + 1]}; } } }
        f32x2 p2[8], p1[8];
        if ((m0 & (SEQ - 1)) == 0) {
#pragma unroll
            for (int k = 0; k < 8; ++k) { p2[k] = (f32x2){0.f, 0.f}; p1[k] = (f32x2){0.f, 0.f}; }
        } else {
            float t[8];
            U_LD8(t, m0 - 2, c0);
#pragma unroll
            for (int k = 0; k < 4; ++k) p2[k] = (f32x2){t[2 * k], t[2 * k + 1]};
            U_LD8(t, m0 - 2, DFF + c0);
#pragma unroll
            for (int k = 0; k < 4; ++k) p2[4 + k] = (f32x2){t[2 * k], t[2 * k + 1]};
            U_LD8(t, m0 - 1, c0);
#pragma unroll
            for (int k = 0; k < 4; ++k) p1[k] = (f32x2){t[2 * k], t[2 * k + 1]};
            U_LD8(t, m0 - 1, DFF + c0);
#pragma unroll
            for (int k = 0; k < 4; ++k) p1[4 + k] = (f32x2){t[2 * k], t[2 * k + 1]};
        }
        for (int r0 = 0; r0 < 32; r0 += 8) {
            u32x4 gl[8], vl[8];
#pragma unroll
            for (int q = 0; q < 8; ++q) { if constexpr (U_FP8) { const u32x2 a = *(const u32x2*)(U + (size_t)(m0 + r0 + q) * DFF2 + c0), b = *(const u32x2*)(U + (size_t)(m0 + r0 + q) * DFF2 + DFF + c0); gl[q].x = a.x; gl[q].y = a.y; vl[q].x = b.x; vl[q].y = b.y; }
                else { gl[q] = *(const u32x4*)(U + ((size_t)(m0 + r0 + q) * DFF2 + c0) * 2); vl[q] = *(const u32x4*)(U + ((size_t)(m0 + r0 + q) * DFF2 + DFF + c0) * 2); } }
#pragma unroll
            for (int q = 0; q < 8; ++q) {
                f32x2 cur[8]; float t[8];
                if constexpr (U_FP8) unpack8_fp8((u32x2){gl[q].x, gl[q].y}, t); else unpack8(gl[q], t);
#pragma unroll
                for (int k = 0; k < 4; ++k) cur[k] = (f32x2){t[2 * k], t[2 * k + 1]};
                if constexpr (U_FP8) unpack8_fp8((u32x2){vl[q].x, vl[q].y}, t); else unpack8(vl[q], t);
#pragma unroll
                for (int k = 0; k < 4; ++k) cur[4 + k] = (f32x2){t[2 * k], t[2 * k + 1]};
                float o[8];
#pragma unroll
                for (int k = 0; k < 4; ++k) {
                    const f32x2 G = __builtin_elementwise_fma(w2[k], cur[k], __builtin_elementwise_fma(w1[k], p1[k], __builtin_elementwise_fma(w0[k], p2[k], bb[k])));
                    const f32x2 V = __builtin_elementwise_fma(w2[4 + k], cur[4 + k], __builtin_elementwise_fma(w1[4 + k], p1[4 + k], __builtin_elementwise_fma(w0[4 + k], p2[4 + k], bb[4 + k])));
                    o[2 * k] = G.x * V.x * __builtin_amdgcn_rcpf(1.f + __builtin_amdgcn_exp2f(G.x));
                    o[2 * k + 1] = G.y * V.y * __builtin_amdgcn_rcpf(1.f + __builtin_amdgcn_exp2f(G.y));
                }
                if constexpr (FFN_FP8) { u32x2 w; w.x = pack4_fp8(o[0], o[1], o[2], o[3]); w.y = pack4_fp8(o[4], o[5], o[6], o[7]); *(u32x2*)((unsigned char*)ACT + (size_t)(m0 + r0 + q) * DFF + c0) = w; }
                else *(u32x4*)(ACT + (size_t)(m0 + r0 + q) * DFF + c0) = pack8(o);
#pragma unroll
                for (int k = 0; k < 8; ++k) { p2[k] = p1[k]; p1[k] = cur[k]; }
            }
        }
    }
#undef U_LD8
}

namespace att {
enum { T_FOX = 0, T_STICK = 1, T_MOBA = 2, T_MLA = 3 };
constexpr int KVB = 64, SHM_K = 16384, SHM_V = 16384, SHM_KR = 8192;
constexpr int OFF_K = 0, OFF_V = 32768, OFF_KR = 65536, OFF_WS = 82432, OFF_MISC = 84480, OFF_AUX = 86016;
#define KSWZ(row, colB) ((row) * 256 + ((colB) ^ (((row) & 7) << 4)))
__device__ __forceinline__ int v_st(int k, int c) { const int kk = (k & ~0xC) | ((k & 4) << 1) | ((k & 8) >> 1); return ((kk >> 3) * 4 + (c >> 5)) * 512 + ((kk & 7) * 32 + (c & 31)) * 2; }
__device__ __forceinline__ int v_rd_base(int lane) { return ((lane & 3) << 3) | (((lane >> 2) & 3) << 6) | (((lane >> 4) & 1) << 5) | (((lane >> 5) & 1) << 8); }
constexpr int v_rd_off(int d0, int ks, int half) { return d0 * 512 + ks * 4096 + half * 2048; }
__device__ __forceinline__ int crow(int r, int hi) { return (r & 3) + 8 * (r >> 2) + 4 * hi; }

__device__ __forceinline__ void pack_p(const f32x16& p0, const f32x16& p1, bf16x8& pa0, bf16x8& pa1, bf16x8& pa2, bf16x8& pa3) {
#define PK4(P, B_, OUT) do { unsigned a0 = cvt_pk_bf16(P[B_+0], P[B_+1]), a1 = cvt_pk_bf16(P[B_+2], P[B_+3]);                          \
        unsigned b0 = cvt_pk_bf16(P[B_+4], P[B_+5]), b1 = cvt_pk_bf16(P[B_+6], P[B_+7]);                                             \
        auto r0 = __builtin_amdgcn_permlane32_swap(a0, b0, false, false); auto r1 = __builtin_amdgcn_permlane32_swap(a1, b1, false, false); \
        u32x4 w = {r0[0], r1[0], r0[1], r1[1]}; OUT = *reinterpret_cast<bf16x8*>(&w); } while (0)
    PK4(p0, 0, pa0); PK4(p0, 8, pa1); PK4(p1, 0, pa2); PK4(p1, 8, pa3);
#undef PK4
}
__device__ __forceinline__ void softmax_tile(f32x16& p0, f32x16& p1, float& m_reg, float& l_reg, float& alpha, const float SCALE, const float C2) {
    float pmax = p0[0];
#pragma unroll
    for (int r = 1; r < 16; ++r) pmax = fmaxf(pmax, p0[r]);
#pragma unroll
    for (int r = 0; r < 16; ++r) pmax = fmaxf(pmax, p1[r]);
    { auto rr = __builtin_amdgcn_permlane32_swap(__float_as_uint(pmax), __float_as_uint(pmax), false, false);
      pmax = fmaxf(__uint_as_float(rr[0]), __uint_as_float(rr[1])); }
    float mn;
    if (__builtin_expect(__all((pmax - m_reg) * SCALE <= 8.f), 1)) { mn = m_reg; alpha = 1.f; }
    else { mn = fmaxf(m_reg, pmax); alpha = __builtin_amdgcn_exp2f((m_reg - mn) * C2); m_reg = mn; }
    const float mnL = -mn * C2;
#pragma unroll
    for (int r = 0; r < 16; ++r) { p0[r] = __builtin_amdgcn_exp2f(fmaf(p0[r], C2, mnL)); p1[r] = __builtin_amdgcn_exp2f(fmaf(p1[r], C2, mnL)); }
    float ps = 0.f;
#pragma unroll
    for (int r = 0; r < 16; ++r) ps += p0[r];
#pragma unroll
    for (int r = 0; r < 16; ++r) ps += p1[r];
    { auto rr = __builtin_amdgcn_permlane32_swap(__float_as_uint(ps), __float_as_uint(ps), false, false);
      ps = __uint_as_float(rr[0]) + __uint_as_float(rr[1]); }
    l_reg = l_reg * alpha + ps;
}
__device__ __forceinline__ void pv_tile(f32x16* o, int vb0, bf16x8 pa0, bf16x8 pa1, bf16x8 pa2, bf16x8 pa3) {
#define TRRD(dst, off) asm volatile("ds_read_b64_tr_b16 %0, %1 offset:%2" : "=&v"(dst) : "v"(vb0), "i"(off) : "memory")
#define PV_D0(d0) do { s16x4 l0, l1, l2, l3, h0, h1, h2, h3; constexpr int b_ = v_rd_off(d0, 0, 0);   \
        TRRD(l0, b_); TRRD(h0, b_ + 2048); TRRD(l1, b_ + 4096); TRRD(h1, b_ + 6144); TRRD(l2, b_ + 8192); TRRD(h2, b_ + 10240); TRRD(l3, b_ + 12288); TRRD(h3, b_ + 14336); \
        asm volatile("s_waitcnt lgkmcnt(0)" ::: "memory"); SBAR();   \
        o[d0] = __builtin_amdgcn_mfma_f32_32x32x16_bf16(pa0, (bf16x8){l0[0], l0[1], l0[2], l0[3], h0[0], h0[1], h0[2], h0[3]}, o[d0], 0, 0, 0);   \
        o[d0] = __builtin_amdgcn_mfma_f32_32x32x16_bf16(pa1, (bf16x8){l1[0], l1[1], l1[2], l1[3], h1[0], h1[1], h1[2], h1[3]}, o[d0], 0, 0, 0);   \
        o[d0] = __builtin_amdgcn_mfma_f32_32x32x16_bf16(pa2, (bf16x8){l2[0], l2[1], l2[2], l2[3], h2[0], h2[1], h2[2], h2[3]}, o[d0], 0, 0, 0);   \
        o[d0] = __builtin_amdgcn_mfma_f32_32x32x16_bf16(pa3, (bf16x8){l3[0], l3[1], l3[2], l3[3], h3[0], h3[1], h3[2], h3[3]}, o[d0], 0, 0, 0); } while (0)
    PV_D0(0); PV_D0(1); PV_D0(2); PV_D0(3);
#undef PV_D0
#undef TRRD
}

__device__ __forceinline__ int moba_k0(unsigned um, int i) { unsigned mm = um; for (int j = 0; j < (i >> 2); ++j) mm &= mm - 1; return (__ffs(mm) - 1) * 256 + (i & 3) * 64; }
struct Tensors {
    const bf16* Q; const bf16* K; const bf16* V; int ldq, ldk, ldv;
    int qh, kh, vh, grp;
    bf16* O;
    const float* LF; const float* KMS; const unsigned* KMAX; unsigned long long* SSG;
};

template <int TYPE>
__device__ __forceinline__ void attn_item(const Tensors& T, int b, int h, int qb, LAS unsigned char* lds, unsigned ldsb, unsigned* qnext) {
    constexpr bool FOX = TYPE == T_FOX, STICK = TYPE == T_STICK, MOBA = TYPE == T_MOBA, MLA = TYPE == T_MLA;
    constexpr int NKS = MLA ? 12 : 8;
    const float SCALE = MLA ? 0.07216878364870322f : 0.08838834764831845f;
    const float C2 = SCALE * 1.4426950408889634f;
    int tid_ = threadIdx.x; asm volatile("" : "+v"(tid_));
    const int tid = tid_, wid = __builtin_amdgcn_readfirstlane(tid >> 6), lane = tid & 63, r32 = lane & 31, hi = lane >> 5;
    const int qlo = qb * 256 + wid * 32, qpos = qlo + r32;
    const size_t tok0 = (size_t)b * SEQ;
    LAS unsigned* misc = (LAS unsigned*)(lds + OFF_MISC);
    LAS float* wsf = (LAS float*)(lds + OFF_WS) + wid * 64; LAS float* li_l = wsf; LAS float* al_l = wsf + 32;
    bf16x8 qr[NKS];
    { const bf16* qp = T.Q + (tok0 + qpos) * T.ldq + h * T.qh + hi * 8;
#pragma unroll
      for (int d0 = 0; d0 < NKS; ++d0) qr[d0] = *(const bf16x8*)(qp + d0 * 16); }
    const bf16* Kp = T.K + tok0 * T.ldk + h * T.kh; const bf16* Vp = T.V + tok0 * T.ldv + h * T.vh;
    unsigned um = 0, selmask = 0; int NT = 4 * (qb + 1);
    if constexpr (MOBA) {
        { LAS float* KM = (LAS float*)(lds + OFF_AUX);
          for (int idx = tid; idx < qb * 128; idx += NWAVES * 64) { const int n = idx >> 7, d = idx & 127;
              const float* s = T.KMS + ((size_t)(b * 64 + 4 * n) * 4 + h) * 128 + d;
              KM[idx] = ((s[0] + s[512]) + (s[1024] + s[1536])) * (1.f / 256); }
          __syncthreads();
          float gate[15];
#pragma unroll
          for (int n = 0; n < 15; ++n) { gate[n] = -__builtin_inff();
              if (n < qb) { float a = 0.f;
#pragma unroll
                  for (int d0 = 0; d0 < 8; ++d0) { const f32x4 ka = *(const LAS f32x4*)(KM + n * 128 + d0 * 16 + hi * 8), kb = *(const LAS f32x4*)(KM + n * 128 + d0 * 16 + hi * 8 + 4);
                      const u32x4 w = __builtin_bit_cast(u32x4, qr[d0]);
                      a = fmaf(__uint_as_float(w[0] << 16), ka[0], a); a = fmaf(__uint_as_float(w[0] & 0xffff0000u), ka[1], a);
                      a = fmaf(__uint_as_float(w[1] << 16), ka[2], a); a = fmaf(__uint_as_float(w[1] & 0xffff0000u), ka[3], a);
                      a = fmaf(__uint_as_float(w[2] << 16), kb[0], a); a = fmaf(__uint_as_float(w[2] & 0xffff0000u), kb[1], a);
                      a = fmaf(__uint_as_float(w[3] << 16), kb[2], a); a = fmaf(__uint_as_float(w[3] & 0xffff0000u), kb[3], a); }
                  gate[n] = a + __shfl_xor(a, 32); } }
#pragma unroll
          for (int pass = 0; pass < 3; ++pass) { float best = -__builtin_inff(); int bi = -1;
#pragma unroll
              for (int n = 0; n < 15; ++n) { if (n < qb && !((selmask >> n) & 1u) && gate[n] > best) { best = gate[n]; bi = n; } }
              if (bi >= 0) selmask |= 1u << bi; } }
        unsigned w = selmask;
#pragma unroll
        for (int o = 1; o < 64; o <<= 1) w |= __shfl_xor(w, o);
        if (lane == 0) __hip_atomic_fetch_or(&misc[1], w, __ATOMIC_RELAXED, __HIP_MEMORY_SCOPE_WORKGROUP);
        __syncthreads();
        um = misc[1] | (1u << qb); NT = 4 * __popc(um);
    }
#define tile_k0(i_) ((STICK || FOX) ? 64 * (NT - 1 - (i_)) : MOBA ? moba_k0(um, (i_)) : 64 * (i_))
    const int sr = tid >> 4, sc = (tid & 15) * 8, kws = KSWZ(sr, sc * 2), vst0 = v_st(sr, sc), vst1 = v_st(32 + sr, sc);
    const int krr = tid >> 3, krc = tid & 7, krw = krr * 128 + ((krc ^ ((krr >> 1) & 7)) << 4);
    bf16x8 st_k0, st_k1, st_v0, st_v1, st_kr;
    LAS float* cfl = (LAS float*)(lds + OFF_AUX);
    if constexpr (FOX) { LAS double* dsum = (LAS double*)(lds + OFF_AUX + 16384);
        const int nk = 256 * (qb + 1); double loc[8], run = 0.0;
        if (8 * tid < nk) {
#pragma unroll
            for (int j = 0; j < 8; ++j) { run += (double)T.LF[(tok0 + 8 * tid + j) * 4 + h]; loc[j] = run; } }
        double inc = run;
#pragma unroll
        for (int o = 1; o < 64; o <<= 1) { const double t = __shfl_up(inc, o); if (lane >= o) inc += t; }
        if (lane == 63) dsum[wid] = inc;
        __syncthreads();
        double off = inc - run;
        for (int w = 0; w < wid; ++w) off += dsum[w];
        if (8 * tid < nk) {
#pragma unroll
            for (int j = 0; j < 8; ++j) cfl[8 * tid + j] = (float)(off + loc[j]); }
        __syncthreads(); }
#define SLOAD(k0_) do { const int k0s = (k0_); const bf16* kp_ = Kp + (size_t)(k0s + sr) * T.ldk + sc; const bf16* vp_ = Vp + (size_t)(k0s + sr) * T.ldv + sc; \
        st_k0 = *(const bf16x8*)kp_; st_k1 = *(const bf16x8*)(kp_ + (size_t)32 * T.ldk); st_v0 = *(const bf16x8*)vp_; st_v1 = *(const bf16x8*)(vp_ + (size_t)32 * T.ldv); \
        if constexpr (MLA) st_kr = *(const bf16x8*)(Kp + (size_t)(k0s + krr) * T.ldk + 128 + krc * 8); \
        } while (0)
#define SWRITE(bf) do { *(LAS bf16x8*)(lds + OFF_K + (bf) * SHM_K + kws) = st_k0; *(LAS bf16x8*)(lds + OFF_K + (bf) * SHM_K + kws + 32 * 256) = st_k1; \
        *(LAS bf16x8*)(lds + OFF_V + (bf) * SHM_V + vst0) = st_v0; *(LAS bf16x8*)(lds + OFF_V + (bf) * SHM_V + vst1) = st_v1; \
        if constexpr (MLA) *(LAS bf16x8*)(lds + OFF_KR + (bf) * SHM_KR + krw) = st_kr; \
        } while (0)
    const int vrd = v_rd_base(lane);
    const int kq0 = KSWZ(r32, (0 * 16 + hi * 8) * 2), kq1 = KSWZ(r32, (1 * 16 + hi * 8) * 2), kq2 = KSWZ(r32, (2 * 16 + hi * 8) * 2), kq3 = KSWZ(r32, (3 * 16 + hi * 8) * 2);
    float m_reg = -1e30f, l_reg = 0.f, Pst = 1.f; f32x16 o[4] = {};
    const float ci = FOX ? cfl[qpos] * 11.313708498984761f : 0.f;
    float bound_s = 0.f; bool wdone = false;
    if constexpr (FOX) { float ssq = 0.f;
#pragma unroll
        for (int d0 = 0; d0 < 8; ++d0) { const u32x4 w = __builtin_bit_cast(u32x4, qr[d0]);
#pragma unroll
            for (int e = 0; e < 4; ++e) { const float a0 = __uint_as_float(w[e] << 16), a1 = __uint_as_float(w[e] & 0xffff0000u); ssq += a0 * a0 + a1 * a1; } }
        ssq += __shfl_xor(ssq, 32);
        const float kmax2 = __uint_as_float(__hip_atomic_load(T.KMAX + (b * 4 + h) * 16, __ATOMIC_RELAXED, __HIP_MEMORY_SCOPE_AGENT));
        bound_s = sqrtf(ssq) * sqrtf(kmax2) * 1.02f; }
    SLOAD(tile_k0(0)); SWRITE(0);
    for (int i = 0; i < NT; ++i) {
        const int cur = i & 1, k0 = tile_k0(i);
        if (i + 1 < NT) SLOAD(tile_k0(i + 1));
        __syncthreads();
        if constexpr (STICK || FOX) { if (i > 0) { bool alld = true;
#pragma unroll
            for (int w = 0; w < 8; ++w) alld = alld && (misc[4 + ((i - 1) & 1) * 8 + w] != 0u);
            if (alld) break; } }
        bool act = k0 <= qlo;
        if constexpr (MOBA) { const int blk = k0 >> 8; if (blk != qb) act = __any((selmask >> blk) & 1u); }
        if constexpr (FOX) { if (wdone) act = false; }
        if (act) {
            f32x16 p0, p1;
            if constexpr (FOX) { const LAS float* bp = cfl + k0 + 4 * hi;
#pragma unroll
                for (int gq = 0; gq < 4; ++gq) { const f32x4 c0 = *(const LAS f32x4*)(bp + 8 * gq), c1 = *(const LAS f32x4*)(bp + 32 + 8 * gq);
#pragma unroll
                    for (int q = 0; q < 4; ++q) { p0[4 * gq + q] = fmaf(c0[q], -11.313708498984761f, ci); p1[4 * gq + q] = fmaf(c1[q], -11.313708498984761f, ci); } } }
            else { p0 = f32x16{}; p1 = f32x16{}; }
            { const LAS unsigned char* kb = lds + OFF_K + cur * SHM_K;
#pragma unroll
              for (int d0 = 0; d0 < 8; ++d0) { const int ko = ((d0 & 3) == 0 ? kq0 : (d0 & 3) == 1 ? kq1 : (d0 & 3) == 2 ? kq2 : kq3) + (d0 >> 2) * 128;
                const bf16x8 b0 = *(const LAS bf16x8*)(kb + ko), b1 = *(const LAS bf16x8*)(kb + ko + 32 * 256);
                p0 = __builtin_amdgcn_mfma_f32_32x32x16_bf16(b0, qr[d0], p0, 0, 0, 0);
                p1 = __builtin_amdgcn_mfma_f32_32x32x16_bf16(b1, qr[d0], p1, 0, 0, 0); } }
            if constexpr (MLA) { const LAS unsigned char* kb = lds + OFF_KR + cur * SHM_KR + r32 * 128; const int sw = (r32 >> 1) & 7;
#pragma unroll
              for (int dd = 0; dd < 4; ++dd) { const int ko = ((2 * dd + hi) ^ sw) << 4;
                const bf16x8 b0 = *(const LAS bf16x8*)(kb + ko), b1 = *(const LAS bf16x8*)(kb + ko + 32 * 128);
                p0 = __builtin_amdgcn_mfma_f32_32x32x16_bf16(b0, qr[8 + dd], p0, 0, 0, 0);
                p1 = __builtin_amdgcn_mfma_f32_32x32x16_bf16(b1, qr[8 + dd], p1, 0, 0, 0); } }
            bf16x8 pa0, pa1, pa2, pa3;
            if constexpr (!STICK) {
                const float NEG = -__builtin_inff();
                if constexpr (MOBA) { const int blk = k0 >> 8; if (blk != qb && !((selmask >> blk) & 1u)) {
#pragma unroll
                    for (int r = 0; r < 16; ++r) { p0[r] = NEG; p1[r] = NEG; } } }
                if (k0 + 63 > qlo) { const int dq = qpos - k0 - 4 * hi;
#pragma unroll
                    for (int r = 0; r < 16; ++r) { const int c = (r & 3) + 8 * (r >> 2); if (dq - c < 0) p0[r] = NEG; if (dq - c - 32 < 0) p1[r] = NEG; } }
                float alpha;
                softmax_tile(p0, p1, m_reg, l_reg, alpha, SCALE, C2);
                if constexpr (FOX) { const float ck0 = cfl[k0] * 11.313708498984761f;
                    wdone = __all((bound_s + ci - ck0 - m_reg) * SCALE < -30.f); }
                if (__any(alpha < 1.f)) { if (hi == 0) al_l[r32] = alpha; LDS_WAIT();
#pragma unroll
                    for (int d_ = 0; d_ < 4; ++d_)
#pragma unroll
                        for (int r = 0; r < 16; ++r) o[d_][r] *= al_l[crow(r, hi)];
                    LDS_WAIT(); }
                pack_p(p0, p1, pa0, pa1, pa2, pa3);
            } else {
                const bool needmask = k0 + 63 >= qlo; const int dq = qpos - k0 - 4 * hi;
                float Tg[8];
#pragma unroll
                for (int gq = 0; gq < 8; ++gq) {
                    float be[4], om[4];
#pragma unroll
                    for (int q = 0; q < 4; ++q) { const float s = gq < 4 ? p0[4 * gq + q] : p1[4 * (gq - 4) + q];
                        const float z2 = fminf(fmaxf(s * C2, -115.f), 115.f), e = __builtin_amdgcn_exp2f(z2);
                        float omq = __builtin_amdgcn_rcpf(1.f + e), beq = e * omq;
                        const int c = q + 8 * (gq & 3) + 32 * (gq >> 2);
                        if (needmask && !(c < dq)) { omq = 1.f; beq = 0.f; }
                        om[q] = omq; be[q] = beq; }
                    const float s2 = om[3], s1 = s2 * om[2], s0 = s1 * om[1];
                    Tg[gq] = s0 * om[0];
                    const float w0 = be[0] * s0, w1 = be[1] * s1, w2 = be[2] * s2, w3 = be[3];
                    if (gq < 4) { p0[4 * gq] = w0; p0[4 * gq + 1] = w1; p0[4 * gq + 2] = w2; p0[4 * gq + 3] = w3; }
                    else { p1[4 * (gq - 4)] = w0; p1[4 * (gq - 4) + 1] = w1; p1[4 * (gq - 4) + 2] = w2; p1[4 * (gq - 4) + 3] = w3; }
                }
                float S = Pst;
#pragma unroll
                for (int gq = 7; gq >= 0; --gq) {
                    const float oth = __shfl_xor(Tg[gq], 32);
                    const float E = hi ? S : S * oth;
                    S = S * (Tg[gq] * oth);
                    if (gq < 4) { p0[4 * gq] *= E; p0[4 * gq + 1] *= E; p0[4 * gq + 2] *= E; p0[4 * gq + 3] *= E; }
                    else { p1[4 * (gq - 4)] *= E; p1[4 * (gq - 4) + 1] *= E; p1[4 * (gq - 4) + 2] *= E; p1[4 * (gq - 4) + 3] *= E; }
                }
                Pst = S;
                pack_p(p0, p1, pa0, pa1, pa2, pa3);
            }
            pv_tile(o, (int)(ldsb + OFF_V + cur * SHM_V) + vrd, pa0, pa1, pa2, pa3);
        }
        if constexpr (STICK) { const bool dn = __all(Pst < 1e-30f); if (lane == 0) misc[4 + (i & 1) * 8 + wid] = dn ? 1u : 0u; }
        if constexpr (FOX) { if (lane == 0) misc[4 + (i & 1) * 8 + wid] = wdone ? 1u : 0u; }
        if (i + 1 < NT) SWRITE(cur ^ 1);
    }
    float rli[16];
    if constexpr (!STICK) { if (hi == 0) li_l[r32] = l_reg; LDS_WAIT();
#pragma unroll
        for (int r = 0; r < 16; ++r) rli[r] = __builtin_amdgcn_rcpf(li_l[crow(r, hi)]); }
    unsigned pfv = 0xffffffffu; if (qnext && tid == 0) pfv = __hip_atomic_fetch_add(qnext, 1u, __ATOMIC_RELAXED, __HIP_MEMORY_SCOPE_AGENT);
    __syncthreads();
    LAS unsigned char* ost = lds + wid * 8192;
    float sq[16];
#pragma unroll
    for (int r = 0; r < 16; ++r) { const int orow = crow(r, hi); sq[r] = 0.f;
#pragma unroll
        for (int d0 = 0; d0 < 4; ++d0) { float v = o[d0][r]; if constexpr (!STICK) v *= rli[r];
            sq[r] += v * v;
            const float vn = __shfl_xor(v, 1);
            if ((r32 & 1) == 0) *(LAS unsigned*)(ost + orow * 256 + (d0 * 32 + r32) * 2) = cvt_pk_bf16(v, vn); } }
    { float t8[8], t4[4], t2[2];
      const bool b4 = r32 & 16, b3 = r32 & 8, b2 = r32 & 4, b1 = r32 & 2;
#pragma unroll
      for (int j = 0; j < 8; ++j) { const float keep = b4 ? sq[8 + j] : sq[j], send = b4 ? sq[j] : sq[8 + j]; t8[j] = keep + __shfl_xor(send, 16); }
#pragma unroll
      for (int j = 0; j < 4; ++j) { const float keep = b3 ? t8[4 + j] : t8[j], send = b3 ? t8[j] : t8[4 + j]; t4[j] = keep + __shfl_xor(send, 8); }
#pragma unroll
      for (int j = 0; j < 2; ++j) { const float keep = b2 ? t4[2 + j] : t4[j], send = b2 ? t4[j] : t4[2 + j]; t2[j] = keep + __shfl_xor(send, 4); }
      float w1; { const float keep = b1 ? t2[1] : t2[0], send = b1 ? t2[0] : t2[1]; w1 = keep + __shfl_xor(send, 2); }
      w1 += __shfl_xor(w1, 1);
      const int ri = r32 >> 1;
      if ((r32 & 1) == 0) __hip_atomic_fetch_add(T.SSG + (tok0 + qlo + crow(ri, hi)) * 4 + T.grp, (unsigned long long)(w1 * 16777216.f), __ATOMIC_RELAXED, __HIP_MEMORY_SCOPE_AGENT); }
    LDS_WAIT();
    { bf16* Ow = T.O + (tok0 + qlo) * MIXW + h * HD;
#pragma unroll
      for (int k = 0; k < 8; ++k) { const int row = (lane >> 4) + 4 * k, ch = lane & 15;
          const u32x4 w = *(const LAS u32x4*)(ost + row * 256 + ch * 16);
          *(u32x4*)(Ow + (size_t)row * MIXW + ch * 8) = w; } }
    if (qnext && tid == 0) misc[2] = pfv;
#undef SLOAD
#undef SWRITE
#undef tile_k0
}

struct PhaseArgs { const bf16* PROJ; const bf16* QDR; const bf16* KVR; const bf16* KD; bf16* O; const float* LF; const float* KMS; unsigned* queue; const unsigned* KMAX; unsigned long long* SSG; int only; };
struct PairOrder { unsigned char ty[64], qb[64]; };
__host__ __device__ constexpr PairOrder make_pair_order() {
    PairOrder o{}; float cost[64] = {}; int n = 0;
    for (int ty = 0; ty < 4; ++ty) for (int qb = 0; qb < 16; ++qb) {
        const float c = ty == T_MLA ? 1.25f * (qb + 1) : ty == T_MOBA ? 1.0f * (qb + 1) + 0.5f : ty == T_FOX ? (qb + 1 < 5 ? 1.0f * (qb + 1) : 4.5f + 0.05f * qb) : (qb + 1 < 2 ? 0.6f : 0.8f + 0.01f * qb);
        int pos = n; while (pos > 0 && cost[pos - 1] < c) { cost[pos] = cost[pos - 1]; o.ty[pos] = o.ty[pos - 1]; o.qb[pos] = o.qb[pos - 1]; --pos; }
        cost[pos] = c; o.ty[pos] = (unsigned char)ty; o.qb[pos] = (unsigned char)qb; ++n; }
    return o;
}
__constant__ PairOrder PAIR_ORDER = make_pair_order();
__device__ __forceinline__ void attn_phase(const PhaseArgs& A, LAS unsigned char* lds, unsigned ldsb) {
    LAS unsigned* misc = (LAS unsigned*)(lds + OFF_MISC);
    Tensors TD, TA, TC, TB;
    TD.LF = TA.LF = TC.LF = TB.LF = A.LF; TD.KMS = TA.KMS = TC.KMS = TB.KMS = A.KMS; TD.KMAX = TA.KMAX = TC.KMAX = TB.KMAX = A.KMAX; TD.SSG = TA.SSG = TC.SSG = TB.SSG = A.SSG;
    TD.Q = A.QDR; TD.K = A.KD; TD.V = A.KVR + 128; TD.ldq = 768; TD.ldk = 768; TD.ldv = 1024; TD.qh = 192; TD.kh = 192; TD.vh = 256; TD.O = A.O + 3 * GW; TD.grp = 3;
    TA.Q = A.PROJ + C_AQ; TA.K = A.PROJ + C_AK; TA.V = A.PROJ + C_AV; TA.ldq = TA.ldk = TA.ldv = INP; TA.qh = TA.kh = TA.vh = 128; TA.O = A.O; TA.grp = 0;
    TC = TA; TC.Q = A.PROJ + C_CQ; TC.K = A.PROJ + C_CK; TC.V = A.PROJ + C_CV; TC.O = A.O + 2 * GW; TC.grp = 2;
    TB = TA; TB.Q = A.PROJ + C_BQ; TB.K = A.PROJ + C_BK; TB.V = A.PROJ + C_BV; TB.O = A.O + GW; TB.grp = 1;
    const int G = (int)gridDim.x, x0 = (int)blockIdx.x & 7, nstat = (G == 256) ? 32 : 0;
    int kq = 0;
    for (int round = 0;; ++round) {
        if (threadIdx.x == 0) { unsigned code = 0xffffffffu;
            if (round == 0 && nstat) code = (unsigned)(x0 * 128 + ((int)blockIdx.x >> 3));
            else { if (round > 0 && kq < 8) { const unsigned i = (unsigned)nstat + misc[2];
                       if (i < 128u) code = (unsigned)((x0 + kq) & 7) * 128u + i; else ++kq; }
                   if (code == 0xffffffffu) for (; kq < 8; ++kq) { const int q = (x0 + kq) & 7;
                       const unsigned i = (unsigned)nstat + __hip_atomic_fetch_add(A.queue + 16 * q, 1u, __ATOMIC_RELAXED, __HIP_MEMORY_SCOPE_AGENT);
                       if (i < 128u) { code = (unsigned)q * 128u + i; break; } } }
            misc[0] = code; misc[1] = 0u; }
        __syncthreads();
        const unsigned code = misc[0];
        if (code == 0xffffffffu) break;
        const int q = (int)(code >> 7), i = (int)(code & 127u), pr = i >> 1, bh = q + 8 * (i & 1), ty = PAIR_ORDER.ty[pr], qb = PAIR_ORDER.qb[pr];
        unsigned* qn = (kq < 8) ? A.queue + 16 * ((x0 + kq) & 7) : nullptr;
        if (ty == T_MLA) attn_item<T_MLA>(TD, bh >> 2, bh & 3, qb, lds, ldsb, qn);
        else if (ty == T_MOBA) attn_item<T_MOBA>(TC, bh >> 2, bh & 3, qb, lds, ldsb, qn);
        else if (ty == T_FOX) attn_item<T_FOX>(TA, bh >> 2, bh & 3, qb, lds, ldsb, qn);
        else attn_item<T_STICK>(TB, bh >> 2, bh & 3, qb, lds, ldsb, qn);
        __syncthreads();
    }
}
}

#ifndef PROBE_DUP
#define PROBE_DUP 0
#endif
#ifndef MK_SPLIT
#define MK_SPLIT 0
#endif
constexpr int N_PHASES = 1 + 8 * DEPTH;
struct Args { const float* in[21]; float* out; unsigned char* ws; int ph_lo, ph_hi; };
__global__ void __launch_bounds__(NWAVES * 64, 2) hybrid_fwd(Args args) {
    extern __shared__ __attribute__((aligned(16))) unsigned char lds_raw[];
#define MKWG() WG g; { int t_ = threadIdx.x; asm volatile("" : "+v"(t_)); g.lds = (LAS unsigned char*)lds_raw; g.tid = t_; g.lane = t_ & 63; g.wave = __builtin_amdgcn_readfirstlane(t_ >> 6); \
        g.G = gridDim.x; const int bx_ = blockIdx.x; g.vcu = (g.G % 8 == 0) ? (bx_ % 8) * (g.G / 8) + bx_ / 8 : bx_; }
    LAS unsigned char* const lds0 = (LAS unsigned char*)lds_raw; const int tid0 = threadIdx.x, G0 = gridDim.x;
    volatile LAS unsigned* MISC = (volatile LAS unsigned*)(lds0 + MISC_OFF);
    unsigned char* ws = args.ws;
    unsigned* ctl = (unsigned*)(ws + WS_CTL);
    for (int u = tid0; u < (LDS_BYTES - RING_BYTES) / 4; u += NWAVES * 64) ((LAS unsigned*)(lds0 + RING_BYTES))[u] = 0u;
    __syncthreads();
    const int lo = args.ph_lo, hi = args.ph_hi;
    XcdBarrier bar; bar.bar = ctl + CW_BAR; bar.x = 0; bar.st = nullptr;
    if (hi - lo > 1) bar = xcd_barrier_post(ctl + CW_BAR, MISC + 8);
    if (tid0 == 0) (void)__hip_atomic_fetch_or(ctl + 8192 + 64 * ((int)blockIdx.x & 7) + 16, 1u << xb_xcc_id(), __ATOMIC_RELAXED, __HIP_MEMORY_SCOPE_AGENT);
    const unsigned ldsb = (unsigned)(uintptr_t)lds_raw;
#ifndef PH_EN
#define PH_EN 0x1fff
#endif
#define IN(k) (lo <= (k) && (k) < hi)
#define EN(j) ((PH_EN >> (j)) & 1)
#if PROBE_DUP == 10
#define SEAM(k) do { if (IN(k) && IN((k) + 1)) { xcd_barrier(bar); xcd_barrier(bar); } } while (0)
#else
#define SEAM(k) do { if (IN(k) && IN((k) + 1)) xcd_barrier(bar); } while (0)
#endif
#ifndef CLASS_SEAMS
#define CLASS_SEAMS 1
#endif
#define CSEAM(k, s) do { if (IN(k) && IN((k) + 1)) { if (CLASS_SEAMS && G0 == 256 && hi - lo == N_PHASES && MISC[12] != 0u) class_barrier(ctl + 8192 + 64 * ((int)blockIdx.x & 7), 32u * (unsigned)(s), ctl + CW_BAR); else xcd_barrier(bar); } } while (0)

    bf16* XS = (bf16*)(ws + WS_XS); bf16* PROJ = (bf16*)(ws + WS_PROJ); bf16* QDR = (bf16*)(ws + WS_QDR); bf16* KVR = (bf16*)(ws + WS_KVR); bf16* KD = (bf16*)(ws + WS_KD);
    bf16* OB = (bf16*)(ws + WS_O); bf16* UB = (bf16*)(ws + WS_U); bf16* ACT = (bf16*)(ws + WS_ACT); bf16* X8 = (bf16*)(ws + WS_X8); bf16* X8B = (bf16*)(ws + WS_X8B);
    float* LF = (float*)(ws + WS_LF); float* KMS = (float*)(ws + WS_KMS); unsigned long long* SS = (unsigned long long*)(ws + WS_SS); unsigned long long* SSG = (unsigned long long*)(ws + WS_SSG); unsigned long long* SSD = (unsigned long long*)(ws + WS_SSD);
    const float* cosC = (const float*)(ws + WS_COSC); const float* sinC = (const float*)(ws + WS_SINC); const float* cosR = (const float*)(ws + WS_COSR); const float* sinR = (const float*)(ws + WS_SINR);

    if (EN(12) && IN(0)) { MKWG(); prologue_phase(g, args.in, ws); __syncthreads(); stream_init_phase(g, args.in[0], XS, SS, (unsigned char*)X8B);
#if PROBE_DUP == 4
        __syncthreads(); prologue_phase(g, args.in, ws); __syncthreads(); stream_init_phase(g, args.in[0], XS, SS, (unsigned char*)X8B);
#endif
    }
    SEAM(0);
    if (tid0 == 0) { bool ok = true;
#pragma unroll
        for (int c = 0; c < 8; ++c) { const unsigned mk = __hip_atomic_load(ctl + 8192 + 64 * c + 16, __ATOMIC_RELAXED, __HIP_MEMORY_SCOPE_AGENT); ok = ok && __popc(mk) == 1; }
        MISC[12] = ok ? 1u : 0u; }
    __syncthreads();

    for (int l = 0; l < DEPTH; ++l) {
        const int p0 = 1 + 8 * l;
        const unsigned char* wl = ws + WS_W + (size_t)l * W_LAYER;
        unsigned long long* SS1 = SS + (size_t)(2 * l) * M; unsigned long long* SS2 = SS1 + M;
        unsigned long long* SSQ = SSD + (size_t)(2 * l) * M; unsigned long long* SSKV = SSQ + M;
        if (EN(0) && IN(p0 + 0)) {
            { MKWG(); pg8::Gemm gm{XS, (const bf16*)(wl + W_IN), M, INP_A, DM, DM, nullptr}; pg8::StaticOrder S; S.init(M, INP_A, g.G, (int)blockIdx.x);
              pg8::EpiBf16 E{PROJ, INP, 1.f, SS1, 1.f / DM, SSQ, SSKV, C_DCQ / 256, C_DCQ / 256 + 1, C_DCKV / 256, 0};
              pg8::gemm_phase<pg8::EpiBf16, pg8::StaticOrder, true, true>(g.lds, gm, S, E); }
            if (l + 1 < DEPTH) { MKWG(); const int nwg = (M / 256) * (INP_A / 256), maxr = (nwg + g.G - 1) / g.G, rem = nwg - (maxr - 1) * g.G, c = (int)blockIdx.x;
                if (rem >= g.G) convert_layer(g, args.in, ws, l + 1, c * NWAVES + g.wave, g.G * NWAVES, 0, CONV_SPLIT);
                else if (c >= rem) convert_layer(g, args.in, ws, l + 1, (c - rem) * NWAVES + g.wave, (g.G - rem) * NWAVES, 0, CONV_SPLIT); }
            __syncthreads();
            { MKWG(); pg8::Gemm gm{X8B, (const bf16*)(wl + W_INB), M, INP_B, DM / 2, DM / 2, nullptr};
              pg8::EpiBf16 E{PROJ + INP_A, INP, 1.f / WINB_SCALE, SS1, 1.f / DM, nullptr, nullptr, 0, 0, 0, 0};
              if (l + 1 == DEPTH && g.G == 256) { pg8::SkewOrder S; S.init(M, INP_B, g.G, (int)blockIdx.x); pg8::gemm_phase<pg8::EpiBf16, pg8::SkewOrder, true, true, true>(g.lds, gm, S, E); }
              else { pg8::StaticOrder S; S.init(M, INP_B, g.G, (int)blockIdx.x); pg8::gemm_phase<pg8::EpiBf16, pg8::StaticOrder, true, true, true>(g.lds, gm, S, E); } }
#if PROBE_DUP == 1
            pg8::gemm_phase<pg8::EpiBf16, pg8::StaticOrder, true, true>(g.lds, gm, S, E);
#endif
#if PROBE_DUP == 22
            xcd_barrier(bar); { pg8::EpiBf16 E2{PROJ, INP, 1.f, SS1, 1.f / DM, nullptr, nullptr, 0, 0, 0, 0}; pg8::gemm_phase<pg8::EpiBf16, pg8::StaticOrder, true, true>(g.lds, gm, S, E2); }
#endif
        }
        CSEAM(p0 + 0, 4 * l + 1);
        if (EN(2) && IN(p0 + 1)) { MKWG();
            { pg8::Gemm gm{PROJ + C_DCQ, (const bf16*)(wl + W_UQ), M, 768, QRANK, INP, nullptr}; pg8::StaticOrder S; S.init(M, 768, g.G, (int)blockIdx.x);
              pg8::EpiBf16 E{QDR, 768, 1.f, SSQ, 1.f / QRANK, nullptr, nullptr, 0, 0, 0, 0};
              pg8::gemm_phase<pg8::EpiBf16, pg8::StaticOrder, true, true>(g.lds, gm, S, E); }
            { pg8::Gemm gm{PROJ + C_DCKV, (const bf16*)(wl + W_UKV), M, 1024, KVRANK, INP, nullptr}; pg8::StaticOrder S; S.init(M, 1024, g.G, (int)blockIdx.x);
              pg8::EpiBf16 E{KVR, 1024, 1.f, SSKV, 1.f / KVRANK, nullptr, nullptr, 0, 0, 0, 0};
              pg8::gemm_phase<pg8::EpiBf16, pg8::StaticOrder, true, true>(g.lds, gm, S, E); }
        }
        CSEAM(p0 + 1, 4 * l + 2);
        if (EN(1) && IN(p0 + 2)) { MKWG(); Prep P{PROJ, PROJ, QDR, QDR, KVR, KD, args.in[4] + l * HD, args.in[5] + l * HD, args.in[6] + l * HD, args.in[7] + l * HD, args.in[12] + l * QKD, args.in[13] + l * QKD, args.in[3] + l * GH,
                                                 LF, KMS, cosC, sinC, cosR, sinR, ctl + CW_KMAX + 256 * l};
            prep_phase(g, P);
#if PROBE_DUP == 24
            xcd_barrier(bar); P.OUT = ACT; P.QOUT = ACT + (size_t)M * INP; P.KD = P.QOUT + (size_t)M * 768; P.LF = (float*)(P.KD + (size_t)M * 768); P.KMS = P.LF + (size_t)M * 4; P.KMAX = (unsigned*)(P.KMS + 262144); prep_phase(g, P);
#endif
        }
        SEAM(p0 + 2);
        if (EN(4) && IN(p0 + 3)) { MKWG(); att::PhaseArgs A{PROJ, QDR, KVR, KD, OB, LF, KMS, ctl + CW_QUEUE + 256 * l, ctl + CW_KMAX + 256 * l, SSG + (size_t)l * M * 4, -1};
            att::attn_phase(A, g.lds, ldsb);
            if (l + 1 < DEPTH) { MKWG(); volatile LAS unsigned* mq = (volatile LAS unsigned*)(g.lds + MISC_OFF + 64);
                for (;;) { __syncthreads(); if (g.tid == 0) mq[0] = __hip_atomic_fetch_add(ctl + CW_QUEUE + 256 * l + 192, 1u, __ATOMIC_RELAXED, __HIP_MEMORY_SCOPE_AGENT);
                    __syncthreads(); const int base = CONV_SPLIT + 8 * (int)mq[0]; if (base >= CONV_ITEMS) break;
                    if (base + g.wave < CONV_ITEMS) convert_item(g, args.in, ws, l + 1, base + g.wave); } }
#if PROBE_DUP == 2
            __syncthreads(); A.queue = ctl + CW_QUEUE + 256 * (l + 8); att::attn_phase(A, g.lds, ldsb);
#endif
#if PROBE_DUP >= 30 && PROBE_DUP <= 33
            __syncthreads(); A.queue = ctl + CW_QUEUE + 256 * (l + 8); A.SSG = (unsigned long long*)ACT; A.only = PROBE_DUP - 30; att::attn_phase(A, g.lds, ldsb);
#endif
#if PROBE_DUP == 21
            xcd_barrier(bar); A.queue = ctl + CW_QUEUE + 256 * (l + 8); A.SSG = (unsigned long long*)ACT; att::attn_phase(A, g.lds, ldsb);
#endif
        }
        SEAM(p0 + 3);
        if (EN(6) && IN(p0 + 4)) { MKWG(); pg8::Gemm gm{OB, (const bf16*)(wl + W_OUT), M, DM, MIXW, MIXW, SSG + (size_t)l * M * 4}; pg8::StaticOrder S; S.init(M, DM, g.G, (int)blockIdx.x);
            pg8::EpiStream<FFN_FP8> E{XS, nullptr, X8, SS2, DM, 1.f};
            pg8::gemm_phase<pg8::EpiStream<FFN_FP8>, pg8::StaticOrder, true, true, false, true>(g.lds, gm, S, E);
#if PROBE_DUP == 5
            { pg8::EpiStream<FFN_FP8> E2{XS, nullptr, X8, nullptr, DM, 0.f}; pg8::gemm_phase<pg8::EpiStream<FFN_FP8>, pg8::StaticOrder, true, true>(g.lds, gm, S, E2); }
#endif
        }
        CSEAM(p0 + 4, 4 * l + 3);
        if (EN(8) && IN(p0 + 5)) { MKWG(); constexpr int KD_ = FFN_FP8 ? 2 : 1;
            pg8::Gemm gm{X8, (const bf16*)(wl + W_UP), M, DFF2, DM / KD_, DM / KD_, nullptr}; pg8::StaticOrder S; S.init(M, DFF2, g.G, (int)blockIdx.x);
            pg8::EpiBf16 E{UB, DFF2, 1.f / WUP_SCALE, SS2, 1.f / DM, nullptr, nullptr, 0, 0, 0, U_FP8 ? 1 : 0};
            pg8::gemm_phase<pg8::EpiBf16, pg8::StaticOrder, true, true, FFN_FP8>(g.lds, gm, S, E);
#if PROBE_DUP == 1
            pg8::gemm_phase<pg8::EpiBf16, pg8::StaticOrder, true, true, FFN_FP8>(g.lds, gm, S, E);
#endif
#if PROBE_DUP == 23
            xcd_barrier(bar); pg8::gemm_phase<pg8::EpiBf16, pg8::StaticOrder, true, true, FFN_FP8>(g.lds, gm, S, E);
#endif
        }
        SEAM(p0 + 5);
        if (EN(9) && IN(p0 + 6)) { MKWG(); convgate_phase(g, UB, args.in[18] + (size_t)l * 3 * DFF2, args.in[19] + (size_t)l * DFF2, ACT);
#if PROBE_DUP == 3
            convgate_phase(g, UB, args.in[18] + (size_t)l * 3 * DFF2, args.in[19] + (size_t)l * DFF2, ACT);
#endif
#if PROBE_DUP == 12
            xcd_barrier(bar); convgate_phase(g, UB, args.in[18] + (size_t)l * 3 * DFF2, args.in[19] + (size_t)l * DFF2, ACT);
#endif
        }
        SEAM(p0 + 6);
        if (EN(10) && IN(p0 + 7)) { MKWG(); constexpr int KD_ = FFN_FP8 ? 2 : 1; const bool last = (l + 1 == DEPTH);
            pg8::Gemm gm{ACT, (const bf16*)(wl + W_DOWN), M, DM, DFF / KD_, DFF / KD_, nullptr}; pg8::StaticOrder S; S.init(M, DM, g.G, (int)blockIdx.x);
            pg8::EpiStream<true> E{XS, last ? args.out : nullptr, last ? nullptr : (void*)X8B, last ? nullptr : SS1 + 2 * M, DM, 1.f / WDOWN_SCALE};
            pg8::gemm_phase<pg8::EpiStream<true>, pg8::StaticOrder, true, true, FFN_FP8>(g.lds, gm, S, E);
#if PROBE_DUP == 6
            if (!last) { pg8::EpiStream<false> E2{XS, nullptr, nullptr, nullptr, DM, 0.f}; pg8::gemm_phase<pg8::EpiStream<false>, pg8::StaticOrder, true, true, FFN_FP8>(g.lds, gm, S, E2); }
#endif
        }
        if (l + 1 < DEPTH) CSEAM(p0 + 7, 4 * l + 4);
    }
#undef IN
#undef SEAM
#undef CSEAM
#undef MKWG
}

extern "C" void kernel_launch(void* const* d_in, const int* in_sizes, int n_in, void* d_out, int out_size, void* d_ws, size_t ws_size, hipStream_t stream) {
    static int grid = 0;
    if (grid == 0) {
        if (n_in != 21 || in_sizes[0] != M * DM || out_size != M * DM || ws_size < WS_END) {
            fprintf(stderr, "kernel_launch: built for 21 inputs, x and out of %d floats, >= %zu bytes of workspace; got n_in %d, in0 %d, out %d, ws %zu; nothing launched\n", M * DM, (size_t)WS_END, n_in, n_in > 0 ? in_sizes[0] : -1, out_size, ws_size);
            grid = -1; return; }
        int dev = 0, cus = 0, per_cu = 0;
        if (hipGetDevice(&dev) != hipSuccess || hipDeviceGetAttribute(&cus, hipDeviceAttributeMultiprocessorCount, dev) != hipSuccess) { fprintf(stderr, "kernel_launch: device query failed\n"); grid = -1; return; }
        if (hipFuncSetAttribute((const void*)hybrid_fwd, hipFuncAttributeMaxDynamicSharedMemorySize, LDS_BYTES) != hipSuccess) { fprintf(stderr, "kernel_launch: hipFuncSetAttribute(%d B LDS) failed\n", LDS_BYTES); grid = -1; return; }
        if (hipOccupancyMaxActiveBlocksPerMultiprocessor(&per_cu, (const void*)hybrid_fwd, NWAVES * 64, LDS_BYTES) != hipSuccess || per_cu < 1)
            fprintf(stderr, "kernel_launch: note: occupancy query reports %d workgroups per CU\n", per_cu);
        (void)hipGetLastError();
        grid = cus;
    }
    if (grid < 0) return;
    if (hipMemsetAsync((char*)d_ws + WS_CTL, 0, CTL_ZERO_BYTES, stream) != hipSuccess) { fprintf(stderr, "kernel_launch: memset failed\n"); return; }
    Args a{};
    for (int i = 0; i < 21; ++i) a.in[i] = (const float*)d_in[i];
    a.out = (float*)d_out; a.ws = (unsigned char*)d_ws;
#if MK_SPLIT
    for (int p = 0; p < N_PHASES; ++p) { a.ph_lo = p; a.ph_hi = p + 1; hipLaunchKernelGGL(hybrid_fwd, dim3(grid), dim3(NWAVES * 64), LDS_BYTES, stream, a); }
#else
    a.ph_lo = 0; a.ph_hi = N_PHASES;
    hipLaunchKernelGGL(hybrid_fwd, dim3(grid), dim3(NWAVES * 64), LDS_BYTES, stream, a);
#endif
    const hipError_t le = hipPeekAtLastError();
    if (le != hipSuccess) fprintf(stderr, "kernel_launch: launch failed: %s\n", hipGetErrorName(le));
}
```
